# Optimizing an MI355X kernel written in HIP

```python
import jax, jax.numpy as jnp
from jax import lax
import numpy as np

D_MODEL = 1024
BATCH = 2
SEQ = 8192
DEPTH = 4

CHUNK = 64
GM_BLOCK = 128
GM_HEADS = 4
GM_HEAD_DIM = 128
GM_DIM = GM_HEADS * GM_HEAD_DIM
HG_HEADS = 4
HG_DK = 128
HG_DV = 128
HG_FDIM = HG_HEADS * HG_DK
HG_IDIM = HG_HEADS * HG_DV
N_BRANCH = 2
D_FF = 2816
CONV_W = 3
EPS = 1e-6
TINY = 1e-30
LB_MAX = 0.999
IN_SIZES = (GM_DIM, GM_DIM, HG_FDIM, HG_FDIM, HG_IDIM, HG_IDIM, N_BRANCH * D_MODEL)
IN_COLS = 2 * GM_DIM + 2 * HG_FDIM + 2 * HG_IDIM + N_BRANCH * D_MODEL

kernel_name = "hybrid_gmlp_hgrn2_convffn_trunk"


def _split_cols(z, sizes):
    outs, start = [], 0
    for s in sizes:
        outs.append(z[..., start:start + s])
        start += s
    return outs


def _rmsnorm(x, g):
    xf = x.astype(jnp.float32)
    r = lax.rsqrt(jnp.mean(xf * xf, axis=-1, keepdims=True) + EPS)
    return (xf * r).astype(x.dtype) * g


def _layernorm(x, g, b):
    xf = x.astype(jnp.float32)
    mu = jnp.mean(xf, axis=-1, keepdims=True)
    var = jnp.mean(jnp.square(xf - mu), axis=-1, keepdims=True)
    return ((xf - mu) * lax.rsqrt(var + EPS)).astype(x.dtype) * g + b


def _gmlp_branch(u, v, ln_g, ln_b, ws, bs):
    B, S, _ = v.shape
    nb = S // GM_BLOCK
    v = _layernorm(v, ln_g, ln_b)
    vb = v.reshape(B, nb, GM_BLOCK, GM_HEADS, GM_HEAD_DIM)
    pos = jnp.arange(GM_BLOCK) // CHUNK
    mask = pos[:, None] >= pos[None, :]
    w = jnp.where(mask[None], ws, 0.0).astype(v.dtype)
    mixed = jnp.einsum('hij,bnjhd->bnihd', w, vb) + bs.T[None, None, :, :, None]
    return u * mixed.reshape(B, S, GM_DIM)


def _hgrn2_chunk_step(state, inp):
    q, k, g, v = inp
    C = q.shape[2]
    G = jnp.cumsum(g, axis=2)
    causal = jnp.tril(jnp.ones((C, C), dtype=bool))[None, None, :, :, None]
    diff = G[:, :, :, None, :] - G[:, :, None, :, :]
    decay = jnp.where(causal, jnp.exp(jnp.minimum(diff, 0.0)), 0.0)
    A = jnp.einsum('bhid,bhijd,bhjd->bhij', q, decay, k)
    o = jnp.einsum('bhij,bhje->bhie', A, v) + jnp.einsum('bhid,bhde->bhie', q * jnp.exp(G), state)
    G_last = G[:, :, -1:, :]
    state = jnp.exp(G_last[:, :, 0, :])[..., None] * state + \
        jnp.einsum('bhjd,bhje->bhde', k * jnp.exp(G_last - G), v)
    return state, o


def _hgrn2_branch(q, f, i, og, lb, norm_g):
    B, S, _ = q.shape
    nc = S // CHUNK
    out_dtype = i.dtype
    qf = jax.nn.silu(q.astype(jnp.float32))
    ff = f.astype(jnp.float32)
    lb = jnp.clip(lb.astype(jnp.float32), 0.0, LB_MAX)
    forget = lb + (1.0 - lb) * jax.nn.sigmoid(ff)
    g_log = jnp.log(jnp.maximum(forget, TINY))
    k = (1.0 - lb) * jax.nn.sigmoid(-ff)
    vf = i.astype(jnp.float32)

    def to_chunks(t, d):
        return t.reshape(B, nc, CHUNK, HG_HEADS, d).transpose(1, 0, 3, 2, 4)

    xs = (to_chunks(qf, HG_DK), to_chunks(k, HG_DK), to_chunks(g_log, HG_DK), to_chunks(vf, HG_DV))
    s0 = jnp.zeros((B, HG_HEADS, HG_DK, HG_DV), jnp.float32)
    _, o = lax.scan(_hgrn2_chunk_step, s0, xs)
    o = o.transpose(1, 0, 3, 2, 4).reshape(B, S, HG_HEADS, HG_DV).astype(out_dtype)
    o = _rmsnorm(o, norm_g) * jax.nn.silu(og.reshape(B, S, HG_HEADS, HG_DV))
    return o.reshape(B, S, HG_IDIM)


def _conv_ffn(h, w_up, conv_w, conv_b, w_down):
    S = h.shape[1]
    z = h @ w_up
    zp = jnp.pad(z, ((0, 0), (CONV_W - 1, 0), (0, 0)))
    zc = conv_b + sum(zp[:, t:t + S, :] * conv_w[t] for t in range(CONV_W))
    gate, val = zc[..., :D_FF], zc[..., D_FF:]
    return (jax.nn.silu(gate) * val) @ w_down


def setup_inputs(seed: int = 0) -> dict:
    key = jax.random.key(seed)
    ks = jax.random.split(key, 20)
    f32 = jnp.float32

    def nrm(k, shape, scale):
        return jax.random.normal(k, shape, f32) * scale

    return {
        "x": nrm(ks[0], (BATCH, SEQ, D_MODEL), 1.0),
        "mix_norm": 1.0 + nrm(ks[1], (DEPTH, D_MODEL), 0.05),
        "w_in": nrm(ks[2], (DEPTH, D_MODEL, IN_COLS), D_MODEL ** -0.5),
        "gm_ln_g": 1.0 + nrm(ks[3], (DEPTH, GM_DIM), 0.05),
        "gm_ln_b": nrm(ks[4], (DEPTH, GM_DIM), 0.02),
        "gm_ws": nrm(ks[5], (DEPTH, GM_HEADS, GM_BLOCK, GM_BLOCK), GM_BLOCK ** -0.5),
        "gm_bs": 1.0 + nrm(ks[6], (DEPTH, GM_HEADS, GM_BLOCK), 0.1),
        "hg_lb_logits": nrm(ks[7], (DEPTH, HG_FDIM), 0.5),
        "hg_norm_g": 1.0 + nrm(ks[8], (DEPTH, HG_DV), 0.05),
        "w_br_gm": nrm(ks[9], (DEPTH, GM_DIM, D_MODEL), GM_DIM ** -0.5),
        "w_br_hg": nrm(ks[10], (DEPTH, HG_IDIM, D_MODEL), HG_IDIM ** -0.5),
        "w_out": nrm(ks[11], (DEPTH, D_MODEL, D_MODEL), D_MODEL ** -0.5),
        "ffn_norm": 1.0 + nrm(ks[12], (DEPTH, D_MODEL), 0.05),
        "w_up": nrm(ks[13], (DEPTH, D_MODEL, 2 * D_FF), D_MODEL ** -0.5),
        "conv_w": nrm(ks[14], (DEPTH, CONV_W, 2 * D_FF), CONV_W ** -0.5),
        "conv_b": nrm(ks[15], (DEPTH, 2 * D_FF), 0.02),
        "w_down": nrm(ks[16], (DEPTH, D_FF, D_MODEL), D_FF ** -0.5),
        "final_norm": 1.0 + nrm(ks[17], (D_MODEL,), 0.05),
    }


def reference(x, mix_norm, w_in, gm_ln_g, gm_ln_b, gm_ws, gm_bs, hg_lb_logits, hg_norm_g,
              w_br_gm, w_br_hg, w_out, ffn_norm, w_up, conv_w, conv_b, w_down, final_norm):
    p = jax.nn.softmax(hg_lb_logits.astype(jnp.float32), axis=0)
    lower_bounds = jnp.cumsum(p, axis=0) - p[0:1]
    for l in range(DEPTH):
        h = _rmsnorm(x, mix_norm[l])
        z = h @ w_in[l]
        u, v, q, f, i, og, gates = _split_cols(z, IN_SIZES)
        a = _gmlp_branch(jax.nn.gelu(u, approximate=False), jax.nn.gelu(v, approximate=False),
                         gm_ln_g[l], gm_ln_b[l], gm_ws[l], gm_bs[l])
        b = _hgrn2_branch(q, f, i, og, lower_bounds[l], hg_norm_g[l])
        gate_a, gate_b = gates[..., :D_MODEL], gates[..., D_MODEL:]
        y = jax.nn.sigmoid(gate_a) * (a @ w_br_gm[l]) + jax.nn.sigmoid(gate_b) * (b @ w_br_hg[l])
        x = x + y @ w_out[l]
        h = _rmsnorm(x, ffn_norm[l])
        x = x + _conv_ffn(h, w_up[l], conv_w[l], conv_b[l], w_down[l])
    return _rmsnorm(x, final_norm)
```

```cpp
#include <hip/hip_runtime.h>
#include <hip/hip_cooperative_groups.h>
#include <cstdio>
#include <cstdint>
namespace cg = cooperative_groups;
namespace pg8 {
#define PG8_LAS __attribute__((address_space(3)))
typedef unsigned short bf16_t;
typedef short bf16x8 __attribute__((ext_vector_type(8)));
typedef float f32x4 __attribute__((ext_vector_type(4)));
typedef unsigned u32x4 __attribute__((ext_vector_type(4)));
constexpr int BM = 256, BK = 64, HALF = 128, HTB = HALF * BK * 2  , STAGE_BYTES = 8 * HTB, NXCD = 8, WGM = 8;

__host__ __device__ __forceinline__ int lds_byte(int r, int c) { const int st = (r >> 4) * 2 + (c >> 5), rr = r & 15, cc = c & 31, ob = rr * 64 + cc * 2; return st * 1024 + (ob ^ (((ob >> 9) & 1) << 5)); }
__host__ __device__ __forceinline__ void stage_rc(int b, int& R, int& C) { const int st = b / 1024, sb = b % 1024, swz = sb ^ (((sb >> 9) & 1) << 5); R = (st >> 1) * 16 + swz / 64; C = (st & 1) * 32 + (swz % 64) / 2; }
__host__ __device__ __forceinline__ int perm32(int rho) { const int n = rho >> 4, i = rho & 15; return 8 * (i >> 2) + 4 * n + (i & 3); }

struct Unit { int pm, pn; };
struct Gemm { const bf16_t* A; const bf16_t* Bt; int M, N, K; };

struct StaticOrder {
    int nM, nN, nwg, G, c;
    __host__ __device__ void init(int M, int N, int G_, int c_) { nM = M / BM; nN = N / BM; nwg = nM * nN; G = G_; c = c_; }
    __host__ __device__ bool next(int i, Unit& u) const {
        const long L = (long)i * G + c; if (L >= nwg) return false;
        int wgid = (int)L; { const int q = nwg / NXCD, r = nwg % NXCD, xcd = wgid % NXCD, off = wgid / NXCD; wgid = (xcd < r ? xcd * (q + 1) : r * (q + 1) + (xcd - r) * q) + off; }
        const int nig = WGM * nN, gid = wgid / nig, fm = gid * WGM, gsz = (nM - fm) < WGM ? (nM - fm) : WGM;
        u.pm = fm + ((wgid % nig) % gsz); u.pn = (wgid % nig) / gsz; return true;
    }
    __device__ __forceinline__ void a_ready(const Unit&) const {}
    __device__ __forceinline__ void done(const Unit&) const {}
};

__device__ __forceinline__ unsigned cvt_pk_bf16(float lo, float hi) { unsigned r; asm volatile("v_cvt_pk_bf16_f32 %0, %1, %2" : "=v"(r) : "v"(lo), "v"(hi)); return r; }
typedef float f32x2 __attribute__((ext_vector_type(2)));
__device__ __forceinline__ f32x2 gelu_pk(f32x2 v) {
    const f32x2 av = __builtin_elementwise_abs(v), d = av * 0.2316418882f + 1.0f;
    f32x2 t; t.x = __builtin_amdgcn_rcpf(d.x); t.y = __builtin_amdgcn_rcpf(d.y);
    f32x2 q = t * 0.5307027145f + (-0.7265760135f); q = q * t + 0.7107068705f; q = q * t + (-0.142248368f); q = q * t + 0.127414796f; q = q * t;
    const f32x2 s = (v * v) * (-0.72134752044f);
    f32x2 e; e.x = __builtin_amdgcn_exp2f(s.x); e.y = __builtin_amdgcn_exp2f(s.y);
    const f32x2 m = v * (q * e), r = v - m;
    f32x2 o; o.x = v.x < 0.f ? m.x : r.x; o.y = v.y < 0.f ? m.y : r.y; return o;
}

template <int ACT  > struct EpiBf16 {
    static constexpr bool PERM = true, AFTER_DRAIN = false; static_assert(ACT == 0 || ACT == 1, "EpiBf16: ACT is 0 (none) or 1 (gelu_pk)");
    bf16_t* O; int ldc; const float* bias; int split_cols; size_t split_stride; float scale0;
    __device__ __forceinline__ void operator()(const f32x4 (&acc)[2][2][4][2], const Unit& u, int wr, int wc, int fr, int fq) const {
        const int row0 = u.pm * BM + wr * 64 + fr; int colt = u.pn * BM; bf16_t* base = O;
        float sc = 1.f; if (split_cols) { const int t = colt / split_cols; base += (size_t)t * split_stride; colt -= t * split_cols; if (t == 0) sc = scale0; }
        const int col0 = colt + wc * 32 + 8 * fq, bcol0 = u.pn * BM + wc * 32 + 8 * fq;
        f32x4 bv[2][2];
#pragma unroll
        for (int bj = 0; bj < 2; ++bj)
#pragma unroll
            for (int n = 0; n < 2; ++n) bv[bj][n] = bias ? *(const f32x4*)(bias + bcol0 + bj * HALF + 4 * n) : (f32x4){0.f, 0.f, 0.f, 0.f};
#pragma unroll
        for (int ai = 0; ai < 2; ++ai)
#pragma unroll
            for (int m = 0; m < 4; ++m) { bf16_t* rowp = base + (size_t)(row0 + ai * HALF + m * 16) * ldc + col0;
#pragma unroll
                for (int bj = 0; bj < 2; ++bj) { f32x4 v0 = acc[ai][bj][m][0] + bv[bj][0], v1 = acc[ai][bj][m][1] + bv[bj][1];
                    if (ACT == 1) { f32x2 a = gelu_pk((f32x2){v0[0], v0[1]}), b = gelu_pk((f32x2){v0[2], v0[3]}), c = gelu_pk((f32x2){v1[0], v1[1]}), d = gelu_pk((f32x2){v1[2], v1[3]});
                        v0 = (f32x4){a.x, a.y, b.x, b.y}; v1 = (f32x4){c.x, c.y, d.x, d.y}; }
                    v0 = v0 * sc; v1 = v1 * sc; u32x4 w; w.x = cvt_pk_bf16(v0[0], v0[1]); w.y = cvt_pk_bf16(v0[2], v0[3]); w.z = cvt_pk_bf16(v1[0], v1[1]); w.w = cvt_pk_bf16(v1[2], v1[3]);
                    *(u32x4*)(rowp + bj * HALF) = w; } }
    }
};
template <class Epi, class Sched, bool ALIGN_EPI = false, bool SP2 = false>
__device__ __forceinline__ void gemm_phase(PG8_LAS unsigned char* lds, const Gemm g, const Sched& S, const Epi& E) {
    int tid_ = threadIdx.x; asm volatile("" : "+v"(tid_)); const int tid = tid_, wid = __builtin_amdgcn_readfirstlane(tid >> 6), lane = tid & 63, wr = wid >> 2, wc = wid & 3, fr = lane & 15, fq = lane >> 4;
    const int K = g.K, nt = K / BK;
    unsigned voffA[2], voffB[2];
#pragma unroll
    for (int i = 0; i < 2; ++i) { int R, C; stage_rc(tid * 16 + i * 8192, R, C); const int Rb = Epi::PERM ? ((R & ~31) + perm32(R & 31)) : R;
        voffA[i] = (unsigned)(R * K + C) * 2u; voffB[i] = (unsigned)(Rb * K + C) * 2u; }
    const size_t kstep = (size_t)(BK * 2);
    const size_t hstep = (size_t)HALF * K * 2;
    const size_t tstep = 2 * hstep;
    const unsigned ldsw = (unsigned)wid * 1024u;
    const int aoff = lds_byte(wr * 64 + fr, fq * 8), boff = lds_byte(wc * 32 + fr, fq * 8);
#define PG8_SA(b, h) (((b) * 2 + (h)) * HTB)
#define PG8_SB(b, h) ((4 + (b) * 2 + (h)) * HTB)
#define PG8_STAGE(bufoff, gbase, voff) do { _Pragma("unroll") for (int _i = 0; _i < 2; ++_i) \
        __builtin_amdgcn_global_load_lds((const unsigned*)((const char*)(gbase) + (voff)[_i]), (PG8_LAS unsigned*)(lds + (bufoff) + ldsw + _i * 8192), 16, 0, 0); } while (0)
#define PG8_LDA(dst, b, h) do { _Pragma("unroll") for (int m = 0; m < 4; ++m) _Pragma("unroll") for (int k = 0; k < 2; ++k) dst[m][k] = *(const PG8_LAS bf16x8*)(lds + PG8_SA(b, h) + aoff + m * 2048 + k * 1024); } while (0)
#define PG8_LDB(dst, b, h) do { _Pragma("unroll") for (int n = 0; n < 2; ++n) _Pragma("unroll") for (int k = 0; k < 2; ++k) dst[n][k] = *(const PG8_LAS bf16x8*)(lds + PG8_SB(b, h) + boff + n * 2048 + k * 1024); } while (0)
#define PG8_MMA(ai, bj, At, Bt) do { __builtin_amdgcn_s_setprio(1); _Pragma("unroll") for (int m = 0; m < 4; ++m) _Pragma("unroll") for (int n = 0; n < 2; ++n) _Pragma("unroll") for (int k = 0; k < 2; ++k) \
        acc[ai][bj][m][n] = __builtin_amdgcn_mfma_f32_16x16x32_bf16(Bt[n][k], At[m][k], acc[ai][bj][m][n], 0, 0, 0); __builtin_amdgcn_s_setprio(0); } while (0)
#define PG8_WAIT_V(n) asm volatile("s_waitcnt vmcnt(" #n ")" ::: "memory")
#define PG8_WAIT_L(n) asm volatile("s_waitcnt lgkmcnt(" #n ")" ::: "memory")
#define PG8_BAR __builtin_amdgcn_s_barrier()
#define PG8_SCHED __builtin_amdgcn_sched_barrier(0)
    Unit cur, nxt; int ui = 0;
    if (!S.next(0, cur)) return;
    f32x4 acc[2][2][4][2];
#pragma unroll
    for (int a = 0; a < 2; ++a)
#pragma unroll
        for (int b = 0; b < 2; ++b)
#pragma unroll
            for (int m = 0; m < 4; ++m)
#pragma unroll
                for (int n = 0; n < 2; ++n) acc[a][b][m][n] = (f32x4){0.f, 0.f, 0.f, 0.f};
    bf16x8 At[4][2], B0[2][2], B1[2][2];
    const char* cA = (const char*)g.A + (size_t)cur.pm * tstep; const char* cB = (const char*)g.Bt + (size_t)cur.pn * tstep;
    S.a_ready(cur);
    if constexpr (SP2) {
        PG8_STAGE(PG8_SB(0, 0), cB, voffB); PG8_STAGE(PG8_SB(0, 1), cB + hstep, voffB); PG8_STAGE(PG8_SA(0, 0), cA, voffA); PG8_STAGE(PG8_SA(0, 1), cA + hstep, voffA);
        if (wr == 1) PG8_BAR;
        PG8_WAIT_V(2); PG8_BAR;
        PG8_STAGE(PG8_SB(1, 0), cB + kstep, voffB); PG8_STAGE(PG8_SA(1, 0), cA + kstep, voffA); PG8_STAGE(PG8_SB(1, 1), cB + hstep + kstep, voffB);
        PG8_WAIT_V(6); PG8_BAR;
    } else {
        PG8_STAGE(PG8_SB(0, 0), cB, voffB); PG8_STAGE(PG8_SA(0, 0), cA, voffA); PG8_STAGE(PG8_SB(0, 1), cB + hstep, voffB); PG8_STAGE(PG8_SA(0, 1), cA + hstep, voffA);
        if (wr == 1) PG8_BAR;
        PG8_WAIT_V(4); PG8_BAR;
        PG8_STAGE(PG8_SB(1, 0), cB + kstep, voffB); PG8_STAGE(PG8_SA(1, 0), cA + kstep, voffA); PG8_STAGE(PG8_SB(1, 1), cB + hstep + kstep, voffB);
        PG8_WAIT_V(6); PG8_BAR;
    }
    for (;;) {
        const bool has_next = S.next(ui + 1, nxt);
        const char* nA = has_next ? (const char*)g.A + (size_t)nxt.pm * tstep : cA; const char* nB = has_next ? (const char*)g.Bt + (size_t)nxt.pn * tstep : cB;
        for (int t = 0; t < nt; t += 2) {
            const bool last = (t == nt - 2);
            const char* a1 = cA + (size_t)(t + 1) * kstep;
            const char* a2 = last ? nA : cA + (size_t)(t + 2) * kstep; const char* b2 = last ? nB : cB + (size_t)(t + 2) * kstep;
            const char* a3 = a2 + kstep; const char* b3 = b2 + kstep;
            if (last && has_next) S.a_ready(nxt);
            if constexpr (SP2) {
            PG8_LDB(B0, 0, 0); PG8_LDB(B1, 0, 1); PG8_SCHED; PG8_LDA(At, 0, 0); PG8_STAGE(PG8_SA(1, 1), a1 + hstep, voffA);
            PG8_WAIT_V(8); PG8_WAIT_L(0); PG8_BAR; PG8_MMA(0, 0, At, B0); PG8_MMA(0, 1, At, B1); PG8_BAR; PG8_SCHED;
            PG8_LDA(At, 0, 1); PG8_STAGE(PG8_SB(0, 0), b2, voffB); PG8_STAGE(PG8_SB(0, 1), b2 + hstep, voffB); PG8_STAGE(PG8_SA(0, 0), a2, voffA);
            PG8_WAIT_V(8); PG8_WAIT_L(0); PG8_BAR; PG8_MMA(1, 0, At, B0); PG8_MMA(1, 1, At, B1); PG8_BAR; PG8_SCHED;
            PG8_LDB(B0, 1, 0); PG8_LDB(B1, 1, 1); PG8_SCHED; PG8_LDA(At, 1, 0); PG8_STAGE(PG8_SA(0, 1), a2 + hstep, voffA);
            PG8_WAIT_V(8); PG8_WAIT_L(0); PG8_BAR; PG8_MMA(0, 0, At, B0); PG8_MMA(0, 1, At, B1); PG8_BAR; PG8_SCHED;
            PG8_LDA(At, 1, 1); PG8_STAGE(PG8_SB(1, 0), b3, voffB); PG8_STAGE(PG8_SB(1, 1), b3 + hstep, voffB); PG8_STAGE(PG8_SA(1, 0), a3, voffA);
            PG8_WAIT_V(8); PG8_WAIT_L(0); PG8_BAR; PG8_MMA(1, 0, At, B0); PG8_MMA(1, 1, At, B1); PG8_BAR; PG8_SCHED;
            } else {
            PG8_LDB(B0, 0, 0); PG8_SCHED; PG8_LDA(At, 0, 0); PG8_STAGE(PG8_SA(1, 1), a1 + hstep, voffA);
            PG8_WAIT_L(8); PG8_BAR; PG8_WAIT_L(0); PG8_MMA(0, 0, At, B0); PG8_BAR; PG8_SCHED;
            PG8_LDB(B1, 0, 1); PG8_STAGE(PG8_SB(0, 0), b2, voffB);
            PG8_BAR; PG8_WAIT_L(0); PG8_MMA(0, 1, At, B1); PG8_BAR;
            PG8_LDA(At, 0, 1); PG8_STAGE(PG8_SA(0, 0), a2, voffA);
            PG8_BAR; PG8_WAIT_L(0); PG8_MMA(1, 0, At, B0); PG8_BAR; PG8_SCHED;
            PG8_STAGE(PG8_SB(0, 1), b2 + hstep, voffB);
            PG8_WAIT_V(6); PG8_BAR; PG8_MMA(1, 1, At, B1); PG8_BAR;
            PG8_LDB(B0, 1, 0); PG8_SCHED; PG8_LDA(At, 1, 0); PG8_STAGE(PG8_SA(0, 1), a2 + hstep, voffA);
            PG8_WAIT_L(8); PG8_BAR; PG8_WAIT_L(0); PG8_MMA(0, 0, At, B0); PG8_BAR; PG8_SCHED;
            PG8_LDB(B1, 1, 1); PG8_STAGE(PG8_SB(1, 0), b3, voffB);
            PG8_BAR; PG8_WAIT_L(0); PG8_MMA(0, 1, At, B1); PG8_BAR;
            PG8_LDA(At, 1, 1); PG8_STAGE(PG8_SA(1, 0), a3, voffA);
            PG8_BAR; PG8_WAIT_L(0); PG8_MMA(1, 0, At, B0); PG8_BAR; PG8_SCHED;
            PG8_STAGE(PG8_SB(1, 1), b3 + hstep, voffB);
            PG8_WAIT_V(6); PG8_BAR; PG8_MMA(1, 1, At, B1); PG8_BAR;
            }
        }
        if constexpr (ALIGN_EPI) { if (wr == 0) PG8_BAR; }
        if constexpr (!Epi::AFTER_DRAIN) { E(acc, cur, wr, wc, fr, fq); S.done(cur); }
        if (!has_next) break;
#pragma unroll
        for (int a = 0; a < 2; ++a)
#pragma unroll
            for (int b = 0; b < 2; ++b)
#pragma unroll
                for (int m = 0; m < 4; ++m)
#pragma unroll
                    for (int n = 0; n < 2; ++n) acc[a][b][m][n] = (f32x4){0.f, 0.f, 0.f, 0.f};
        cur = nxt; cA = nA; cB = nB; ++ui;
        if constexpr (ALIGN_EPI) { if (wr == 1) PG8_BAR; }
    }
    PG8_WAIT_V(0);
    if constexpr (!ALIGN_EPI) { if (wr == 0) PG8_BAR; }
    PG8_BAR;
    if constexpr (Epi::AFTER_DRAIN) { E.fused(acc, cur, wr, wc, fr, fq, lds, wid, lane); S.done(cur); }
#undef PG8_SA
#undef PG8_SB
#undef PG8_STAGE
#undef PG8_LDA
#undef PG8_LDB
#undef PG8_MMA
#undef PG8_WAIT_V
#undef PG8_WAIT_L
#undef PG8_BAR
#undef PG8_SCHED
}
}
#define LAS __attribute__((address_space(3)))
__device__ __forceinline__ int opaque_tid() { int t = threadIdx.x; asm volatile("" : "+v"(t)); return t; }
using pg8::bf16_t; using pg8::bf16x8; using pg8::f32x4; using pg8::u32x4; using pg8::Unit;
typedef float f32x2 __attribute__((ext_vector_type(2)));
typedef unsigned u32x2 __attribute__((ext_vector_type(2)));

constexpr int NB = 2, SEQ = 8192, M = NB * SEQ, D = 1024, DEPTH = 4, INC = 5120, DFF = 2816, NUP = 2 * DFF;
constexpr float EPS = 1e-6f, LOG2E = 1.4426950408889634f;
constexpr size_t MiB = 1u << 20;
constexpr size_t WS_LB = 1 * MiB, WS_SSQ = 2 * MiB, WS_DEC = 3 * MiB;
constexpr size_t WS_WIN = 4 * MiB, WS_WGM = 14 * MiB, WS_WHG = 15 * MiB, WS_WOUT = 16 * MiB, WS_WUP = 18 * MiB, WS_WDN = 29 * MiB;
constexpr size_t WS_XN = 36 * MiB, WS_ACT0 = 68 * MiB;
constexpr size_t WS_U = WS_ACT0, WS_V = WS_U + 16 * MiB, WS_Q = WS_V + 16 * MiB, WS_KK = WS_Q + 16 * MiB, WS_GL = WS_KK + 16 * MiB, WS_I = WS_GL + 32 * MiB,
                 WS_OG = WS_I + 16 * MiB, WS_GT = WS_OG + 16 * MiB, WS_ST = WS_GT + 64 * MiB, WS_END1 = WS_ST + 64 * MiB;
constexpr size_t WS_Y = WS_Q;
constexpr size_t WS_Z = WS_ACT0, WS_AC = WS_Z + 176 * MiB, WS_END2 = WS_AC + 88 * MiB;
constexpr size_t WS_NEED = WS_END1 > WS_END2 ? WS_END1 : WS_END2;
constexpr int LDS_BYTES = 147456;

struct Args {
    const float *x, *mix_norm, *w_in, *gm_ln_g, *gm_ln_b, *gm_ws, *gm_bs, *hg_lb, *hg_norm_g, *w_br_gm, *w_br_hg, *w_out, *ffn_norm, *w_up, *conv_w, *conv_b, *w_down, *final_norm;
    float* out; unsigned char* ws;
};

__device__ __forceinline__ float bf2f(unsigned h) { return __uint_as_float(h << 16); }
__device__ __forceinline__ unsigned f2bf(float f) { unsigned u = __float_as_uint(f); return (u + 0x7fffu + ((u >> 16) & 1u)) >> 16; }
__device__ __forceinline__ unsigned pk2(float lo, float hi) { return pg8::cvt_pk_bf16(lo, hi); }
__device__ __forceinline__ float fexp2(float x) { return __builtin_amdgcn_exp2f(x); }
__device__ __forceinline__ float frcp(float x) { return __builtin_amdgcn_rcpf(x); }
__device__ __forceinline__ float sigm(float x) { return frcp(1.f + fexp2(-LOG2E * x)); }
__device__ __forceinline__ float silu(float x) { return x * sigm(x); }
__device__ __forceinline__ float wave_sum(float v) {
#pragma unroll
    for (int o = 1; o < 64; o <<= 1) v += __shfl_xor(v, o);
    return v;
}
__device__ __forceinline__ void unpack8(const u32x4 r, float (&x)[8]) {
    x[0] = bf2f(r.x & 0xffffu); x[1] = bf2f(r.x >> 16); x[2] = bf2f(r.y & 0xffffu); x[3] = bf2f(r.y >> 16);
    x[4] = bf2f(r.z & 0xffffu); x[5] = bf2f(r.z >> 16); x[6] = bf2f(r.w & 0xffffu); x[7] = bf2f(r.w >> 16);
}
__device__ __forceinline__ float rowscale(const float* ssq, int row) {
    const f32x4* p = (const f32x4*)(ssq + (size_t)row * 16); const f32x4 s = (p[0] + p[1]) + (p[2] + p[3]);
    return rsqrtf(((s.x + s.y) + (s.z + s.w)) * (1.f / 1024.f) + EPS);
}

struct EpiIn {
    static constexpr bool PERM = true, AFTER_DRAIN = false;
    bf16_t *U, *V, *Q, *KK, *I, *OG, *GT; float* GL; const float* ssq; const float* lb;
    template <int SEG> __device__ __forceinline__ void body(const f32x4 (&acc)[2][2][4][2], const Unit& u, int wr, int wc, int fr, int fq) const {
        const int row0 = u.pm * 256 + wr * 64 + fr, pn = u.pn;
        bf16_t* base; int ldc, colt;
        if (SEG == 6) { base = GT; ldc = 2048; colt = (pn - 12) * 256; }
        else { ldc = 512; colt = (pn & 1) * 256; base = SEG == 0 ? U : SEG == 1 ? V : SEG == 2 ? Q : SEG == 3 ? KK : SEG == 4 ? I : OG; }
        const int col0 = colt + wc * 32 + 8 * fq;
#pragma unroll
        for (int ai = 0; ai < 2; ++ai)
#pragma unroll
            for (int m = 0; m < 4; ++m) {
                const int row = row0 + ai * 128 + m * 16; const float r = rowscale(ssq, row);
#pragma unroll
                for (int bj = 0; bj < 2; ++bj) {
                    const int c = col0 + bj * 128;
                    f32x4 v0 = acc[ai][bj][m][0] * r, v1 = acc[ai][bj][m][1] * r;
                    float o[8] = {v0[0], v0[1], v0[2], v0[3], v1[0], v1[1], v1[2], v1[3]};
                    if (SEG == 0 || SEG == 1) {
#pragma unroll
                        for (int e = 0; e < 8; e += 2) { f32x2 g = pg8::gelu_pk((f32x2){o[e], o[e + 1]}); o[e] = g.x; o[e + 1] = g.y; }
                    } else if (SEG == 2 || SEG == 5) {
#pragma unroll
                        for (int e = 0; e < 8; ++e) o[e] = silu(o[e]);
                    } else if (SEG == 6) {
#pragma unroll
                        for (int e = 0; e < 8; ++e) o[e] = sigm(o[e]);
                    } else if (SEG == 3) {
                        const f32x4 l0 = *(const f32x4*)(lb + c), l1 = *(const f32x4*)(lb + c + 4);
                        const float lbv[8] = {l0[0], l0[1], l0[2], l0[3], l1[0], l1[1], l1[2], l1[3]};
                        float g2[8];
#pragma unroll
                        for (int e = 0; e < 8; ++e) {
                            const float f = fminf(fmaxf(o[e], -80.f), 80.f);
                            const float ex = fexp2(-LOG2E * f), sg = frcp(1.f + ex);
                            const float fg = lbv[e] + (1.f - lbv[e]) * sg;
                            g2[e] = __builtin_amdgcn_logf(fmaxf(fg, 1e-30f));
                            o[e] = (1.f - lbv[e]) * (ex * sg);
                        }
                        float* gp = GL + (size_t)row * 512 + c;
                        *(f32x4*)gp = (f32x4){g2[0], g2[1], g2[2], g2[3]}; *(f32x4*)(gp + 4) = (f32x4){g2[4], g2[5], g2[6], g2[7]};
                    }
                    u32x4 w; w.x = pk2(o[0], o[1]); w.y = pk2(o[2], o[3]); w.z = pk2(o[4], o[5]); w.w = pk2(o[6], o[7]);
                    *(u32x4*)(base + (size_t)row * ldc + c) = w;
                }
                asm volatile("" ::: "memory");
            }
    }
    __device__ __forceinline__ void operator()(const f32x4 (&acc)[2][2][4][2], const Unit& u, int wr, int wc, int fr, int fq) const {
        const int seg = u.pn < 12 ? (u.pn >> 1) : 6;
        switch (seg) {
            case 0: body<0>(acc, u, wr, wc, fr, fq); break;
            case 1: body<1>(acc, u, wr, wc, fr, fq); break;
            case 2: body<2>(acc, u, wr, wc, fr, fq); break;
            case 3: body<3>(acc, u, wr, wc, fr, fq); break;
            case 4: body<4>(acc, u, wr, wc, fr, fq); break;
            case 5: body<5>(acc, u, wr, wc, fr, fq); break;
            default: body<6>(acc, u, wr, wc, fr, fq); break;
        }
    }
};
template <bool ADD> struct EpiBr {
    static constexpr bool PERM = true, AFTER_DRAIN = false;
    bf16_t* Y; const bf16_t* GT; int goff;
    __device__ __forceinline__ void operator()(const f32x4 (&acc)[2][2][4][2], const Unit& u, int wr, int wc, int fr, int fq) const {
        const int row0 = u.pm * 256 + wr * 64 + fr, col0 = u.pn * 256 + wc * 32 + 8 * fq;
#pragma unroll
        for (int ai = 0; ai < 2; ++ai)
#pragma unroll
            for (int m = 0; m < 4; ++m) {
                const int row = row0 + ai * 128 + m * 16;
#pragma unroll
                for (int bj = 0; bj < 2; ++bj) {
                    const int c = col0 + bj * 128;
                    float g[8]; unpack8(*(const u32x4*)(GT + (size_t)row * 2048 + goff + c), g);
                    const f32x4 v0 = acc[ai][bj][m][0], v1 = acc[ai][bj][m][1];
                    float o[8] = {v0[0] * g[0], v0[1] * g[1], v0[2] * g[2], v0[3] * g[3], v1[0] * g[4], v1[1] * g[5], v1[2] * g[6], v1[3] * g[7]};
                    bf16_t* yp = Y + (size_t)row * 1024 + c;
                    if (ADD) { float y[8]; unpack8(*(const u32x4*)yp, y);
#pragma unroll
                        for (int e = 0; e < 8; ++e) o[e] += y[e]; }
                    u32x4 w; w.x = pk2(o[0], o[1]); w.y = pk2(o[2], o[3]); w.z = pk2(o[4], o[5]); w.w = pk2(o[6], o[7]);
                    *(u32x4*)yp = w;
                }
                asm volatile("" ::: "memory");
            }
    }
};
struct EpiRes {
    static constexpr bool PERM = false, AFTER_DRAIN = false;
    float* x; bf16_t* xn; const float* g; float* ssq;
    __device__ __forceinline__ void operator()(const f32x4 (&acc)[2][2][4][2], const Unit& u, int wr, int wc, int fr, int fq) const {
        const int row0 = u.pm * 256 + wr * 64 + fr, col0 = u.pn * 256 + wc * 32 + 4 * fq;
#pragma unroll
        for (int ai = 0; ai < 2; ++ai)
#pragma unroll
            for (int m = 0; m < 4; ++m) {
                const int row = row0 + ai * 128 + m * 16; float ss = 0.f;
#pragma unroll
                for (int bj = 0; bj < 2; ++bj)
#pragma unroll
                    for (int n = 0; n < 2; ++n) {
                        const int c = col0 + bj * 128 + n * 16;
                        float* xp = x + (size_t)row * 1024 + c;
                        f32x4 xo = *(const f32x4*)xp; xo = xo + acc[ai][bj][m][n]; *(f32x4*)xp = xo;
                        ss += (xo[0] * xo[0] + xo[1] * xo[1]) + (xo[2] * xo[2] + xo[3] * xo[3]);
                        const f32x4 gv = *(const f32x4*)(g + c);
                        u32x2 w; w.x = pk2(xo[0] * gv[0], xo[1] * gv[1]); w.y = pk2(xo[2] * gv[2], xo[3] * gv[3]);
                        *(u32x2*)(xn + (size_t)row * 1024 + c) = w;
                    }
                ss += __shfl_xor(ss, 16); ss += __shfl_xor(ss, 32);
                if (fq == 0) ssq[(size_t)row * 16 + u.pn * 4 + wc] = ss;
                asm volatile("" ::: "memory");
            }
    }
};
struct EpiZ {
    static constexpr bool PERM = true, AFTER_DRAIN = false;
    bf16_t* Z; const float* ssq;
    __device__ __forceinline__ void operator()(const f32x4 (&acc)[2][2][4][2], const Unit& u, int wr, int wc, int fr, int fq) const {
        const int row0 = u.pm * 256 + wr * 64 + fr, col0 = u.pn * 256 + wc * 32 + 8 * fq;
#pragma unroll
        for (int ai = 0; ai < 2; ++ai)
#pragma unroll
            for (int m = 0; m < 4; ++m) {
                const int row = row0 + ai * 128 + m * 16; const float r = rowscale(ssq, row);
#pragma unroll
                for (int bj = 0; bj < 2; ++bj) {
                    const f32x4 v0 = acc[ai][bj][m][0] * r, v1 = acc[ai][bj][m][1] * r;
                    u32x4 w; w.x = pk2(v0[0], v0[1]); w.y = pk2(v0[2], v0[3]); w.z = pk2(v1[0], v1[1]); w.w = pk2(v1[2], v1[3]);
                    *(u32x4*)(Z + (size_t)row * NUP + col0 + bj * 128) = w;
                }
                asm volatile("" ::: "memory");
            }
    }
};

__device__ __forceinline__ void transpose_item(const float* W, int K, int N, bf16_t* WT, LAS float* scr, int item, int lane) {
    const int nblk = N / 32, kb = item / nblk, nb = item % nblk, k0 = 64 * kb, n0 = 32 * nb;
#pragma unroll 8
    for (int i = 0; i < 32; ++i) { const int kk = 2 * i + (lane >> 5); scr[kk * 33 + (lane & 31)] = W[(size_t)(k0 + kk) * N + n0 + (lane & 31)]; }
    asm volatile("s_waitcnt lgkmcnt(0)" ::: "memory");
    const int c = lane & 7;
#pragma unroll
    for (int j = 0; j < 4; ++j) { const int n = (lane >> 3) + 8 * j; const LAS float* s = scr + (8 * c) * 33 + n;
        u32x4 o; o.x = pk2(s[0 * 33], s[1 * 33]); o.y = pk2(s[2 * 33], s[3 * 33]); o.z = pk2(s[4 * 33], s[5 * 33]); o.w = pk2(s[6 * 33], s[7 * 33]);
        *(u32x4*)(WT + (size_t)(n0 + n) * K + k0 + 8 * c) = o; }
    asm volatile("s_waitcnt lgkmcnt(0)" ::: "memory");
}
__device__ __forceinline__ void convert_set(const Args& a, LAS unsigned char* lds, int set, int l) {
    const int tid = opaque_tid(), lane = tid & 63, wave = tid >> 6;
    LAS float* scr = (LAS float*)(lds + wave * 16384);
    const int gw = blockIdx.x * 8 + wave, NGW = gridDim.x * 8;
    unsigned char* ws = a.ws;
    if (set == 0) {
        constexpr int I0 = (D / 64) * (INC / 32), I1 = (512 / 64) * (D / 32), I3 = (D / 64) * (D / 32), NI = I0 + 2 * I1 + I3;
        for (int it = gw; it < NI; it += NGW) {
            int r = it;
            if (r < I0) { transpose_item(a.w_in + (size_t)l * D * INC, D, INC, (bf16_t*)(ws + WS_WIN), scr, r, lane); continue; } r -= I0;
            if (r < I1) { transpose_item(a.w_br_gm + (size_t)l * 512 * D, 512, D, (bf16_t*)(ws + WS_WGM), scr, r, lane); continue; } r -= I1;
            if (r < I1) { transpose_item(a.w_br_hg + (size_t)l * 512 * D, 512, D, (bf16_t*)(ws + WS_WHG), scr, r, lane); continue; } r -= I1;
            transpose_item(a.w_out + (size_t)l * D * D, D, D, (bf16_t*)(ws + WS_WOUT), scr, r, lane);
        }
    } else {
        constexpr int I0 = (D / 64) * (NUP / 32), I1 = (DFF / 64) * (D / 32), NI = I0 + I1;
        for (int it = gw; it < NI; it += NGW) {
            int r = it;
            if (r < I0) { transpose_item(a.w_up + (size_t)l * D * NUP, D, NUP, (bf16_t*)(ws + WS_WUP), scr, r, lane); continue; } r -= I0;
            transpose_item(a.w_down + (size_t)l * DFF * D, DFF, D, (bf16_t*)(ws + WS_WDN), scr, r, lane);
        }
    }
}

constexpr int LDQ = 136, LDV = 72, LDG = 132;
__device__ __forceinline__ bf16x8 ldfrag(const LAS bf16_t* base, int ld, int fr, int fq, int k0) { return *(const LAS bf16x8*)(base + fr * ld + k0 + fq * 8); }
#define MMA16(xf, yf, acc) __builtin_amdgcn_mfma_f32_16x16x32_bf16((xf), (yf), (acc), 0, 0, 0)

__device__ __forceinline__ void gmlp_unit(const Args& a, LAS unsigned char* lds, int unit, int l) {
    const int tid = opaque_tid(), lane = tid & 63, w = tid >> 6, fr = lane & 15, fq = lane >> 4;
    const int h = unit & 3, blk = (unit >> 2) & 63, b = unit >> 8;
    const size_t r0 = (size_t)b * SEQ + (size_t)blk * 128;
    LAS bf16_t* Vt = (LAS bf16_t*)lds;
    LAS bf16_t* Wl = Vt + 128 * LDQ;
    const bf16_t* Vg = (const bf16_t*)(a.ws + WS_V); bf16_t* Ug = (bf16_t*)(a.ws + WS_U);
    const float* lng = a.gm_ln_g + l * 512; const float* lnb = a.gm_ln_b + l * 512;
    for (int rr = 0; rr < 16; ++rr) {
        const int j = w * 16 + rr;
        float x[8]; unpack8(*(const u32x4*)(Vg + (r0 + j) * 512 + lane * 8), x);
        float s = ((x[0] + x[1]) + (x[2] + x[3])) + ((x[4] + x[5]) + (x[6] + x[7]));
        const float mean = wave_sum(s) * (1.f / 512.f);
        float q = 0.f;
#pragma unroll
        for (int e = 0; e < 8; ++e) { x[e] -= mean; q += x[e] * x[e]; }
        const float rstd = rsqrtf(wave_sum(q) * (1.f / 512.f) + EPS);
        if ((lane >> 4) == h) {
            const int d0 = (lane & 15) * 8, cg0 = h * 128 + d0;
#pragma unroll
            for (int e = 0; e < 8; ++e) Vt[(d0 + e) * LDQ + j] = (bf16_t)f2bf(x[e] * rstd * lng[cg0 + e] + lnb[cg0 + e]);
        }
    }
    const float* wsrc = a.gm_ws + (size_t)(l * 4 + h) * 16384;
#pragma unroll
    for (int it = 0; it < 8; ++it) {
        const int idx = it * 512 + tid, i = idx >> 5, j4 = (idx & 31) * 4;
        f32x4 wv = *(const f32x4*)(wsrc + i * 128 + j4);
        if ((i >> 6) < (j4 >> 6)) wv = (f32x4){0.f, 0.f, 0.f, 0.f};
        u32x2 o; o.x = pk2(wv[0], wv[1]); o.y = pk2(wv[2], wv[3]);
        *(LAS u32x2*)(Wl + i * LDQ + j4) = o;
    }
    __syncthreads();
    bf16x8 af[4];
#pragma unroll
    for (int ks = 0; ks < 4; ++ks) af[ks] = ldfrag(Wl + (w * 16) * LDQ, LDQ, fr, fq, ks * 32);
    const int i = w * 16 + fr; const float bias = a.gm_bs[(l * 4 + h) * 128 + i];
#pragma unroll
    for (int dt = 0; dt < 8; ++dt) {
        f32x4 acc = {0.f, 0.f, 0.f, 0.f};
#pragma unroll
        for (int ks = 0; ks < 4; ++ks) acc = MMA16(ldfrag(Vt + (dt * 16) * LDQ, LDQ, fr, fq, ks * 32), af[ks], acc);
        bf16_t* up = Ug + (r0 + i) * 512 + h * 128 + dt * 16 + 4 * fq;
        const u32x2 uu = *(const u32x2*)up;
        u32x2 o; o.x = pk2(bf2f(uu.x & 0xffffu) * (acc[0] + bias), bf2f(uu.x >> 16) * (acc[1] + bias));
        o.y = pk2(bf2f(uu.y & 0xffffu) * (acc[2] + bias), bf2f(uu.y >> 16) * (acc[3] + bias));
        *(u32x2*)up = o;
    }
    __syncthreads();
}

__device__ __forceinline__ void hg1_unit(const Args& a, LAS unsigned char* lds, int unit) {
    const int tid = opaque_tid(), lane = tid & 63, w = tid >> 6, fr = lane & 15, fq = lane >> 4;
    const int c = unit & 127, bh = unit >> 7, h = bh & 3, b = bh >> 2;
    const size_t r0 = (size_t)b * SEQ + (size_t)c * 64;
    LAS float* Gs = (LAS float*)lds;
    LAS float* Tot = Gs + 64 * LDG;
    LAS bf16_t* Vt = (LAS bf16_t*)(lds + 64 * LDG * 4 + 2048);
    LAS bf16_t* Kt = Vt + 128 * LDV;
    float* GLg = (float*)(a.ws + WS_GL); const bf16_t* Ig = (const bf16_t*)(a.ws + WS_I); const bf16_t* Kg = (const bf16_t*)(a.ws + WS_KK);
    const int d = tid & 127, sg = tid >> 7;
    float* gp = GLg + (r0 + sg * 16) * 512 + h * 128 + d;
    float g[16];
#pragma unroll
    for (int j = 0; j < 16; ++j) g[j] = gp[(size_t)j * 512];
#pragma unroll
    for (int j = 1; j < 16; ++j) g[j] += g[j - 1];
    Tot[sg * 128 + d] = g[15];
#pragma unroll
    for (int it = 0; it < 2; ++it) {
        const int idx = it * 512 + tid, j = idx >> 4, e0 = (idx & 15) * 8;
        const u32x4 raw = *(const u32x4*)(Ig + (r0 + j) * 512 + h * 128 + e0);
        const unsigned rw[4] = {raw.x, raw.y, raw.z, raw.w};
#pragma unroll
        for (int e = 0; e < 8; ++e) Vt[(e0 + e) * LDV + j] = (bf16_t)((rw[e >> 1] >> ((e & 1) * 16)) & 0xffffu);
    }
    __syncthreads();
    float off = 0.f;
#pragma unroll
    for (int s = 0; s < 3; ++s) off += (s < sg) ? Tot[s * 128 + d] : 0.f;
#pragma unroll
    for (int j = 0; j < 16; ++j) { g[j] += off; gp[(size_t)j * 512] = g[j]; Gs[(sg * 16 + j) * LDG + d] = g[j]; }
    __syncthreads();
#pragma unroll
    for (int it = 0; it < 2; ++it) {
        const int idx = it * 512 + tid, j = idx >> 4, d0 = (idx & 15) * 8;
        float kv[8]; unpack8(*(const u32x4*)(Kg + (r0 + j) * 512 + h * 128 + d0), kv);
#pragma unroll
        for (int e = 0; e < 8; ++e) Kt[(d0 + e) * LDV + j] = (bf16_t)f2bf(kv[e] * fexp2(Gs[63 * LDG + d0 + e] - Gs[j * LDG + d0 + e]));
    }
    if (tid < 128) ((float*)(a.ws + WS_DEC))[(size_t)unit * 128 + tid] = fexp2(Gs[63 * LDG + tid]);
    __syncthreads();
    bf16x8 af[2];
#pragma unroll
    for (int ks = 0; ks < 2; ++ks) af[ks] = ldfrag(Vt + (w * 16) * LDV, LDV, fr, fq, ks * 32);
    float* STg = (float*)(a.ws + WS_ST) + (size_t)unit * 16384;
#pragma unroll
    for (int dt = 0; dt < 8; ++dt) {
        f32x4 acc = {0.f, 0.f, 0.f, 0.f};
#pragma unroll
        for (int ks = 0; ks < 2; ++ks) acc = MMA16(ldfrag(Kt + (dt * 16) * LDV, LDV, fr, fq, ks * 32), af[ks], acc);
        *(f32x4*)(STg + (w * 16 + fr) * 128 + dt * 16 + 4 * fq) = acc;
    }
    __syncthreads();
}

__device__ __forceinline__ void hg_scan(const Args& a) {
    float* ST = (float*)(a.ws + WS_ST); const float* DEC = (const float*)(a.ws + WS_DEC);
    for (int idx = blockIdx.x * 512 + opaque_tid(); idx < 8 * 16384; idx += gridDim.x * 512) {
        const int bh = idx >> 14, ed = idx & 16383, d = ed & 127;
        float* p = ST + (size_t)bh * 128 * 16384 + ed; const float* dc = DEC + (size_t)bh * 128 * 128 + d;
        float S = 0.f;
#pragma unroll 8
        for (int c = 0; c < 128; ++c) { const float u = p[(size_t)c * 16384]; const float dec = dc[c * 128]; p[(size_t)c * 16384] = S; S = dec * S + u; }
    }
}

__device__ __forceinline__ void hg3_unit(const Args& a, LAS unsigned char* lds, int unit, int l) {
    const int tid = opaque_tid(), lane = tid & 63, w = tid >> 6, fr = lane & 15, fq = lane >> 4;
    const int c = unit & 127, bh = unit >> 7, h = bh & 3, b = bh >> 2;
    const size_t r0 = (size_t)b * SEQ + (size_t)c * 64;
    LAS float* Gs = (LAS float*)lds;
    LAS bf16_t* Qs = (LAS bf16_t*)(lds + 64 * LDG * 4);
    LAS bf16_t* Ks = Qs + 64 * LDQ;
    LAS bf16_t* Vt = Ks + 64 * LDQ;
    LAS bf16_t* As = Vt + 128 * LDV;
    LAS bf16_t* Sts = As + 64 * LDV;
    const float* GLg = (const float*)(a.ws + WS_GL); const bf16_t* Ig = (const bf16_t*)(a.ws + WS_I);
    const bf16_t* Qg = (const bf16_t*)(a.ws + WS_Q); const bf16_t* Kg = (const bf16_t*)(a.ws + WS_KK);
    const float* STg = (const float*)(a.ws + WS_ST) + (size_t)unit * 16384;
#pragma unroll
    for (int it = 0; it < 4; ++it) {
        const int idx = it * 512 + tid, j = idx >> 5, d4 = (idx & 31) * 4;
        *(LAS f32x4*)(Gs + j * LDG + d4) = *(const f32x4*)(GLg + (r0 + j) * 512 + h * 128 + d4);
    }
#pragma unroll
    for (int it = 0; it < 2; ++it) {
        const int idx = it * 512 + tid, j = idx >> 4, d0 = (idx & 15) * 8;
        *(LAS u32x4*)(Qs + j * LDQ + d0) = *(const u32x4*)(Qg + (r0 + j) * 512 + h * 128 + d0);
        *(LAS u32x4*)(Ks + j * LDQ + d0) = *(const u32x4*)(Kg + (r0 + j) * 512 + h * 128 + d0);
        const u32x4 raw = *(const u32x4*)(Ig + (r0 + j) * 512 + h * 128 + d0);
        const unsigned rw[4] = {raw.x, raw.y, raw.z, raw.w};
#pragma unroll
        for (int e = 0; e < 8; ++e) Vt[(d0 + e) * LDV + j] = (bf16_t)((rw[e >> 1] >> ((e & 1) * 16)) & 0xffffu);
    }
#pragma unroll
    for (int it = 0; it < 8; ++it) {
        const int idx = it * 512 + tid, e = idx >> 5, d4 = (idx & 31) * 4;
        const f32x4 s = *(const f32x4*)(STg + e * 128 + d4);
        u32x2 o; o.x = pk2(s[0], s[1]); o.y = pk2(s[2], s[3]);
        *(LAS u32x2*)(Sts + e * LDQ + d4) = o;
    }
    __syncthreads();
    {
        const int il = lane >> 4, jg = lane & 15;
#pragma unroll 1
        for (int gi = 0; gi < 2; ++gi) {
            const int g = gi ? 15 - w : w, i = 4 * g + il, nj = ((4 * g + 3) >> 4) + 1;
            float ac[4] = {0.f, 0.f, 0.f, 0.f};
#pragma unroll 2
            for (int d0 = 0; d0 < 128; d0 += 8) {
                float qv[8]; unpack8(*(const LAS u32x4*)(Qs + i * LDQ + d0), qv);
                const f32x4 gi0 = *(const LAS f32x4*)(Gs + i * LDG + d0), gi1 = *(const LAS f32x4*)(Gs + i * LDG + d0 + 4);
                const float giv[8] = {gi0[0], gi0[1], gi0[2], gi0[3], gi1[0], gi1[1], gi1[2], gi1[3]};
#pragma unroll
                for (int jj = 0; jj < 4; ++jj) {
                    if (jj < nj) {
                        const int j = jj * 16 + jg;
                        float kv[8]; unpack8(*(const LAS u32x4*)(Ks + j * LDQ + d0), kv);
                        const f32x4 gj0 = *(const LAS f32x4*)(Gs + j * LDG + d0), gj1 = *(const LAS f32x4*)(Gs + j * LDG + d0 + 4);
                        const float gjv[8] = {gj0[0], gj0[1], gj0[2], gj0[3], gj1[0], gj1[1], gj1[2], gj1[3]};
#pragma unroll
                        for (int e = 0; e < 8; ++e) ac[jj] += (qv[e] * kv[e]) * fexp2(fminf(giv[e] - gjv[e], 0.f));
                    }
                }
            }
#pragma unroll
            for (int jj = 0; jj < 4; ++jj) { const int j = jj * 16 + jg; As[i * LDV + j] = (bf16_t)f2bf((jj < nj && j <= i) ? ac[jj] : 0.f); }
        }
    }
    __syncthreads();
#pragma unroll
    for (int it = 0; it < 2; ++it) {
        const int idx = it * 512 + tid, j = idx >> 4, d0 = (idx & 15) * 8;
        float qv[8]; unpack8(*(const LAS u32x4*)(Qs + j * LDQ + d0), qv);
        const f32x4 g0 = *(const LAS f32x4*)(Gs + j * LDG + d0), g1 = *(const LAS f32x4*)(Gs + j * LDG + d0 + 4);
        u32x4 o; o.x = pk2(qv[0] * fexp2(g0[0]), qv[1] * fexp2(g0[1])); o.y = pk2(qv[2] * fexp2(g0[2]), qv[3] * fexp2(g0[3]));
        o.z = pk2(qv[4] * fexp2(g1[0]), qv[5] * fexp2(g1[1])); o.w = pk2(qv[6] * fexp2(g1[2]), qv[7] * fexp2(g1[3]));
        *(LAS u32x4*)(Qs + j * LDQ + d0) = o;
    }
    __syncthreads();
    {
        const int it = w & 3, eb = (w >> 2) * 4;
        bf16x8 af[2], qf[4];
#pragma unroll
        for (int ks = 0; ks < 2; ++ks) af[ks] = ldfrag(As + (it * 16) * LDV, LDV, fr, fq, ks * 32);
#pragma unroll
        for (int ks = 0; ks < 4; ++ks) qf[ks] = ldfrag(Qs + (it * 16) * LDQ, LDQ, fr, fq, ks * 32);
#pragma unroll
        for (int t = 0; t < 4; ++t) {
            const int et = eb + t; f32x4 acc = {0.f, 0.f, 0.f, 0.f};
#pragma unroll
            for (int ks = 0; ks < 2; ++ks) acc = MMA16(ldfrag(Vt + (et * 16) * LDV, LDV, fr, fq, ks * 32), af[ks], acc);
#pragma unroll
            for (int ks = 0; ks < 4; ++ks) acc = MMA16(ldfrag(Sts + (et * 16) * LDQ, LDQ, fr, fq, ks * 32), qf[ks], acc);
            *(LAS f32x4*)(Gs + (it * 16 + fr) * LDG + et * 16 + 4 * fq) = acc;
        }
    }
    __syncthreads();
    {
        bf16_t* OGg = (bf16_t*)(a.ws + WS_OG);
        const f32x2 ng = *(const f32x2*)(a.hg_norm_g + l * 128 + 2 * lane);
#pragma unroll
        for (int rr = 0; rr < 8; ++rr) {
            const int i = w * 8 + rr;
            const f32x2 o = *(const LAS f32x2*)(Gs + i * LDG + 2 * lane);
            const float r = rsqrtf(wave_sum(o.x * o.x + o.y * o.y) * (1.f / 128.f) + EPS);
            unsigned* op = (unsigned*)(OGg + (r0 + i) * 512 + h * 128 + 2 * lane);
            const unsigned og = *op;
            *op = pk2(o.x * r * ng.x * bf2f(og & 0xffffu), o.y * r * ng.y * bf2f(og >> 16));
        }
    }
    __syncthreads();
}

__device__ __forceinline__ void conv_act(const Args& a, int l) {
    const bf16_t* Z = (const bf16_t*)(a.ws + WS_Z); bf16_t* AC = (bf16_t*)(a.ws + WS_AC);
    const float* cw = a.conv_w + (size_t)l * 3 * NUP; const float* cb = a.conv_b + (size_t)l * NUP;
    constexpr int CCH = DFF / 8, NITEM = (M / 8) * CCH;
    for (int item = blockIdx.x * 512 + opaque_tid(); item < NITEM; item += gridDim.x * 512) {
        const int cc = item % CCH, rb = item / CCH, c = cc * 8, m0 = rb * 8, t0 = m0 & (SEQ - 1);
        float wg[3][8], wv[3][8], bg[8], bv[8];
#pragma unroll
        for (int t = 0; t < 3; ++t) {
            const f32x4 x0 = *(const f32x4*)(cw + t * NUP + c), x1 = *(const f32x4*)(cw + t * NUP + c + 4);
            const f32x4 y0 = *(const f32x4*)(cw + t * NUP + DFF + c), y1 = *(const f32x4*)(cw + t * NUP + DFF + c + 4);
#pragma unroll
            for (int e = 0; e < 4; ++e) { wg[t][e] = x0[e]; wg[t][4 + e] = x1[e]; wv[t][e] = y0[e]; wv[t][4 + e] = y1[e]; }
        }
        { const f32x4 x0 = *(const f32x4*)(cb + c), x1 = *(const f32x4*)(cb + c + 4), y0 = *(const f32x4*)(cb + DFF + c), y1 = *(const f32x4*)(cb + DFF + c + 4);
#pragma unroll
          for (int e = 0; e < 4; ++e) { bg[e] = x0[e]; bg[4 + e] = x1[e]; bv[e] = y0[e]; bv[4 + e] = y1[e]; } }
        float g2[8], g1[8], v2[8], v1[8];
        if (t0 == 0) {
#pragma unroll
            for (int e = 0; e < 8; ++e) { g2[e] = 0.f; g1[e] = 0.f; v2[e] = 0.f; v1[e] = 0.f; }
        } else {
            unpack8(*(const u32x4*)(Z + (size_t)(m0 - 2) * NUP + c), g2); unpack8(*(const u32x4*)(Z + (size_t)(m0 - 1) * NUP + c), g1);
            unpack8(*(const u32x4*)(Z + (size_t)(m0 - 2) * NUP + DFF + c), v2); unpack8(*(const u32x4*)(Z + (size_t)(m0 - 1) * NUP + DFF + c), v1);
        }
#pragma unroll
        for (int r = 0; r < 8; ++r) {
            float g0[8], v0[8];
            unpack8(*(const u32x4*)(Z + (size_t)(m0 + r) * NUP + c), g0); unpack8(*(const u32x4*)(Z + (size_t)(m0 + r) * NUP + DFF + c), v0);
            float o[8];
#pragma unroll
            for (int e = 0; e < 8; ++e) {
                const float zg = bg[e] + wg[0][e] * g2[e] + wg[1][e] * g1[e] + wg[2][e] * g0[e];
                const float zv = bv[e] + wv[0][e] * v2[e] + wv[1][e] * v1[e] + wv[2][e] * v0[e];
                o[e] = silu(zg) * zv;
                g2[e] = g1[e]; g1[e] = g0[e]; v2[e] = v1[e]; v1[e] = v0[e];
            }
            u32x4 w; w.x = pk2(o[0], o[1]); w.y = pk2(o[2], o[3]); w.z = pk2(o[4], o[5]); w.w = pk2(o[6], o[7]);
            *(u32x4*)(AC + (size_t)(m0 + r) * DFF + c) = w;
        }
    }
}

__device__ __forceinline__ void prologue(const Args& a, LAS unsigned char* lds) {
    const int tid = opaque_tid(), lane = tid & 63, wave = tid >> 6;
    if (blockIdx.x == 0) {
        float* LB = (float*)(a.ws + WS_LB);
        for (int c = tid; c < 512; c += 512) {
            const float x0 = a.hg_lb[c], x1 = a.hg_lb[512 + c], x2 = a.hg_lb[1024 + c], x3 = a.hg_lb[1536 + c];
            const float mx = fmaxf(fmaxf(x0, x1), fmaxf(x2, x3));
            const float e0 = __expf(x0 - mx), e1 = __expf(x1 - mx), e2 = __expf(x2 - mx), e3 = __expf(x3 - mx), inv = 1.f / (e0 + e1 + e2 + e3);
            const float p1 = e1 * inv, p2 = e2 * inv, p3 = e3 * inv;
            LB[c] = 0.f; LB[512 + c] = fminf(fmaxf(p1, 0.f), 0.999f); LB[1024 + c] = fminf(fmaxf(p1 + p2, 0.f), 0.999f); LB[1536 + c] = fminf(fmaxf(p1 + p2 + p3, 0.f), 0.999f);
        }
    }
    convert_set(a, lds, 0, 0);
    convert_set(a, lds, 1, 0);
    const int gw = blockIdx.x * 8 + wave, NGW = gridDim.x * 8;
    bf16_t* XN = (bf16_t*)(a.ws + WS_XN); float* ssq = (float*)(a.ws + WS_SSQ);
    for (int m = gw; m < M; m += NGW) {
        const f32x4* xr = (const f32x4*)(a.x + (size_t)m * D) + lane; f32x4* orow = (f32x4*)(a.out + (size_t)m * D) + lane;
        const f32x4* gr = (const f32x4*)a.mix_norm + lane; u32x2* xnr = (u32x2*)(XN + (size_t)m * D) + lane;
        float s = 0.f;
#pragma unroll
        for (int j = 0; j < 4; ++j) { const f32x4 v = xr[64 * j], g = gr[64 * j]; orow[64 * j] = v; s += (v.x * v.x + v.y * v.y) + (v.z * v.z + v.w * v.w);
            u32x2 o; o.x = pk2(v.x * g.x, v.y * g.y); o.y = pk2(v.z * g.z, v.w * g.w); xnr[64 * j] = o; }
        s = wave_sum(s);
        if (lane < 16) ssq[(size_t)m * 16 + lane] = lane == 0 ? s : 0.f;
    }
}
__device__ __forceinline__ void final_norm(const Args& a) {
    const int tid = opaque_tid(), lane = tid & 63, wave = tid >> 6;
    const int gw = blockIdx.x * 8 + wave, NGW = gridDim.x * 8;
    const float* ssq = (const float*)(a.ws + WS_SSQ);
    for (int m = gw; m < M; m += NGW) {
        const float r = rowscale(ssq, m);
        f32x4* orow = (f32x4*)(a.out + (size_t)m * D) + lane; const f32x4* gr = (const f32x4*)a.final_norm + lane;
#pragma unroll
        for (int j = 0; j < 4; ++j) { const f32x4 v = orow[64 * j], g = gr[64 * j]; orow[64 * j] = (f32x4){v.x * r * g.x, v.y * r * g.y, v.z * r * g.z, v.w * r * g.w}; }
    }
}

__global__ void __launch_bounds__(512, 2) trunk_fwd(Args a) {
    extern __shared__ __attribute__((aligned(16))) unsigned char lds_raw[];
    LAS unsigned char* lds = (LAS unsigned char*)lds_raw;
    cg::grid_group grid = cg::this_grid();
    unsigned char* ws = a.ws;
    const int G = gridDim.x, bx = blockIdx.x;
    bf16_t* XN; float* ssq;

#ifndef PH
#define PH 0xFFFF
#endif
    if (PH & 1) prologue(a, lds);
    grid.sync();
#define LAUNDER(p) asm volatile("" : "+s"(p))
#pragma unroll 1
    for (int l = 0; l < DEPTH; ++l) {
        if (PH & 2) { LAUNDER(ws); XN = (bf16_t*)(ws + WS_XN); ssq = (float*)(ws + WS_SSQ);
            pg8::Gemm g{XN, (const bf16_t*)(ws + WS_WIN), M, INC, D}; pg8::StaticOrder S; S.init(M, INC, G, bx);
            EpiIn E{(bf16_t*)(ws + WS_U), (bf16_t*)(ws + WS_V), (bf16_t*)(ws + WS_Q), (bf16_t*)(ws + WS_KK), (bf16_t*)(ws + WS_I), (bf16_t*)(ws + WS_OG), (bf16_t*)(ws + WS_GT),
                    (float*)(ws + WS_GL), ssq, (const float*)(ws + WS_LB) + l * 512};
            pg8::gemm_phase<EpiIn, pg8::StaticOrder, true, true>(lds, g, S, E);
        }
        grid.sync();
        if (PH & 4) for (int u = bx; u < 1536; u += G) { if (u < 1024) hg1_unit(a, lds, u); else gmlp_unit(a, lds, u - 1024, l); }
        grid.sync();
        if (PH & 8) { hg_scan(a);
        if (l > 0) convert_set(a, lds, 1, l); }
        grid.sync();
        if (PH & 16) for (int u = bx; u < 1024; u += G) hg3_unit(a, lds, u, l);
        grid.sync();
        if (PH & 32) { LAUNDER(ws);
            pg8::StaticOrder S; S.init(M, D, G, bx);
            pg8::Gemm g1{(const bf16_t*)(ws + WS_U), (const bf16_t*)(ws + WS_WGM), M, D, 512};
            EpiBr<false> E1{(bf16_t*)(ws + WS_Y), (const bf16_t*)(ws + WS_GT), 0};
            pg8::gemm_phase<EpiBr<false>, pg8::StaticOrder, true, true>(lds, g1, S, E1);
            pg8::Gemm g2{(const bf16_t*)(ws + WS_OG), (const bf16_t*)(ws + WS_WHG), M, D, 512};
            EpiBr<true> E2{(bf16_t*)(ws + WS_Y), (const bf16_t*)(ws + WS_GT), 1024};
            pg8::gemm_phase<EpiBr<true>, pg8::StaticOrder, true, true>(lds, g2, S, E2);
        }
        grid.sync();
        if (PH & 64) { LAUNDER(ws); XN = (bf16_t*)(ws + WS_XN); ssq = (float*)(ws + WS_SSQ); float* xo = a.out; LAUNDER(xo);
            pg8::Gemm g{(const bf16_t*)(ws + WS_Y), (const bf16_t*)(ws + WS_WOUT), M, D, D}; pg8::StaticOrder S; S.init(M, D, G, bx);
            EpiRes E{xo, XN, a.ffn_norm + l * D, ssq};
            pg8::gemm_phase<EpiRes, pg8::StaticOrder, true, true>(lds, g, S, E);
        }
        grid.sync();
        if (PH & 128) { LAUNDER(ws); XN = (bf16_t*)(ws + WS_XN); ssq = (float*)(ws + WS_SSQ);
            pg8::Gemm g{XN, (const bf16_t*)(ws + WS_WUP), M, NUP, D}; pg8::StaticOrder S; S.init(M, NUP, G, bx);
            EpiZ E{(bf16_t*)(ws + WS_Z), ssq};
            pg8::gemm_phase<EpiZ, pg8::StaticOrder, true, true>(lds, g, S, E);
        }
        grid.sync();
        if (PH & 256) { conv_act(a, l);
        if (l + 1 < DEPTH) convert_set(a, lds, 0, l + 1); }
        grid.sync();
        if (PH & 512) { LAUNDER(ws); XN = (bf16_t*)(ws + WS_XN); ssq = (float*)(ws + WS_SSQ); float* xo = a.out; LAUNDER(xo);
            pg8::Gemm g{(const bf16_t*)(ws + WS_AC), (const bf16_t*)(ws + WS_WDN), M, D, DFF}; pg8::StaticOrder S; S.init(M, D, G, bx);
            EpiRes E{xo, XN, l + 1 < DEPTH ? a.mix_norm + (l + 1) * D : a.final_norm, ssq};
            pg8::gemm_phase<EpiRes, pg8::StaticOrder, true, true>(lds, g, S, E);
        }
        grid.sync();
    }
    if (PH & 1024) final_norm(a);
}

extern "C" void kernel_launch(void* const* d_in, const int* in_sizes, int n_in, void* d_out, int out_size, void* d_ws, size_t ws_size, hipStream_t stream) {
    static int grid = 0;
    if (grid == 0) {
        if (n_in != 18 || out_size != M * D || ws_size < WS_NEED) { fprintf(stderr, "kernel_launch: unexpected shapes (n_in %d, out %d, ws %zu < %zu)\n", n_in, out_size, ws_size, (size_t)WS_NEED); grid = -1; return; }
        int dev = 0, cus = 0, per_cu = 0;
        hipGetDevice(&dev); hipDeviceGetAttribute(&cus, hipDeviceAttributeMultiprocessorCount, dev);
        if (hipFuncSetAttribute((const void*)trunk_fwd, hipFuncAttributeMaxDynamicSharedMemorySize, LDS_BYTES) != hipSuccess) { fprintf(stderr, "kernel_launch: hipFuncSetAttribute failed\n"); grid = -1; return; }
        if (hipOccupancyMaxActiveBlocksPerMultiprocessor(&per_cu, (const void*)trunk_fwd, 512, LDS_BYTES) != hipSuccess || per_cu < 1) { fprintf(stderr, "kernel_launch: occupancy query says %d\n", per_cu); per_cu = 1; }
        (void)hipGetLastError();
        grid = cus * 1;
    }
    if (grid < 0) return;
    Args a{};
    const float** ap = (const float**)&a;
    for (int i = 0; i < 18; ++i) ap[i] = (const float*)d_in[i];
    a.out = (float*)d_out; a.ws = (unsigned char*)d_ws;
    void* args[] = {&a};
    hipError_t e = hipLaunchCooperativeKernel((const void*)trunk_fwd, dim3(grid), dim3(512), args, LDS_BYTES, stream);
    if (e != hipSuccess) fprintf(stderr, "cooperative launch failed: %s (grid %d)\n", hipGetErrorString(e), grid);
}
```

```cpp
#include <hip/hip_runtime.h>
#include <hip/hip_cooperative_groups.h>
#include <cstdio>
#include <cstdint>
namespace cg = cooperative_groups;
namespace pg8 {
#define PG8_LAS __attribute__((address_space(3)))
typedef unsigned short bf16_t;
typedef short bf16x8 __attribute__((ext_vector_type(8)));
typedef float f32x4 __attribute__((ext_vector_type(4)));
typedef unsigned u32x4 __attribute__((ext_vector_type(4)));
constexpr int BM = 256, BK = 64, HALF = 128, HTB = HALF * BK * 2  , STAGE_BYTES = 8 * HTB, NXCD = 8, WGM = 8;

__host__ __device__ __forceinline__ int lds_byte(int r, int c) { const int st = (r >> 4) * 2 + (c >> 5), rr = r & 15, cc = c & 31, ob = rr * 64 + cc * 2; return st * 1024 + (ob ^ (((ob >> 9) & 1) << 5)); }
__host__ __device__ __forceinline__ void stage_rc(int b, int& R, int& C) { const int st = b / 1024, sb = b % 1024, swz = sb ^ (((sb >> 9) & 1) << 5); R = (st >> 1) * 16 + swz / 64; C = (st & 1) * 32 + (swz % 64) / 2; }
__host__ __device__ __forceinline__ int perm32(int rho) { const int n = rho >> 4, i = rho & 15; return 8 * (i >> 2) + 4 * n + (i & 3); }

struct Unit { int pm, pn; };
struct Gemm { const bf16_t* A; const bf16_t* Bt; int M, N, K; };

struct StaticOrder {
    int nM, nN, nwg, G, c;
    __host__ __device__ void init(int M, int N, int G_, int c_) { nM = M / BM; nN = N / BM; nwg = nM * nN; G = G_; c = c_; }
    __host__ __device__ bool next(int i, Unit& u) const {
        const long L = (long)i * G + c; if (L >= nwg) return false;
        int wgid = (int)L; { const int q = nwg / NXCD, r = nwg % NXCD, xcd = wgid % NXCD, off = wgid / NXCD; wgid = (xcd < r ? xcd * (q + 1) : r * (q + 1) + (xcd - r) * q) + off; }
        const int nig = WGM * nN, gid = wgid / nig, fm = gid * WGM, gsz = (nM - fm) < WGM ? (nM - fm) : WGM;
        u.pm = fm + ((wgid % nig) % gsz); u.pn = (wgid % nig) / gsz; return true;
    }
    __device__ __forceinline__ void a_ready(const Unit&) const {}
    __device__ __forceinline__ void done(const Unit&) const {}
};

__device__ __forceinline__ unsigned cvt_pk_bf16(float lo, float hi) { unsigned r; asm volatile("v_cvt_pk_bf16_f32 %0, %1, %2" : "=v"(r) : "v"(lo), "v"(hi)); return r; }
typedef float f32x2 __attribute__((ext_vector_type(2)));
__device__ __forceinline__ f32x2 gelu_pk(f32x2 v) {
    const f32x2 av = __builtin_elementwise_abs(v), d = av * 0.2316418882f + 1.0f;
    f32x2 t; t.x = __builtin_amdgcn_rcpf(d.x); t.y = __builtin_amdgcn_rcpf(d.y);
    f32x2 q = t * 0.5307027145f + (-0.7265760135f); q = q * t + 0.7107068705f; q = q * t + (-0.142248368f); q = q * t + 0.127414796f; q = q * t;
    const f32x2 s = (v * v) * (-0.72134752044f);
    f32x2 e; e.x = __builtin_amdgcn_exp2f(s.x); e.y = __builtin_amdgcn_exp2f(s.y);
    const f32x2 m = v * (q * e), r = v - m;
    f32x2 o; o.x = v.x < 0.f ? m.x : r.x; o.y = v.y < 0.f ? m.y : r.y; return o;
}

template <int ACT  > struct EpiBf16 {
    static constexpr bool PERM = true, AFTER_DRAIN = false; static_assert(ACT == 0 || ACT == 1, "EpiBf16: ACT is 0 (none) or 1 (gelu_pk)");
    bf16_t* O; int ldc; const float* bias; int split_cols; size_t split_stride; float scale0;
    __device__ __forceinline__ void operator()(const f32x4 (&acc)[2][2][4][2], const Unit& u, int wr, int wc, int fr, int fq) const {
        const int row0 = u.pm * BM + wr * 64 + fr; int colt = u.pn * BM; bf16_t* base = O;
        float sc = 1.f; if (split_cols) { const int t = colt / split_cols; base += (size_t)t * split_stride; colt -= t * split_cols; if (t == 0) sc = scale0; }
        const int col0 = colt + wc * 32 + 8 * fq, bcol0 = u.pn * BM + wc * 32 + 8 * fq;
        f32x4 bv[2][2];
#pragma unroll
        for (int bj = 0; bj < 2; ++bj)
#pragma unroll
            for (int n = 0; n < 2; ++n) bv[bj][n] = bias ? *(const f32x4*)(bias + bcol0 + bj * HALF + 4 * n) : (f32x4){0.f, 0.f, 0.f, 0.f};
#pragma unroll
        for (int ai = 0; ai < 2; ++ai)
#pragma unroll
            for (int m = 0; m < 4; ++m) { bf16_t* rowp = base + (size_t)(row0 + ai * HALF + m * 16) * ldc + col0;
#pragma unroll
                for (int bj = 0; bj < 2; ++bj) { f32x4 v0 = acc[ai][bj][m][0] + bv[bj][0], v1 = acc[ai][bj][m][1] + bv[bj][1];
                    if (ACT == 1) { f32x2 a = gelu_pk((f32x2){v0[0], v0[1]}), b = gelu_pk((f32x2){v0[2], v0[3]}), c = gelu_pk((f32x2){v1[0], v1[1]}), d = gelu_pk((f32x2){v1[2], v1[3]});
                        v0 = (f32x4){a.x, a.y, b.x, b.y}; v1 = (f32x4){c.x, c.y, d.x, d.y}; }
                    v0 = v0 * sc; v1 = v1 * sc; u32x4 w; w.x = cvt_pk_bf16(v0[0], v0[1]); w.y = cvt_pk_bf16(v0[2], v0[3]); w.z = cvt_pk_bf16(v1[0], v1[1]); w.w = cvt_pk_bf16(v1[2], v1[3]);
                    *(u32x4*)(rowp + bj * HALF) = w; } }
    }
};
template <class Epi, class Sched, bool ALIGN_EPI = false, bool SP2 = false>
__device__ __forceinline__ void gemm_phase(PG8_LAS unsigned char* lds, const Gemm g, const Sched& S, const Epi& E) {
    int tid_ = threadIdx.x; asm volatile("" : "+v"(tid_)); const int tid = tid_, wid = __builtin_amdgcn_readfirstlane(tid >> 6), lane = tid & 63, wr = wid >> 2, wc = wid & 3, fr = lane & 15, fq = lane >> 4;
    const int K = g.K, nt = K / BK;
    unsigned voffA[2], voffB[2];
#pragma unroll
    for (int i = 0; i < 2; ++i) { int R, C; stage_rc(tid * 16 + i * 8192, R, C); const int Rb = Epi::PERM ? ((R & ~31) + perm32(R & 31)) : R;
        voffA[i] = (unsigned)(R * K + C) * 2u; voffB[i] = (unsigned)(Rb * K + C) * 2u; }
    const size_t kstep = (size_t)(BK * 2);
    const size_t hstep = (size_t)HALF * K * 2;
    const size_t tstep = 2 * hstep;
    const unsigned ldsw = (unsigned)wid * 1024u;
    const int aoff = lds_byte(wr * 64 + fr, fq * 8), boff = lds_byte(wc * 32 + fr, fq * 8);
#define PG8_SA(b, h) (((b) * 2 + (h)) * HTB)
#define PG8_SB(b, h) ((4 + (b) * 2 + (h)) * HTB)
#define PG8_STAGE(bufoff, gbase, voff) do { _Pragma("unroll") for (int _i = 0; _i < 2; ++_i) \
        __builtin_amdgcn_global_load_lds((const unsigned*)((const char*)(gbase) + (voff)[_i]), (PG8_LAS unsigned*)(lds + (bufoff) + ldsw + _i * 8192), 16, 0, 0); } while (0)
#define PG8_LDA(dst, b, h) do { _Pragma("unroll") for (int m = 0; m < 4; ++m) _Pragma("unroll") for (int k = 0; k < 2; ++k) dst[m][k] = *(const PG8_LAS bf16x8*)(lds + PG8_SA(b, h) + aoff + m * 2048 + k * 1024); } while (0)
#define PG8_LDB(dst, b, h) do { _Pragma("unroll") for (int n = 0; n < 2; ++n) _Pragma("unroll") for (int k = 0; k < 2; ++k) dst[n][k] = *(const PG8_LAS bf16x8*)(lds + PG8_SB(b, h) + boff + n * 2048 + k * 1024); } while (0)
#define PG8_MMA(ai, bj, At, Bt) do { __builtin_amdgcn_s_setprio(1); _Pragma("unroll") for (int m = 0; m < 4; ++m) _Pragma("unroll") for (int n = 0; n < 2; ++n) _Pragma("unroll") for (int k = 0; k < 2; ++k) \
        acc[ai][bj][m][n] = __builtin_amdgcn_mfma_f32_16x16x32_bf16(Bt[n][k], At[m][k], acc[ai][bj][m][n], 0, 0, 0); __builtin_amdgcn_s_setprio(0); } while (0)
#define PG8_WAIT_V(n) asm volatile("s_waitcnt vmcnt(" #n ")" ::: "memory")
#define PG8_WAIT_L(n) asm volatile("s_waitcnt lgkmcnt(" #n ")" ::: "memory")
#define PG8_BAR __builtin_amdgcn_s_barrier()
#define PG8_SCHED __builtin_amdgcn_sched_barrier(0)
    Unit cur, nxt; int ui = 0;
    if (!S.next(0, cur)) return;
    f32x4 acc[2][2][4][2];
#pragma unroll
    for (int a = 0; a < 2; ++a)
#pragma unroll
        for (int b = 0; b < 2; ++b)
#pragma unroll
            for (int m = 0; m < 4; ++m)
#pragma unroll
                for (int n = 0; n < 2; ++n) acc[a][b][m][n] = (f32x4){0.f, 0.f, 0.f, 0.f};
    bf16x8 At[4][2], B0[2][2], B1[2][2];
    const char* cA = (const char*)g.A + (size_t)cur.pm * tstep; const char* cB = (const char*)g.Bt + (size_t)cur.pn * tstep;
    S.a_ready(cur);
    if constexpr (SP2) {
        PG8_STAGE(PG8_SB(0, 0), cB, voffB); PG8_STAGE(PG8_SB(0, 1), cB + hstep, voffB); PG8_STAGE(PG8_SA(0, 0), cA, voffA); PG8_STAGE(PG8_SA(0, 1), cA + hstep, voffA);
        if (wr == 1) PG8_BAR;
        PG8_WAIT_V(2); PG8_BAR;
        PG8_STAGE(PG8_SB(1, 0), cB + kstep, voffB); PG8_STAGE(PG8_SA(1, 0), cA + kstep, voffA); PG8_STAGE(PG8_SB(1, 1), cB + hstep + kstep, voffB);
        PG8_WAIT_V(6); PG8_BAR;
    } else {
        PG8_STAGE(PG8_SB(0, 0), cB, voffB); PG8_STAGE(PG8_SA(0, 0), cA, voffA); PG8_STAGE(PG8_SB(0, 1), cB + hstep, voffB); PG8_STAGE(PG8_SA(0, 1), cA + hstep, voffA);
        if (wr == 1) PG8_BAR;
        PG8_WAIT_V(4); PG8_BAR;
        PG8_STAGE(PG8_SB(1, 0), cB + kstep, voffB); PG8_STAGE(PG8_SA(1, 0), cA + kstep, voffA); PG8_STAGE(PG8_SB(1, 1), cB + hstep + kstep, voffB);
        PG8_WAIT_V(6); PG8_BAR;
    }
    for (;;) {
        const bool has_next = S.next(ui + 1, nxt);
        const char* nA = has_next ? (const char*)g.A + (size_t)nxt.pm * tstep : cA; const char* nB = has_next ? (const char*)g.Bt + (size_t)nxt.pn * tstep : cB;
        for (int t = 0; t < nt; t += 2) {
            const bool last = (t == nt - 2);
            const char* a1 = cA + (size_t)(t + 1) * kstep;
            const char* a2 = last ? nA : cA + (size_t)(t + 2) * kstep; const char* b2 = last ? nB : cB + (size_t)(t + 2) * kstep;
            const char* a3 = a2 + kstep; const char* b3 = b2 + kstep;
            if (last && has_next) S.a_ready(nxt);
            if constexpr (SP2) {
            PG8_LDB(B0, 0, 0); PG8_LDB(B1, 0, 1); PG8_SCHED; PG8_LDA(At, 0, 0); PG8_STAGE(PG8_SA(1, 1), a1 + hstep, voffA);
            PG8_WAIT_V(8); PG8_WAIT_L(0); PG8_BAR; PG8_MMA(0, 0, At, B0); PG8_MMA(0, 1, At, B1); PG8_BAR; PG8_SCHED;
            PG8_LDA(At, 0, 1); PG8_STAGE(PG8_SB(0, 0), b2, voffB); PG8_STAGE(PG8_SB(0, 1), b2 + hstep, voffB); PG8_STAGE(PG8_SA(0, 0), a2, voffA);
            PG8_WAIT_V(8); PG8_WAIT_L(0); PG8_BAR; PG8_MMA(1, 0, At, B0); PG8_MMA(1, 1, At, B1); PG8_BAR; PG8_SCHED;
            PG8_LDB(B0, 1, 0); PG8_LDB(B1, 1, 1); PG8_SCHED; PG8_LDA(At, 1, 0); PG8_STAGE(PG8_SA(0, 1), a2 + hstep, voffA);
            PG8_WAIT_V(8); PG8_WAIT_L(0); PG8_BAR; PG8_MMA(0, 0, At, B0); PG8_MMA(0, 1, At, B1); PG8_BAR; PG8_SCHED;
            PG8_LDA(At, 1, 1); PG8_STAGE(PG8_SB(1, 0), b3, voffB); PG8_STAGE(PG8_SB(1, 1), b3 + hstep, voffB); PG8_STAGE(PG8_SA(1, 0), a3, voffA);
            PG8_WAIT_V(8); PG8_WAIT_L(0); PG8_BAR; PG8_MMA(1, 0, At, B0); PG8_MMA(1, 1, At, B1); PG8_BAR; PG8_SCHED;
            } else {
            PG8_LDB(B0, 0, 0); PG8_SCHED; PG8_LDA(At, 0, 0); PG8_STAGE(PG8_SA(1, 1), a1 + hstep, voffA);
            PG8_WAIT_L(8); PG8_BAR; PG8_WAIT_L(0); PG8_MMA(0, 0, At, B0); PG8_BAR; PG8_SCHED;
            PG8_LDB(B1, 0, 1); PG8_STAGE(PG8_SB(0, 0), b2, voffB);
            PG8_BAR; PG8_WAIT_L(0); PG8_MMA(0, 1, At, B1); PG8_BAR;
            PG8_LDA(At, 0, 1); PG8_STAGE(PG8_SA(0, 0), a2, voffA);
            PG8_BAR; PG8_WAIT_L(0); PG8_MMA(1, 0, At, B0); PG8_BAR; PG8_SCHED;
            PG8_STAGE(PG8_SB(0, 1), b2 + hstep, voffB);
            PG8_WAIT_V(6); PG8_BAR; PG8_MMA(1, 1, At, B1); PG8_BAR;
            PG8_LDB(B0, 1, 0); PG8_SCHED; PG8_LDA(At, 1, 0); PG8_STAGE(PG8_SA(0, 1), a2 + hstep, voffA);
            PG8_WAIT_L(8); PG8_BAR; PG8_WAIT_L(0); PG8_MMA(0, 0, At, B0); PG8_BAR; PG8_SCHED;
            PG8_LDB(B1, 1, 1); PG8_STAGE(PG8_SB(1, 0), b3, voffB);
            PG8_BAR; PG8_WAIT_L(0); PG8_MMA(0, 1, At, B1); PG8_BAR;
            PG8_LDA(At, 1, 1); PG8_STAGE(PG8_SA(1, 0), a3, voffA);
            PG8_BAR; PG8_WAIT_L(0); PG8_MMA(1, 0, At, B0); PG8_BAR; PG8_SCHED;
            PG8_STAGE(PG8_SB(1, 1), b3 + hstep, voffB);
            PG8_WAIT_V(6); PG8_BAR; PG8_MMA(1, 1, At, B1); PG8_BAR;
            }
        }
        if constexpr (ALIGN_EPI) { if (wr == 0) PG8_BAR; }
        if constexpr (!Epi::AFTER_DRAIN) { E(acc, cur, wr, wc, fr, fq); S.done(cur); }
        if (!has_next) break;
#pragma unroll
        for (int a = 0; a < 2; ++a)
#pragma unroll
            for (int b = 0; b < 2; ++b)
#pragma unroll
                for (int m = 0; m < 4; ++m)
#pragma unroll
                    for (int n = 0; n < 2; ++n) acc[a][b][m][n] = (f32x4){0.f, 0.f, 0.f, 0.f};
        cur = nxt; cA = nA; cB = nB; ++ui;
        if constexpr (ALIGN_EPI) { if (wr == 1) PG8_BAR; }
    }
    PG8_WAIT_V(0);
    if constexpr (!ALIGN_EPI) { if (wr == 0) PG8_BAR; }
    PG8_BAR;
    if constexpr (Epi::AFTER_DRAIN) { E.fused(acc, cur, wr, wc, fr, fq, lds, wid, lane); S.done(cur); }
#undef PG8_SA
#undef PG8_SB
#undef PG8_STAGE
#undef PG8_LDA
#undef PG8_LDB
#undef PG8_MMA
#undef PG8_WAIT_V
#undef PG8_WAIT_L
#undef PG8_BAR
#undef PG8_SCHED
}
}
#define LAS __attribute__((address_space(3)))
__device__ __forceinline__ int opaque_tid() { int t = threadIdx.x; asm volatile("" : "+v"(t)); return t; }
using pg8::bf16_t; using pg8::bf16x8; using pg8::f32x4; using pg8::u32x4; using pg8::Unit;
typedef float f32x2 __attribute__((ext_vector_type(2)));
typedef unsigned u32x2 __attribute__((ext_vector_type(2)));

constexpr int NB = 2, SEQ = 8192, M = NB * SEQ, D = 1024, DEPTH = 4, INC = 5120, DFF = 2816, NUP = 2 * DFF;
constexpr float EPS = 1e-6f, LOG2E = 1.4426950408889634f;
constexpr size_t MiB = 1u << 20;
constexpr size_t WS_LB = 1 * MiB, WS_SSQ = 2 * MiB, WS_DEC = 3 * MiB;
constexpr size_t WS_WIN = 4 * MiB, WS_WGM = 14 * MiB, WS_WHG = 15 * MiB, WS_WOUT = 16 * MiB, WS_WUP = 18 * MiB, WS_WDN = 29 * MiB;
constexpr size_t WS_XN = 36 * MiB, WS_ACT0 = 68 * MiB;
constexpr size_t WS_U = WS_ACT0, WS_V = WS_U + 16 * MiB, WS_Q = WS_V + 16 * MiB, WS_KK = WS_Q + 16 * MiB, WS_GL = WS_KK + 16 * MiB, WS_I = WS_GL + 32 * MiB,
                 WS_OG = WS_I + 16 * MiB, WS_GT = WS_OG + 16 * MiB, WS_ST = WS_GT + 64 * MiB, WS_END1 = WS_ST + 64 * MiB;
constexpr size_t WS_Y = WS_Q;
constexpr size_t WS_Z = WS_ACT0, WS_AC = WS_Z + 176 * MiB, WS_END2 = WS_AC + 88 * MiB;
constexpr size_t WS_NEED = WS_END1 > WS_END2 ? WS_END1 : WS_END2;
constexpr int LDS_BYTES = 147456;

struct Args {
    const float *x, *mix_norm, *w_in, *gm_ln_g, *gm_ln_b, *gm_ws, *gm_bs, *hg_lb, *hg_norm_g, *w_br_gm, *w_br_hg, *w_out, *ffn_norm, *w_up, *conv_w, *conv_b, *w_down, *final_norm;
    float* out; unsigned char* ws;
};

__device__ __forceinline__ float bf2f(unsigned h) { return __uint_as_float(h << 16); }
__device__ __forceinline__ unsigned f2bf(float f) { unsigned u = __float_as_uint(f); return (u + 0x7fffu + ((u >> 16) & 1u)) >> 16; }
__device__ __forceinline__ unsigned pk2(float lo, float hi) { return pg8::cvt_pk_bf16(lo, hi); }
__device__ __forceinline__ float fexp2(float x) { return __builtin_amdgcn_exp2f(x); }
__device__ __forceinline__ float frcp(float x) { return __builtin_amdgcn_rcpf(x); }
__device__ __forceinline__ float sigm(float x) { return frcp(1.f + fexp2(-LOG2E * x)); }
__device__ __forceinline__ float silu(float x) { return x * sigm(x); }
__device__ __forceinline__ float wave_sum(float v) {
#pragma unroll
    for (int o = 1; o < 64; o <<= 1) v += __shfl_xor(v, o);
    return v;
}
__device__ __forceinline__ void unpack8(const u32x4 r, float (&x)[8]) {
    x[0] = bf2f(r.x & 0xffffu); x[1] = bf2f(r.x >> 16); x[2] = bf2f(r.y & 0xffffu); x[3] = bf2f(r.y >> 16);
    x[4] = bf2f(r.z & 0xffffu); x[5] = bf2f(r.z >> 16); x[6] = bf2f(r.w & 0xffffu); x[7] = bf2f(r.w >> 16);
}
__device__ __forceinline__ float rowscale(const float* ssq, int row) {
    const f32x4* p = (const f32x4*)(ssq + (size_t)row * 16); const f32x4 s = (p[0] + p[1]) + (p[2] + p[3]);
    return rsqrtf(((s.x + s.y) + (s.z + s.w)) * (1.f / 1024.f) + EPS);
}

struct EpiIn {
    static constexpr bool PERM = true, AFTER_DRAIN = false;
    bf16_t *U, *V, *Q, *KK, *I, *OG, *GT; float* GL; const float* ssq; const float* lb;
    template <int SEG> __device__ __forceinline__ void body(const f32x4 (&acc)[2][2][4][2], const Unit& u, int wr, int wc, int fr, int fq) const {
        const int row0 = u.pm * 256 + wr * 64 + fr, pn = u.pn;
        bf16_t* base; int ldc, colt;
        if (SEG == 6) { base = GT; ldc = 2048; colt = (pn - 12) * 256; }
        else { ldc = 512; colt = (pn & 1) * 256; base = SEG == 0 ? U : SEG == 1 ? V : SEG == 2 ? Q : SEG == 3 ? KK : SEG == 4 ? I : OG; }
        const int col0 = colt + wc * 32 + 8 * fq;
#pragma unroll
        for (int ai = 0; ai < 2; ++ai)
#pragma unroll
            for (int m = 0; m < 4; ++m) {
                const int row = row0 + ai * 128 + m * 16; const float r = rowscale(ssq, row);
#pragma unroll
                for (int bj = 0; bj < 2; ++bj) {
                    const int c = col0 + bj * 128;
                    f32x4 v0 = acc[ai][bj][m][0] * r, v1 = acc[ai][bj][m][1] * r;
                    float o[8] = {v0[0], v0[1], v0[2], v0[3], v1[0], v1[1], v1[2], v1[3]};
                    if (SEG == 0 || SEG == 1) {
#pragma unroll
                        for (int e = 0; e < 8; e += 2) { f32x2 g = pg8::gelu_pk((f32x2){o[e], o[e + 1]}); o[e] = g.x; o[e + 1] = g.y; }
                    } else if (SEG == 2 || SEG == 5) {
#pragma unroll
                        for (int e = 0; e < 8; ++e) o[e] = silu(o[e]);
                    } else if (SEG == 6) {
#pragma unroll
                        for (int e = 0; e < 8; ++e) o[e] = sigm(o[e]);
                    } else if (SEG == 3) {
                        const f32x4 l0 = *(const f32x4*)(lb + c), l1 = *(const f32x4*)(lb + c + 4);
                        const float lbv[8] = {l0[0], l0[1], l0[2], l0[3], l1[0], l1[1], l1[2], l1[3]};
                        float g2[8];
#pragma unroll
                        for (int e = 0; e < 8; ++e) {
                            const float f = fminf(fmaxf(o[e], -80.f), 80.f);
                            const float ex = fexp2(-LOG2E * f), sg = frcp(1.f + ex);
                            const float fg = lbv[e] + (1.f - lbv[e]) * sg;
                            g2[e] = __builtin_amdgcn_logf(fmaxf(fg, 1e-30f));
                            o[e] = (1.f - lbv[e]) * (ex * sg);
                        }
                        float* gp = GL + (size_t)row * 512 + c;
                        *(f32x4*)gp = (f32x4){g2[0], g2[1], g2[2], g2[3]}; *(f32x4*)(gp + 4) = (f32x4){g2[4], g2[5], g2[6], g2[7]};
                    }
                    u32x4 w; w.x = pk2(o[0], o[1]); w.y = pk2(o[2], o[3]); w.z = pk2(o[4], o[5]); w.w = pk2(o[6], o[7]);
                    *(u32x4*)(base + (size_t)row * ldc + c) = w;
                }
                asm volatile("" ::: "memory");
            }
    }
    __device__ __forceinline__ void operator()(const f32x4 (&acc)[2][2][4][2], const Unit& u, int wr, int wc, int fr, int fq) const {
        const int seg = u.pn < 12 ? (u.pn >> 1) : 6;
        switch (seg) {
            case 0: body<0>(acc, u, wr, wc, fr, fq); break;
            case 1: body<1>(acc, u, wr, wc, fr, fq); break;
            case 2: body<2>(acc, u, wr, wc, fr, fq); break;
            case 3: body<3>(acc, u, wr, wc, fr, fq); break;
            case 4: body<4>(acc, u, wr, wc, fr, fq); break;
            case 5: body<5>(acc, u, wr, wc, fr, fq); break;
            default: body<6>(acc, u, wr, wc, fr, fq); break;
        }
    }
};
template <bool ADD> struct EpiBr {
    static constexpr bool PERM = true, AFTER_DRAIN = false;
    bf16_t* Y; const bf16_t* GT; int goff;
    __device__ __forceinline__ void operator()(const f32x4 (&acc)[2][2][4][2], const Unit& u, int wr, int wc, int fr, int fq) const {
        const int row0 = u.pm * 256 + wr * 64 + fr, col0 = u.pn * 256 + wc * 32 + 8 * fq;
#pragma unroll
        for (int ai = 0; ai < 2; ++ai)
#pragma unroll
            for (int m = 0; m < 4; ++m) {
                const int row = row0 + ai * 128 + m * 16;
#pragma unroll
                for (int bj = 0; bj < 2; ++bj) {
                    const int c = col0 + bj * 128;
                    float g[8]; unpack8(*(const u32x4*)(GT + (size_t)row * 2048 + goff + c), g);
                    const f32x4 v0 = acc[ai][bj][m][0], v1 = acc[ai][bj][m][1];
                    float o[8] = {v0[0] * g[0], v0[1] * g[1], v0[2] * g[2], v0[3] * g[3], v1[0] * g[4], v1[1] * g[5], v1[2] * g[6], v1[3] * g[7]};
                    bf16_t* yp = Y + (size_t)row * 1024 + c;
                    if (ADD) { float y[8]; unpack8(*(const u32x4*)yp, y);
#pragma unroll
                        for (int e = 0; e < 8; ++e) o[e] += y[e]; }
                    u32x4 w; w.x = pk2(o[0], o[1]); w.y = pk2(o[2], o[3]); w.z = pk2(o[4], o[5]); w.w = pk2(o[6], o[7]);
                    *(u32x4*)yp = w;
                }
                asm volatile("" ::: "memory");
            }
    }
};
struct EpiRes {
    static constexpr bool PERM = false, AFTER_DRAIN = false;
    float* x; bf16_t* xn; const float* g; float* ssq;
    __device__ __forceinline__ void operator()(const f32x4 (&acc)[2][2][4][2], const Unit& u, int wr, int wc, int fr, int fq) const {
        const int row0 = u.pm * 256 + wr * 64 + fr, col0 = u.pn * 256 + wc * 32 + 4 * fq;
#pragma unroll
        for (int ai = 0; ai < 2; ++ai)
#pragma unroll
            for (int m = 0; m < 4; ++m) {
                const int row = row0 + ai * 128 + m * 16; float ss = 0.f;
#pragma unroll
                for (int bj = 0; bj < 2; ++bj)
#pragma unroll
                    for (int n = 0; n < 2; ++n) {
                        const int c = col0 + bj * 128 + n * 16;
                        float* xp = x + (size_t)row * 1024 + c;
                        f32x4 xo = *(const f32x4*)xp; xo = xo + acc[ai][bj][m][n]; *(f32x4*)xp = xo;
                        ss += (xo[0] * xo[0] + xo[1] * xo[1]) + (xo[2] * xo[2] + xo[3] * xo[3]);
                        const f32x4 gv = *(const f32x4*)(g + c);
                        u32x2 w; w.x = pk2(xo[0] * gv[0], xo[1] * gv[1]); w.y = pk2(xo[2] * gv[2], xo[3] * gv[3]);
                        *(u32x2*)(xn + (size_t)row * 1024 + c) = w;
                    }
                ss += __shfl_xor(ss, 16); ss += __shfl_xor(ss, 32);
                if (fq == 0) ssq[(size_t)row * 16 + u.pn * 4 + wc] = ss;
                asm volatile("" ::: "memory");
            }
    }
};
struct EpiZ {
    static constexpr bool PERM = true, AFTER_DRAIN = false;
    bf16_t* Z; const float* ssq;
    __device__ __forceinline__ void operator()(const f32x4 (&acc)[2][2][4][2], const Unit& u, int wr, int wc, int fr, int fq) const {
        const int row0 = u.pm * 256 + wr * 64 + fr, col0 = u.pn * 256 + wc * 32 + 8 * fq;
#pragma unroll
        for (int ai = 0; ai < 2; ++ai)
#pragma unroll
            for (int m = 0; m < 4; ++m) {
                const int row = row0 + ai * 128 + m * 16; const float r = rowscale(ssq, row);
#pragma unroll
                for (int bj = 0; bj < 2; ++bj) {
                    const f32x4 v0 = acc[ai][bj][m][0] * r, v1 = acc[ai][bj][m][1] * r;
                    u32x4 w; w.x = pk2(v0[0], v0[1]); w.y = pk2(v0[2], v0[3]); w.z = pk2(v1[0], v1[1]); w.w = pk2(v1[2], v1[3]);
                    *(u32x4*)(Z + (size_t)row * NUP + col0 + bj * 128) = w;
                }
                asm volatile("" ::: "memory");
            }
    }
};

__device__ __forceinline__ void transpose_item(const float* W, int K, int N, bf16_t* WT, LAS float* scr, int item, int lane) {
    const int nblk = N / 32, kb = item / nblk, nb = item % nblk, k0 = 64 * kb, n0 = 32 * nb;
#pragma unroll 8
    for (int i = 0; i < 32; ++i) { const int kk = 2 * i + (lane >> 5); scr[kk * 33 + (lane & 31)] = W[(size_t)(k0 + kk) * N + n0 + (lane & 31)]; }
    asm volatile("s_waitcnt lgkmcnt(0)" ::: "memory");
    const int c = lane & 7;
#pragma unroll
    for (int j = 0; j < 4; ++j) { const int n = (lane >> 3) + 8 * j; const LAS float* s = scr + (8 * c) * 33 + n;
        u32x4 o; o.x = pk2(s[0 * 33], s[1 * 33]); o.y = pk2(s[2 * 33], s[3 * 33]); o.z = pk2(s[4 * 33], s[5 * 33]); o.w = pk2(s[6 * 33], s[7 * 33]);
        *(u32x4*)(WT + (size_t)(n0 + n) * K + k0 + 8 * c) = o; }
    asm volatile("s_waitcnt lgkmcnt(0)" ::: "memory");
}
__device__ __forceinline__ void convert_set(const Args& a, LAS unsigned char* lds, int set, int l) {
    const int tid = opaque_tid(), lane = tid & 63, wave = tid >> 6;
    LAS float* scr = (LAS float*)(lds + wave * 16384);
    const int gw = blockIdx.x * 8 + wave, NGW = gridDim.x * 8;
    unsigned char* ws = a.ws;
    if (set == 0) {
        constexpr int I0 = (D / 64) * (INC / 32), I1 = (512 / 64) * (D / 32), I3 = (D / 64) * (D / 32), NI = I0 + 2 * I1 + I3;
        for (int it = gw; it < NI; it += NGW) {
            int r = it;
            if (r < I0) { transpose_item(a.w_in + (size_t)l * D * INC, D, INC, (bf16_t*)(ws + WS_WIN), scr, r, lane); continue; } r -= I0;
            if (r < I1) { transpose_item(a.w_br_gm + (size_t)l * 512 * D, 512, D, (bf16_t*)(ws + WS_WGM), scr, r, lane); continue; } r -= I1;
            if (r < I1) { transpose_item(a.w_br_hg + (size_t)l * 512 * D, 512, D, (bf16_t*)(ws + WS_WHG), scr, r, lane); continue; } r -= I1;
            transpose_item(a.w_out + (size_t)l * D * D, D, D, (bf16_t*)(ws + WS_WOUT), scr, r, lane);
        }
    } else {
        constexpr int I0 = (D / 64) * (NUP / 32), I1 = (DFF / 64) * (D / 32), NI = I0 + I1;
        for (int it = gw; it < NI; it += NGW) {
            int r = it;
            if (r < I0) { transpose_item(a.w_up + (size_t)l * D * NUP, D, NUP, (bf16_t*)(ws + WS_WUP), scr, r, lane); continue; } r -= I0;
            transpose_item(a.w_down + (size_t)l * DFF * D, DFF, D, (bf16_t*)(ws + WS_WDN), scr, r, lane);
        }
    }
}

constexpr int LDQ = 136, LDV = 72, LDG = 132;
__device__ __forceinline__ bf16x8 ldfrag(const LAS bf16_t* base, int ld, int fr, int fq, int k0) { return *(const LAS bf16x8*)(base + fr * ld + k0 + fq * 8); }
#define MMA16(xf, yf, acc) __builtin_amdgcn_mfma_f32_16x16x32_bf16((xf), (yf), (acc), 0, 0, 0)

__device__ __forceinline__ void gmlp_unit(const Args& a, LAS unsigned char* lds, int unit, int l) {
    const int tid = opaque_tid(), lane = tid & 63, w = tid >> 6, fr = lane & 15, fq = lane >> 4;
    const int h = unit & 3, blk = (unit >> 2) & 63, b = unit >> 8;
    const size_t r0 = (size_t)b * SEQ + (size_t)blk * 128;
    LAS bf16_t* Vt = (LAS bf16_t*)lds;
    LAS bf16_t* Wl = Vt + 128 * LDQ;
    const bf16_t* Vg = (const bf16_t*)(a.ws + WS_V); bf16_t* Ug = (bf16_t*)(a.ws + WS_U);
    const float* lng = a.gm_ln_g + l * 512; const float* lnb = a.gm_ln_b + l * 512;
    for (int rr = 0; rr < 16; ++rr) {
        const int j = w * 16 + rr;
        float x[8]; unpack8(*(const u32x4*)(Vg + (r0 + j) * 512 + lane * 8), x);
        float s = ((x[0] + x[1]) + (x[2] + x[3])) + ((x[4] + x[5]) + (x[6] + x[7]));
        const float mean = wave_sum(s) * (1.f / 512.f);
        float q = 0.f;
#pragma unroll
        for (int e = 0; e < 8; ++e) { x[e] -= mean; q += x[e] * x[e]; }
        const float rstd = rsqrtf(wave_sum(q) * (1.f / 512.f) + EPS);
        if ((lane >> 4) == h) {
            const int d0 = (lane & 15) * 8, cg0 = h * 128 + d0;
#pragma unroll
            for (int e = 0; e < 8; ++e) Vt[(d0 + e) * LDQ + j] = (bf16_t)f2bf(x[e] * rstd * lng[cg0 + e] + lnb[cg0 + e]);
        }
    }
    const float* wsrc = a.gm_ws + (size_t)(l * 4 + h) * 16384;
#pragma unroll
    for (int it = 0; it < 8; ++it) {
        const int idx = it * 512 + tid, i = idx >> 5, j4 = (idx & 31) * 4;
        f32x4 wv = *(const f32x4*)(wsrc + i * 128 + j4);
        if ((i >> 6) < (j4 >> 6)) wv = (f32x4){0.f, 0.f, 0.f, 0.f};
        u32x2 o; o.x = pk2(wv[0], wv[1]); o.y = pk2(wv[2], wv[3]);
        *(LAS u32x2*)(Wl + i * LDQ + j4) = o;
    }
    __syncthreads();
    bf16x8 af[4];
#pragma unroll
    for (int ks = 0; ks < 4; ++ks) af[ks] = ldfrag(Wl + (w * 16) * LDQ, LDQ, fr, fq, ks * 32);
    const int i = w * 16 + fr; const float bias = a.gm_bs[(l * 4 + h) * 128 + i];
#pragma unroll
    for (int dt = 0; dt < 8; ++dt) {
        f32x4 acc = {0.f, 0.f, 0.f, 0.f};
#pragma unroll
        for (int ks = 0; ks < 4; ++ks) acc = MMA16(ldfrag(Vt + (dt * 16) * LDQ, LDQ, fr, fq, ks * 32), af[ks], acc);
        bf16_t* up = Ug + (r0 + i) * 512 + h * 128 + dt * 16 + 4 * fq;
        const u32x2 uu = *(const u32x2*)up;
        u32x2 o; o.x = pk2(bf2f(uu.x & 0xffffu) * (acc[0] + bias), bf2f(uu.x >> 16) * (acc[1] + bias));
        o.y = pk2(bf2f(uu.y & 0xffffu) * (acc[2] + bias), bf2f(uu.y >> 16) * (acc[3] + bias));
        *(u32x2*)up = o;
    }
    __syncthreads();
}

__device__ __forceinline__ void hg1_unit(const Args& a, LAS unsigned char* lds, int unit) {
    const int tid = opaque_tid(), lane = tid & 63, w = tid >> 6, fr = lane & 15, fq = lane >> 4;
    const int c = unit & 127, bh = unit >> 7, h = bh & 3, b = bh >> 2;
    const size_t r0 = (size_t)b * SEQ + (size_t)c * 64;
    LAS float* Gs = (LAS float*)lds;
    LAS float* Tot = Gs + 64 * LDG;
    LAS bf16_t* Vt = (LAS bf16_t*)(lds + 64 * LDG * 4 + 2048);
    LAS bf16_t* Kt = Vt + 128 * LDV;
    float* GLg = (float*)(a.ws + WS_GL); const bf16_t* Ig = (const bf16_t*)(a.ws + WS_I); const bf16_t* Kg = (const bf16_t*)(a.ws + WS_KK);
    const int d = tid & 127, sg = tid >> 7;
    float* gp = GLg + (r0 + sg * 16) * 512 + h * 128 + d;
    float g[16];
#pragma unroll
    for (int j = 0; j < 16; ++j) g[j] = gp[(size_t)j * 512];
#pragma unroll
    for (int j = 1; j < 16; ++j) g[j] += g[j - 1];
    Tot[sg * 128 + d] = g[15];
#pragma unroll
    for (int it = 0; it < 2; ++it) {
        const int idx = it * 512 + tid, j = idx >> 4, e0 = (idx & 15) * 8;
        const u32x4 raw = *(const u32x4*)(Ig + (r0 + j) * 512 + h * 128 + e0);
        const unsigned rw[4] = {raw.x, raw.y, raw.z, raw.w};
#pragma unroll
        for (int e = 0; e < 8; ++e) Vt[(e0 + e) * LDV + j] = (bf16_t)((rw[e >> 1] >> ((e & 1) * 16)) & 0xffffu);
    }
    __syncthreads();
    float off = 0.f;
#pragma unroll
    for (int s = 0; s < 3; ++s) off += (s < sg) ? Tot[s * 128 + d] : 0.f;
#pragma unroll
    for (int j = 0; j < 16; ++j) { g[j] += off; gp[(size_t)j * 512] = g[j]; Gs[(sg * 16 + j) * LDG + d] = g[j]; }
    __syncthreads();
#pragma unroll
    for (int it = 0; it < 2; ++it) {
        const int idx = it * 512 + tid, j = idx >> 4, d0 = (idx & 15) * 8;
        float kv[8]; unpack8(*(const u32x4*)(Kg + (r0 + j) * 512 + h * 128 + d0), kv);
#pragma unroll
        for (int e = 0; e < 8; ++e) Kt[(d0 + e) * LDV + j] = (bf16_t)f2bf(kv[e] * fexp2(Gs[63 * LDG + d0 + e] - Gs[j * LDG + d0 + e]));
    }
    if (tid < 128) ((float*)(a.ws + WS_DEC))[(size_t)unit * 128 + tid] = fexp2(Gs[63 * LDG + tid]);
    __syncthreads();
    bf16x8 af[2];
#pragma unroll
    for (int ks = 0; ks < 2; ++ks) af[ks] = ldfrag(Vt + (w * 16) * LDV, LDV, fr, fq, ks * 32);
    float* STg = (float*)(a.ws + WS_ST) + (size_t)unit * 16384;
#pragma unroll
    for (int dt = 0; dt < 8; ++dt) {
        f32x4 acc = {0.f, 0.f, 0.f, 0.f};
#pragma unroll
        for (int ks = 0; ks < 2; ++ks) acc = MMA16(ldfrag(Kt + (dt * 16) * LDV, LDV, fr, fq, ks * 32), af[ks], acc);
        *(f32x4*)(STg + (w * 16 + fr) * 128 + dt * 16 + 4 * fq) = acc;
    }
    __syncthreads();
}

__device__ __forceinline__ void hg_scan(const Args& a) {
    float* ST = (float*)(a.ws + WS_ST); const float* DEC = (const float*)(a.ws + WS_DEC);
    for (int idx = blockIdx.x * 512 + opaque_tid(); idx < 8 * 16384; idx += gridDim.x * 512) {
        const int bh = idx >> 14, ed = idx & 16383, d = ed & 127;
        float* p = ST + (size_t)bh * 128 * 16384 + ed; const float* dc = DEC + (size_t)bh * 128 * 128 + d;
        float S = 0.f;
#pragma unroll 8
        for (int c = 0; c < 128; ++c) { const float u = p[(size_t)c * 16384]; const float dec = dc[c * 128]; p[(size_t)c * 16384] = S; S = dec * S + u; }
    }
}

__device__ __forceinline__ void hg3_unit(const Args& a, LAS unsigned char* lds, int unit, int l) {
    const int tid = opaque_tid(), lane = tid & 63, w = tid >> 6, fr = lane & 15, fq = lane >> 4;
    const int c = unit & 127, bh = unit >> 7, h = bh & 3, b = bh >> 2;
    const size_t r0 = (size_t)b * SEQ + (size_t)c * 64;
    LAS float* Gs = (LAS float*)lds;
    LAS bf16_t* Qs = (LAS bf16_t*)(lds + 64 * LDG * 4);
    LAS bf16_t* Ks = Qs + 64 * LDQ;
    LAS bf16_t* Vt = Ks + 64 * LDQ;
    LAS bf16_t* As = Vt + 128 * LDV;
    LAS bf16_t* Sts = As + 64 * LDV;
    const float* GLg = (const float*)(a.ws + WS_GL); const bf16_t* Ig = (const bf16_t*)(a.ws + WS_I);
    const bf16_t* Qg = (const bf16_t*)(a.ws + WS_Q); const bf16_t* Kg = (const bf16_t*)(a.ws + WS_KK);
    const float* STg = (const float*)(a.ws + WS_ST) + (size_t)unit * 16384;
#pragma unroll
    for (int it = 0; it < 4; ++it) {
        const int idx = it * 512 + tid, j = idx >> 5, d4 = (idx & 31) * 4;
        *(LAS f32x4*)(Gs + j * LDG + d4) = *(const f32x4*)(GLg + (r0 + j) * 512 + h * 128 + d4);
    }
#pragma unroll
    for (int it = 0; it < 2; ++it) {
        const int idx = it * 512 + tid, j = idx >> 4, d0 = (idx & 15) * 8;
        *(LAS u32x4*)(Qs + j * LDQ + d0) = *(const u32x4*)(Qg + (r0 + j) * 512 + h * 128 + d0);
        *(LAS u32x4*)(Ks + j * LDQ + d0) = *(const u32x4*)(Kg + (r0 + j) * 512 + h * 128 + d0);
        const u32x4 raw = *(const u32x4*)(Ig + (r0 + j) * 512 + h * 128 + d0);
        const unsigned rw[4] = {raw.x, raw.y, raw.z, raw.w};
#pragma unroll
        for (int e = 0; e < 8; ++e) Vt[(d0 + e) * LDV + j] = (bf16_t)((rw[e >> 1] >> ((e & 1) * 16)) & 0xffffu);
    }
#pragma unroll
    for (int it = 0; it < 8; ++it) {
        const int idx = it * 512 + tid, e = idx >> 5, d4 = (idx & 31) * 4;
        const f32x4 s = *(const f32x4*)(STg + e * 128 + d4);
        u32x2 o; o.x = pk2(s[0], s[1]); o.y = pk2(s[2], s[3]);
        *(LAS u32x2*)(Sts + e * LDQ + d4) = o;
    }
    __syncthreads();
    {
        const int il = lane >> 4, jg = lane & 15;
#pragma unroll 1
        for (int gi = 0; gi < 2; ++gi) {
            const int g = gi ? 15 - w : w, i = 4 * g + il, nj = ((4 * g + 3) >> 4) + 1;
            float ac[4] = {0.f, 0.f, 0.f, 0.f};
#pragma unroll 2
            for (int d0 = 0; d0 < 128; d0 += 8) {
                float qv[8]; unpack8(*(const LAS u32x4*)(Qs + i * LDQ + d0), qv);
                const f32x4 gi0 = *(const LAS f32x4*)(Gs + i * LDG + d0), gi1 = *(const LAS f32x4*)(Gs + i * LDG + d0 + 4);
                const float giv[8] = {gi0[0], gi0[1], gi0[2], gi0[3], gi1[0], gi1[1], gi1[2], gi1[3]};
#pragma unroll
                for (int jj = 0; jj < 4; ++jj) {
                    if (jj < nj) {
                        const int j = jj * 16 + jg;
                        float kv[8]; unpack8(*(const LAS u32x4*)(Ks + j * LDQ + d0), kv);
                        const f32x4 gj0 = *(const LAS f32x4*)(Gs + j * LDG + d0), gj1 = *(const LAS f32x4*)(Gs + j * LDG + d0 + 4);
                        const float gjv[8] = {gj0[0], gj0[1], gj0[2], gj0[3], gj1[0], gj1[1], gj1[2], gj1[3]};
#pragma unroll
                        for (int e = 0; e < 8; ++e) ac[jj] += (qv[e] * kv[e]) * fexp2(fminf(giv[e] - gjv[e], 0.f));
                    }
                }
            }
#pragma unroll
            for (int jj = 0; jj < 4; ++jj) { const int j = jj * 16 + jg; As[i * LDV + j] = (bf16_t)f2bf((jj < nj && j <= i) ? ac[jj] : 0.f); }
        }
    }
    __syncthreads();
#pragma unroll
    for (int it = 0; it < 2; ++it) {
        const int idx = it * 512 + tid, j = idx >> 4, d0 = (idx & 15) * 8;
        float qv[8]; unpack8(*(const LAS u32x4*)(Qs + j * LDQ + d0), qv);
        const f32x4 g0 = *(const LAS f32x4*)(Gs + j * LDG + d0), g1 = *(const LAS f32x4*)(Gs + j * LDG + d0 + 4);
        u32x4 o; o.x = pk2(qv[0] * fexp2(g0[0]), qv[1] * fexp2(g0[1])); o.y = pk2(qv[2] * fexp2(g0[2]), qv[3] * fexp2(g0[3]));
        o.z = pk2(qv[4] * fexp2(g1[0]), qv[5] * fexp2(g1[1])); o.w = pk2(qv[6] * fexp2(g1[2]), qv[7] * fexp2(g1[3]));
        *(LAS u32x4*)(Qs + j * LDQ + d0) = o;
    }
    __syncthreads();
    {
        const int it = w & 3, eb = (w >> 2) * 4;
        bf16x8 af[2], qf[4];
#pragma unroll
        for (int ks = 0; ks < 2; ++ks) af[ks] = ldfrag(As + (it * 16) * LDV, LDV, fr, fq, ks * 32);
#pragma unroll
        for (int ks = 0; ks < 4; ++ks) qf[ks] = ldfrag(Qs + (it * 16) * LDQ, LDQ, fr, fq, ks * 32);
#pragma unroll
        for (int t = 0; t < 4; ++t) {
            const int et = eb + t; f32x4 acc = {0.f, 0.f, 0.f, 0.f};
#pragma unroll
            for (int ks = 0; ks < 2; ++ks) acc = MMA16(ldfrag(Vt + (et * 16) * LDV, LDV, fr, fq, ks * 32), af[ks], acc);
#pragma unroll
            for (int ks = 0; ks < 4; ++ks) acc = MMA16(ldfrag(Sts + (et * 16) * LDQ, LDQ, fr, fq, ks * 32), qf[ks], acc);
            *(LAS f32x4*)(Gs + (it * 16 + fr) * LDG + et * 16 + 4 * fq) = acc;
        }
    }
    __syncthreads();
    {
        bf16_t* OGg = (bf16_t*)(a.ws + WS_OG);
        const f32x2 ng = *(const f32x2*)(a.hg_norm_g + l * 128 + 2 * lane);
#pragma unroll
        for (int rr = 0; rr < 8; ++rr) {
            const int i = w * 8 + rr;
            const f32x2 o = *(const LAS f32x2*)(Gs + i * LDG + 2 * lane);
            const float r = rsqrtf(wave_sum(o.x * o.x + o.y * o.y) * (1.f / 128.f) + EPS);
            unsigned* op = (unsigned*)(OGg + (r0 + i) * 512 + h * 128 + 2 * lane);
            const unsigned og = *op;
            *op = pk2(o.x * r * ng.x * bf2f(og & 0xffffu), o.y * r * ng.y * bf2f(og >> 16));
        }
    }
    __syncthreads();
}

__device__ __forceinline__ void conv_act(const Args& a, int l) {
    const bf16_t* Z = (const bf16_t*)(a.ws + WS_Z); bf16_t* AC = (bf16_t*)(a.ws + WS_AC);
    const float* cw = a.conv_w + (size_t)l * 3 * NUP; const float* cb = a.conv_b + (size_t)l * NUP;
    constexpr int CCH = DFF / 8, NITEM = (M / 8) * CCH;
    for (int item = blockIdx.x * 512 + opaque_tid(); item < NITEM; item += gridDim.x * 512) {
        const int cc = item % CCH, rb = item / CCH, c = cc * 8, m0 = rb * 8, t0 = m0 & (SEQ - 1);
        float wg[3][8], wv[3][8], bg[8], bv[8];
#pragma unroll
        for (int t = 0; t < 3; ++t) {
            const f32x4 x0 = *(const f32x4*)(cw + t * NUP + c), x1 = *(const f32x4*)(cw + t * NUP + c + 4);
            const f32x4 y0 = *(const f32x4*)(cw + t * NUP + DFF + c), y1 = *(const f32x4*)(cw + t * NUP + DFF + c + 4);
#pragma unroll
            for (int e = 0; e < 4; ++e) { wg[t][e] = x0[e]; wg[t][4 + e] = x1[e]; wv[t][e] = y0[e]; wv[t][4 + e] = y1[e]; }
        }
        { const f32x4 x0 = *(const f32x4*)(cb + c), x1 = *(const f32x4*)(cb + c + 4), y0 = *(const f32x4*)(cb + DFF + c), y1 = *(const f32x4*)(cb + DFF + c + 4);
#pragma unroll
          for (int e = 0; e < 4; ++e) { bg[e] = x0[e]; bg[4 + e] = x1[e]; bv[e] = y0[e]; bv[4 + e] = y1[e]; } }
        float g2[8], g1[8], v2[8], v1[8];
        if (t0 == 0) {
#pragma unroll
            for (int e = 0; e < 8; ++e) { g2[e] = 0.f; g1[e] = 0.f; v2[e] = 0.f; v1[e] = 0.f; }
        } else {
            unpack8(*(const u32x4*)(Z + (size_t)(m0 - 2) * NUP + c), g2); unpack8(*(const u32x4*)(Z + (size_t)(m0 - 1) * NUP + c), g1);
            unpack8(*(const u32x4*)(Z + (size_t)(m0 - 2) * NUP + DFF + c), v2); unpack8(*(const u32x4*)(Z + (size_t)(m0 - 1) * NUP + DFF + c), v1);
        }
#pragma unroll
        for (int r = 0; r < 8; ++r) {
            float g0[8], v0[8];
            unpack8(*(const u32x4*)(Z + (size_t)(m0 + r) * NUP + c), g0); unpack8(*(const u32x4*)(Z + (size_t)(m0 + r) * NUP + DFF + c), v0);
            float o[8];
#pragma unroll
            for (int e = 0; e < 8; ++e) {
                const float zg = bg[e] + wg[0][e] * g2[e] + wg[1][e] * g1[e] + wg[2][e] * g0[e];
                const float zv = bv[e] + wv[0][e] * v2[e] + wv[1][e] * v1[e] + wv[2][e] * v0[e];
                o[e] = silu(zg) * zv;
                g2[e] = g1[e]; g1[e] = g0[e]; v2[e] = v1[e]; v1[e] = v0[e];
            }
            u32x4 w; w.x = pk2(o[0], o[1]); w.y = pk2(o[2], o[3]); w.z = pk2(o[4], o[5]); w.w = pk2(o[6], o[7]);
            *(u32x4*)(AC + (size_t)(m0 + r) * DFF + c) = w;
        }
    }
}

__device__ __forceinline__ void prologue(const Args& a, LAS unsigned char* lds) {
    const int tid = opaque_tid(), lane = tid & 63, wave = tid >> 6;
    if (blockIdx.x == 0) {
        float* LB = (float*)(a.ws + WS_LB);
        for (int c = tid; c < 512; c += 512) {
            const float x0 = a.hg_lb[c], x1 = a.hg_lb[512 + c], x2 = a.hg_lb[1024 + c], x3 = a.hg_lb[1536 + c];
            const float mx = fmaxf(fmaxf(x0, x1), fmaxf(x2, x3));
            const float e0 = __expf(x0 - mx), e1 = __expf(x1 - mx), e2 = __expf(x2 - mx), e3 = __expf(x3 - mx), inv = 1.f / (e0 + e1 + e2 + e3);
            const float p1 = e1 * inv, p2 = e2 * inv, p3 = e3 * inv;
            LB[c] = 0.f; LB[512 + c] = fminf(fmaxf(p1, 0.f), 0.999f); LB[1024 + c] = fminf(fmaxf(p1 + p2, 0.f), 0.999f); LB[1536 + c] = fminf(fmaxf(p1 + p2 + p3, 0.f), 0.999f);
        }
    }
    convert_set(a, lds, 0, 0);
    convert_set(a, lds, 1, 0);
    const int gw = blockIdx.x * 8 + wave, NGW = gridDim.x * 8;
    bf16_t* XN = (bf16_t*)(a.ws + WS_XN); float* ssq = (float*)(a.ws + WS_SSQ);
    for (int m = gw; m < M; m += NGW) {
        const f32x4* xr = (const f32x4*)(a.x + (size_t)m * D) + lane; f32x4* orow = (f32x4*)(a.out + (size_t)m * D) + lane;
        const f32x4* gr = (const f32x4*)a.mix_norm + lane; u32x2* xnr = (u32x2*)(XN + (size_t)m * D) + lane;
        float s = 0.f;
#pragma unroll
        for (int j = 0; j < 4; ++j) { const f32x4 v = xr[64 * j], g = gr[64 * j]; orow[64 * j] = v; s += (v.x * v.x + v.y * v.y) + (v.z * v.z + v.w * v.w);
            u32x2 o; o.x = pk2(v.x * g.x, v.y * g.y); o.y = pk2(v.z * g.z, v.w * g.w); xnr[64 * j] = o; }
        s = wave_sum(s);
        if (lane < 16) ssq[(size_t)m * 16 + lane] = lane == 0 ? s : 0.f;
    }
}
__device__ __forceinline__ void final_norm(const Args& a) {
    const int tid = opaque_tid(), lane = tid & 63, wave = tid >> 6;
    const int gw = blockIdx.x * 8 + wave, NGW = gridDim.x * 8;
    const float* ssq = (const float*)(a.ws + WS_SSQ);
    for (int m = gw; m < M; m += NGW) {
        const float r = rowscale(ssq, m);
        f32x4* orow = (f32x4*)(a.out + (size_t)m * D) + lane; const f32x4* gr = (const f32x4*)a.final_norm + lane;
#pragma unroll
        for (int j = 0; j < 4; ++j) { const f32x4 v = orow[64 * j], g = gr[64 * j]; orow[64 * j] = (f32x4){v.x * r * g.x, v.y * r * g.y, v.z * r * g.z, v.w * r * g.w}; }
    }
}

#define XB_TMO      128
#define XB_XCNT(j)  (256  + 64 * (j))
#define XB_XSUB(j)  (1280 + 64 * (j))
#define XB_XGEN(j)  (2304 + 64 * (j))
#define XB_TOP      3328
#define XB_TOPGEN   3392
#define XCD_BAR_WORDS 3456
#define XB_SPIN_CAP (1u << 18)

__device__ __forceinline__ unsigned xb_ld(unsigned* p)              { return __hip_atomic_load(p, __ATOMIC_RELAXED, __HIP_MEMORY_SCOPE_AGENT); }
__device__ __forceinline__ unsigned xb_add(unsigned* p, unsigned v) { return __hip_atomic_fetch_add(p, v, __ATOMIC_RELAXED, __HIP_MEMORY_SCOPE_AGENT); }
__device__ __forceinline__ unsigned xb_xcc_id() { return (unsigned)__builtin_amdgcn_s_getreg((3 << 11) | 20) & 0xFu; }
#define XB_SPIN(cond, bar) do { unsigned _sp = 0; while (cond) { __builtin_amdgcn_s_sleep(1); \
    if ((++_sp & 255u) == 0u) { if (xb_ld(&(bar)[XB_TMO])) break; if (_sp > XB_SPIN_CAP) { atomicAdd(&(bar)[XB_TMO], 1u); break; } } } } while (0)

struct XcdBarrier {
    unsigned* bar; unsigned x;
    volatile LAS unsigned* st;
};

__device__ __forceinline__ XcdBarrier xcd_barrier_post(unsigned* bar, volatile LAS unsigned* st) {
    XcdBarrier b; b.bar = bar; b.x = xb_xcc_id(); b.st = st;
    if (threadIdx.x == 0) (void)xb_add(&bar[XB_XCNT(b.x)], 1u);
    return b;
}
__device__ __forceinline__ void xcd_barrier_complete(unsigned* bar, unsigned x, unsigned& nloc, unsigned& nx) {
    const unsigned G = gridDim.x * gridDim.y * gridDim.z;
    unsigned sum, cnt, mine, sp = 0u;
    for (;;) {
        sum = 0u; cnt = 0u; mine = 0u;
#pragma unroll
        for (unsigned j = 0; j < 16; ++j) { const unsigned c = xb_ld(&bar[XB_XCNT(j)]); sum += c; cnt += (c > 0u) ? 1u : 0u; mine = (j == x) ? c : mine; }
        if (sum == G) break;
        __builtin_amdgcn_s_sleep(1);
        if ((++sp & 255u) == 0u) { if (xb_ld(&bar[XB_TMO])) break; if (sp > XB_SPIN_CAP) { atomicAdd(&bar[XB_TMO], 1u); break; } }
    }
    nloc = mine > 0u ? mine : 1u; nx = cnt > 0u ? cnt : 1u;
}

__device__ __forceinline__ void xcd_barrier(const XcdBarrier& b) {
    asm volatile("s_waitcnt vmcnt(0)" ::: "memory");
    __syncthreads();
    if (threadIdx.x == 0) {
        unsigned* bar = b.bar;
        __builtin_amdgcn_s_waitcnt(0);
        unsigned nloc = b.st[0], nx = b.st[1];
        if (nloc == 0u) { xcd_barrier_complete(bar, b.x, nloc, nx); b.st[0] = nloc; b.st[1] = nx; }
        const unsigned old = xb_add(&bar[XB_XSUB(b.x)], 1u);
        const unsigned gen = old / nloc;
        if (old + 1u == (gen + 1u) * nloc) {
            __builtin_amdgcn_fence(__ATOMIC_RELEASE, "agent");
            asm volatile("s_waitcnt vmcnt(0)" ::: "memory");
            const unsigned og = xb_add(&bar[XB_TOP], 1u);
            const unsigned tg = og / nx;
            if (og + 1u == (tg + 1u) * nx) xb_add(&bar[XB_TOPGEN], 1u);
            else XB_SPIN(xb_ld(&bar[XB_TOPGEN]) == tg, bar);
            __builtin_amdgcn_fence(__ATOMIC_ACQUIRE, "agent");
            xb_add(&bar[XB_XGEN(b.x)], 1u);
            asm volatile("s_waitcnt vmcnt(0)" ::: "memory");
        } else {
            XB_SPIN(xb_ld(&bar[XB_XGEN(b.x)]) == gen, bar);
            __builtin_amdgcn_fence(__ATOMIC_ACQUIRE, "agent");
            asm volatile("s_waitcnt vmcnt(0)" ::: "memory");
        }
    }
    __syncthreads();
}

__global__ void __launch_bounds__(512, 2) trunk_fwd(Args a) {
    extern __shared__ __attribute__((aligned(16))) unsigned char lds_raw[];
    LAS unsigned char* lds = (LAS unsigned char*)lds_raw;
    cg::grid_group grid = cg::this_grid();
    if (threadIdx.x < 64) ((LAS unsigned*)(lds + 131072 + 256))[threadIdx.x] = 0u;
    __syncthreads();
    XcdBarrier bar = xcd_barrier_post((unsigned*)a.ws + 4096, (volatile LAS unsigned*)(lds + 131072 + 256));
    unsigned char* ws = a.ws;
    const int G = gridDim.x, bx = blockIdx.x;
    bf16_t* XN; float* ssq;

#ifndef PH
#define PH 0xFFFF
#endif
    if (PH & 1) prologue(a, lds);
    grid.sync();
#define LAUNDER(p) asm volatile("" : "+s"(p))
#pragma unroll 1
    for (int l = 0; l < DEPTH; ++l) {
        if (PH & 2) { LAUNDER(ws); XN = (bf16_t*)(ws + WS_XN); ssq = (float*)(ws + WS_SSQ);
            pg8::Gemm g{XN, (const bf16_t*)(ws + WS_WIN), M, INC, D}; pg8::StaticOrder S; S.init(M, INC, G, bx);
            EpiIn E{(bf16_t*)(ws + WS_U), (bf16_t*)(ws + WS_V), (bf16_t*)(ws + WS_Q), (bf16_t*)(ws + WS_KK), (bf16_t*)(ws + WS_I), (bf16_t*)(ws + WS_OG), (bf16_t*)(ws + WS_GT),
                    (float*)(ws + WS_GL), ssq, (const float*)(ws + WS_LB) + l * 512};
            pg8::gemm_phase<EpiIn, pg8::StaticOrder, true, true>(lds, g, S, E);
        }
        xcd_barrier(bar);
        if (PH & 4) for (int u = bx; u < 1536; u += G) { if (u < 1024) hg1_unit(a, lds, u); else gmlp_unit(a, lds, u - 1024, l); }
        xcd_barrier(bar);
        if (PH & 8) { hg_scan(a);
        if (l > 0) convert_set(a, lds, 1, l); }
        xcd_barrier(bar);
        if (PH & 16) for (int u = bx; u < 1024; u += G) hg3_unit(a, lds, u, l);
        xcd_barrier(bar);
        if (PH & 32) { LAUNDER(ws);
            pg8::StaticOrder S; S.init(M, D, G, bx);
            pg8::Gemm g1{(const bf16_t*)(ws + WS_U), (const bf16_t*)(ws + WS_WGM), M, D, 512};
            EpiBr<false> E1{(bf16_t*)(ws + WS_Y), (const bf16_t*)(ws + WS_GT), 0};
            pg8::gemm_phase<EpiBr<false>, pg8::StaticOrder, true, true>(lds, g1, S, E1);
            pg8::Gemm g2{(const bf16_t*)(ws + WS_OG), (const bf16_t*)(ws + WS_WHG), M, D, 512};
            EpiBr<true> E2{(bf16_t*)(ws + WS_Y), (const bf16_t*)(ws + WS_GT), 1024};
            pg8::gemm_phase<EpiBr<true>, pg8::StaticOrder, true, true>(lds, g2, S, E2);
        }
        xcd_barrier(bar);
        if (PH & 64) { LAUNDER(ws); XN = (bf16_t*)(ws + WS_XN); ssq = (float*)(ws + WS_SSQ); float* xo = a.out; LAUNDER(xo);
            pg8::Gemm g{(const bf16_t*)(ws + WS_Y), (const bf16_t*)(ws + WS_WOUT), M, D, D}; pg8::StaticOrder S; S.init(M, D, G, bx);
            EpiRes E{xo, XN, a.ffn_norm + l * D, ssq};
            pg8::gemm_phase<EpiRes, pg8::StaticOrder, true, true>(lds, g, S, E);
        }
        xcd_barrier(bar);
        if (PH & 128) { LAUNDER(ws); XN = (bf16_t*)(ws + WS_XN); ssq = (float*)(ws + WS_SSQ);
            pg8::Gemm g{XN, (const bf16_t*)(ws + WS_WUP), M, NUP, D}; pg8::StaticOrder S; S.init(M, NUP, G, bx);
            EpiZ E{(bf16_t*)(ws + WS_Z), ssq};
            pg8::gemm_phase<EpiZ, pg8::StaticOrder, true, true>(lds, g, S, E);
        }
        xcd_barrier(bar);
        if (PH & 256) { conv_act(a, l);
        if (l + 1 < DEPTH) convert_set(a, lds, 0, l + 1); }
        xcd_barrier(bar);
        if (PH & 512) { LAUNDER(ws); XN = (bf16_t*)(ws + WS_XN); ssq = (float*)(ws + WS_SSQ); float* xo = a.out; LAUNDER(xo);
            pg8::Gemm g{(const bf16_t*)(ws + WS_AC), (const bf16_t*)(ws + WS_WDN), M, D, DFF}; pg8::StaticOrder S; S.init(M, D, G, bx);
            EpiRes E{xo, XN, l + 1 < DEPTH ? a.mix_norm + (l + 1) * D : a.final_norm, ssq};
            pg8::gemm_phase<EpiRes, pg8::StaticOrder, true, true>(lds, g, S, E);
        }
        xcd_barrier(bar);
    }
    if (PH & 1024) final_norm(a);
}

extern "C" void kernel_launch(void* const* d_in, const int* in_sizes, int n_in, void* d_out, int out_size, void* d_ws, size_t ws_size, hipStream_t stream) {
    static int grid = 0;
    if (grid == 0) {
        if (n_in != 18 || out_size != M * D || ws_size < WS_NEED) { fprintf(stderr, "kernel_launch: unexpected shapes (n_in %d, out %d, ws %zu < %zu)\n", n_in, out_size, ws_size, (size_t)WS_NEED); grid = -1; return; }
        int dev = 0, cus = 0, per_cu = 0;
        hipGetDevice(&dev); hipDeviceGetAttribute(&cus, hipDeviceAttributeMultiprocessorCount, dev);
        if (hipFuncSetAttribute((const void*)trunk_fwd, hipFuncAttributeMaxDynamicSharedMemorySize, LDS_BYTES) != hipSuccess) { fprintf(stderr, "kernel_launch: hipFuncSetAttribute failed\n"); grid = -1; return; }
        if (hipOccupancyMaxActiveBlocksPerMultiprocessor(&per_cu, (const void*)trunk_fwd, 512, LDS_BYTES) != hipSuccess || per_cu < 1) { fprintf(stderr, "kernel_launch: occupancy query says %d\n", per_cu); per_cu = 1; }
        (void)hipGetLastError();
        grid = cus * 1;
    }
    if (grid < 0) return;
    if (hipMemsetAsync(d_ws, 0, 65536, stream) != hipSuccess) { fprintf(stderr, "kernel_launch: memset failed\n"); return; }
    Args a{};
    const float** ap = (const float**)&a;
    for (int i = 0; i < 18; ++i) ap[i] = (const float*)d_in[i];
    a.out = (float*)d_out; a.ws = (unsigned char*)d_ws;
    void* args[] = {&a};
    hipError_t e = hipLaunchCooperativeKernel((const void*)trunk_fwd, dim3(grid), dim3(512), args, LDS_BYTES, stream);
    if (e != hipSuccess) fprintf(stderr, "cooperative launch failed: %s (grid %d)\n", hipGetErrorString(e), grid);
}
```

```cpp
#include <hip/hip_runtime.h>
#include <hip/hip_cooperative_groups.h>
#include <cstdio>
#include <cstdint>
namespace cg = cooperative_groups;
namespace pg8 {
#define PG8_LAS __attribute__((address_space(3)))
typedef unsigned short bf16_t;
typedef short bf16x8 __attribute__((ext_vector_type(8)));
typedef float f32x4 __attribute__((ext_vector_type(4)));
typedef unsigned u32x4 __attribute__((ext_vector_type(4)));
constexpr int BM = 256, BK = 64, HALF = 128, HTB = HALF * BK * 2  , STAGE_BYTES = 8 * HTB, NXCD = 8, WGM = 8;

__host__ __device__ __forceinline__ int lds_byte(int r, int c) { const int st = (r >> 4) * 2 + (c >> 5), rr = r & 15, cc = c & 31, ob = rr * 64 + cc * 2; return st * 1024 + (ob ^ (((ob >> 9) & 1) << 5)); }
__host__ __device__ __forceinline__ void stage_rc(int b, int& R, int& C) { const int st = b / 1024, sb = b % 1024, swz = sb ^ (((sb >> 9) & 1) << 5); R = (st >> 1) * 16 + swz / 64; C = (st & 1) * 32 + (swz % 64) / 2; }
__host__ __device__ __forceinline__ int perm32(int rho) { const int n = rho >> 4, i = rho & 15; return 8 * (i >> 2) + 4 * n + (i & 3); }

struct Unit { int pm, pn; };
struct Gemm { const bf16_t* A; const bf16_t* Bt; int M, N, K; };

struct StaticOrder {
    int nM, nN, nwg, G, c;
    __host__ __device__ void init(int M, int N, int G_, int c_) { nM = M / BM; nN = N / BM; nwg = nM * nN; G = G_; c = c_; }
    __host__ __device__ bool next(int i, Unit& u) const {
        const long L = (long)i * G + c; if (L >= nwg) return false;
        int wgid = (int)L; { const int q = nwg / NXCD, r = nwg % NXCD, xcd = wgid % NXCD, off = wgid / NXCD; wgid = (xcd < r ? xcd * (q + 1) : r * (q + 1) + (xcd - r) * q) + off; }
        const int nig = WGM * nN, gid = wgid / nig, fm = gid * WGM, gsz = (nM - fm) < WGM ? (nM - fm) : WGM;
        u.pm = fm + ((wgid % nig) % gsz); u.pn = (wgid % nig) / gsz; return true;
    }
    __device__ __forceinline__ void a_ready(const Unit&) const {}
    __device__ __forceinline__ void done(const Unit&) const {}
};

__device__ __forceinline__ unsigned cvt_pk_bf16(float lo, float hi) { unsigned r; asm volatile("v_cvt_pk_bf16_f32 %0, %1, %2" : "=v"(r) : "v"(lo), "v"(hi)); return r; }
typedef float f32x2 __attribute__((ext_vector_type(2)));
__device__ __forceinline__ f32x2 gelu_pk(f32x2 v) {
    const f32x2 av = __builtin_elementwise_abs(v), d = av * 0.2316418882f + 1.0f;
    f32x2 t; t.x = __builtin_amdgcn_rcpf(d.x); t.y = __builtin_amdgcn_rcpf(d.y);
    f32x2 q = t * 0.5307027145f + (-0.7265760135f); q = q * t + 0.7107068705f; q = q * t + (-0.142248368f); q = q * t + 0.127414796f; q = q * t;
    const f32x2 s = (v * v) * (-0.72134752044f);
    f32x2 e; e.x = __builtin_amdgcn_exp2f(s.x); e.y = __builtin_amdgcn_exp2f(s.y);
    const f32x2 m = v * (q * e), r = v - m;
    f32x2 o; o.x = v.x < 0.f ? m.x : r.x; o.y = v.y < 0.f ? m.y : r.y; return o;
}

template <int ACT  > struct EpiBf16 {
    static constexpr bool PERM = true, AFTER_DRAIN = false; static_assert(ACT == 0 || ACT == 1, "EpiBf16: ACT is 0 (none) or 1 (gelu_pk)");
    bf16_t* O; int ldc; const float* bias; int split_cols; size_t split_stride; float scale0;
    __device__ __forceinline__ void operator()(const f32x4 (&acc)[2][2][4][2], const Unit& u, int wr, int wc, int fr, int fq) const {
        const int row0 = u.pm * BM + wr * 64 + fr; int colt = u.pn * BM; bf16_t* base = O;
        float sc = 1.f; if (split_cols) { const int t = colt / split_cols; base += (size_t)t * split_stride; colt -= t * split_cols; if (t == 0) sc = scale0; }
        const int col0 = colt + wc * 32 + 8 * fq, bcol0 = u.pn * BM + wc * 32 + 8 * fq;
        f32x4 bv[2][2];
#pragma unroll
        for (int bj = 0; bj < 2; ++bj)
#pragma unroll
            for (int n = 0; n < 2; ++n) bv[bj][n] = bias ? *(const f32x4*)(bias + bcol0 + bj * HALF + 4 * n) : (f32x4){0.f, 0.f, 0.f, 0.f};
#pragma unroll
        for (int ai = 0; ai < 2; ++ai)
#pragma unroll
            for (int m = 0; m < 4; ++m) { bf16_t* rowp = base + (size_t)(row0 + ai * HALF + m * 16) * ldc + col0;
#pragma unroll
                for (int bj = 0; bj < 2; ++bj) { f32x4 v0 = acc[ai][bj][m][0] + bv[bj][0], v1 = acc[ai][bj][m][1] + bv[bj][1];
                    if (ACT == 1) { f32x2 a = gelu_pk((f32x2){v0[0], v0[1]}), b = gelu_pk((f32x2){v0[2], v0[3]}), c = gelu_pk((f32x2){v1[0], v1[1]}), d = gelu_pk((f32x2){v1[2], v1[3]});
                        v0 = (f32x4){a.x, a.y, b.x, b.y}; v1 = (f32x4){c.x, c.y, d.x, d.y}; }
                    v0 = v0 * sc; v1 = v1 * sc; u32x4 w; w.x = cvt_pk_bf16(v0[0], v0[1]); w.y = cvt_pk_bf16(v0[2], v0[3]); w.z = cvt_pk_bf16(v1[0], v1[1]); w.w = cvt_pk_bf16(v1[2], v1[3]);
                    *(u32x4*)(rowp + bj * HALF) = w; } }
    }
};
template <class Epi, class Sched, bool ALIGN_EPI = false, bool SP2 = false>
__device__ __forceinline__ void gemm_phase(PG8_LAS unsigned char* lds, const Gemm g, const Sched& S, const Epi& E) {
    int tid_ = threadIdx.x; asm volatile("" : "+v"(tid_)); const int tid = tid_, wid = __builtin_amdgcn_readfirstlane(tid >> 6), lane = tid & 63, wr = wid >> 2, wc = wid & 3, fr = lane & 15, fq = lane >> 4;
    const int K = g.K, nt = K / BK;
    unsigned voffA[2], voffB[2];
#pragma unroll
    for (int i = 0; i < 2; ++i) { int R, C; stage_rc(tid * 16 + i * 8192, R, C); const int Rb = Epi::PERM ? ((R & ~31) + perm32(R & 31)) : R;
        voffA[i] = (unsigned)(R * K + C) * 2u; voffB[i] = (unsigned)(Rb * K + C) * 2u; }
    const size_t kstep = (size_t)(BK * 2);
    const size_t hstep = (size_t)HALF * K * 2;
    const size_t tstep = 2 * hstep;
    const unsigned ldsw = (unsigned)wid * 1024u;
    const int aoff = lds_byte(wr * 64 + fr, fq * 8), boff = lds_byte(wc * 32 + fr, fq * 8);
#define PG8_SA(b, h) (((b) * 2 + (h)) * HTB)
#define PG8_SB(b, h) ((4 + (b) * 2 + (h)) * HTB)
#define PG8_STAGE(bufoff, gbase, voff) do { _Pragma("unroll") for (int _i = 0; _i < 2; ++_i) \
        __builtin_amdgcn_global_load_lds((const unsigned*)((const char*)(gbase) + (voff)[_i]), (PG8_LAS unsigned*)(lds + (bufoff) + ldsw + _i * 8192), 16, 0, 0); } while (0)
#define PG8_LDA(dst, b, h) do { _Pragma("unroll") for (int m = 0; m < 4; ++m) _Pragma("unroll") for (int k = 0; k < 2; ++k) dst[m][k] = *(const PG8_LAS bf16x8*)(lds + PG8_SA(b, h) + aoff + m * 2048 + k * 1024); } while (0)
#define PG8_LDB(dst, b, h) do { _Pragma("unroll") for (int n = 0; n < 2; ++n) _Pragma("unroll") for (int k = 0; k < 2; ++k) dst[n][k] = *(const PG8_LAS bf16x8*)(lds + PG8_SB(b, h) + boff + n * 2048 + k * 1024); } while (0)
#define PG8_MMA(ai, bj, At, Bt) do { __builtin_amdgcn_s_setprio(1); _Pragma("unroll") for (int m = 0; m < 4; ++m) _Pragma("unroll") for (int n = 0; n < 2; ++n) _Pragma("unroll") for (int k = 0; k < 2; ++k) \
        acc[ai][bj][m][n] = __builtin_amdgcn_mfma_f32_16x16x32_bf16(Bt[n][k], At[m][k], acc[ai][bj][m][n], 0, 0, 0); __builtin_amdgcn_s_setprio(0); } while (0)
#define PG8_WAIT_V(n) asm volatile("s_waitcnt vmcnt(" #n ")" ::: "memory")
#define PG8_WAIT_L(n) asm volatile("s_waitcnt lgkmcnt(" #n ")" ::: "memory")
#define PG8_BAR __builtin_amdgcn_s_barrier()
#define PG8_SCHED __builtin_amdgcn_sched_barrier(0)
    Unit cur, nxt; int ui = 0;
    if (!S.next(0, cur)) return;
    f32x4 acc[2][2][4][2];
#pragma unroll
    for (int a = 0; a < 2; ++a)
#pragma unroll
        for (int b = 0; b < 2; ++b)
#pragma unroll
            for (int m = 0; m < 4; ++m)
#pragma unroll
                for (int n = 0; n < 2; ++n) acc[a][b][m][n] = (f32x4){0.f, 0.f, 0.f, 0.f};
    bf16x8 At[4][2], B0[2][2], B1[2][2];
    const char* cA = (const char*)g.A + (size_t)cur.pm * tstep; const char* cB = (const char*)g.Bt + (size_t)cur.pn * tstep;
    S.a_ready(cur);
    if constexpr (SP2) {
        PG8_STAGE(PG8_SB(0, 0), cB, voffB); PG8_STAGE(PG8_SB(0, 1), cB + hstep, voffB); PG8_STAGE(PG8_SA(0, 0), cA, voffA); PG8_STAGE(PG8_SA(0, 1), cA + hstep, voffA);
        if (wr == 1) PG8_BAR;
        PG8_WAIT_V(2); PG8_BAR;
        PG8_STAGE(PG8_SB(1, 0), cB + kstep, voffB); PG8_STAGE(PG8_SA(1, 0), cA + kstep, voffA); PG8_STAGE(PG8_SB(1, 1), cB + hstep + kstep, voffB);
        PG8_WAIT_V(6); PG8_BAR;
    } else {
        PG8_STAGE(PG8_SB(0, 0), cB, voffB); PG8_STAGE(PG8_SA(0, 0), cA, voffA); PG8_STAGE(PG8_SB(0, 1), cB + hstep, voffB); PG8_STAGE(PG8_SA(0, 1), cA + hstep, voffA);
        if (wr == 1) PG8_BAR;
        PG8_WAIT_V(4); PG8_BAR;
        PG8_STAGE(PG8_SB(1, 0), cB + kstep, voffB); PG8_STAGE(PG8_SA(1, 0), cA + kstep, voffA); PG8_STAGE(PG8_SB(1, 1), cB + hstep + kstep, voffB);
        PG8_WAIT_V(6); PG8_BAR;
    }
    for (;;) {
        const bool has_next = S.next(ui + 1, nxt);
        const char* nA = has_next ? (const char*)g.A + (size_t)nxt.pm * tstep : cA; const char* nB = has_next ? (const char*)g.Bt + (size_t)nxt.pn * tstep : cB;
        for (int t = 0; t < nt; t += 2) {
            const bool last = (t == nt - 2);
            const char* a1 = cA + (size_t)(t + 1) * kstep;
            const char* a2 = last ? nA : cA + (size_t)(t + 2) * kstep; const char* b2 = last ? nB : cB + (size_t)(t + 2) * kstep;
            const char* a3 = a2 + kstep; const char* b3 = b2 + kstep;
            if (last && has_next) S.a_ready(nxt);
            if constexpr (SP2) {
            PG8_LDB(B0, 0, 0); PG8_LDB(B1, 0, 1); PG8_SCHED; PG8_LDA(At, 0, 0); PG8_STAGE(PG8_SA(1, 1), a1 + hstep, voffA);
            PG8_WAIT_V(8); PG8_WAIT_L(0); PG8_BAR; PG8_MMA(0, 0, At, B0); PG8_MMA(0, 1, At, B1); PG8_BAR; PG8_SCHED;
            PG8_LDA(At, 0, 1); PG8_STAGE(PG8_SB(0, 0), b2, voffB); PG8_STAGE(PG8_SB(0, 1), b2 + hstep, voffB); PG8_STAGE(PG8_SA(0, 0), a2, voffA);
            PG8_WAIT_V(8); PG8_WAIT_L(0); PG8_BAR; PG8_MMA(1, 0, At, B0); PG8_MMA(1, 1, At, B1); PG8_BAR; PG8_SCHED;
            PG8_LDB(B0, 1, 0); PG8_LDB(B1, 1, 1); PG8_SCHED; PG8_LDA(At, 1, 0); PG8_STAGE(PG8_SA(0, 1), a2 + hstep, voffA);
            PG8_WAIT_V(8); PG8_WAIT_L(0); PG8_BAR; PG8_MMA(0, 0, At, B0); PG8_MMA(0, 1, At, B1); PG8_BAR; PG8_SCHED;
            PG8_LDA(At, 1, 1); PG8_STAGE(PG8_SB(1, 0), b3, voffB); PG8_STAGE(PG8_SB(1, 1), b3 + hstep, voffB); PG8_STAGE(PG8_SA(1, 0), a3, voffA);
            PG8_WAIT_V(8); PG8_WAIT_L(0); PG8_BAR; PG8_MMA(1, 0, At, B0); PG8_MMA(1, 1, At, B1); PG8_BAR; PG8_SCHED;
            } else {
            PG8_LDB(B0, 0, 0); PG8_SCHED; PG8_LDA(At, 0, 0); PG8_STAGE(PG8_SA(1, 1), a1 + hstep, voffA);
            PG8_WAIT_L(8); PG8_BAR; PG8_WAIT_L(0); PG8_MMA(0, 0, At, B0); PG8_BAR; PG8_SCHED;
            PG8_LDB(B1, 0, 1); PG8_STAGE(PG8_SB(0, 0), b2, voffB);
            PG8_BAR; PG8_WAIT_L(0); PG8_MMA(0, 1, At, B1); PG8_BAR;
            PG8_LDA(At, 0, 1); PG8_STAGE(PG8_SA(0, 0), a2, voffA);
            PG8_BAR; PG8_WAIT_L(0); PG8_MMA(1, 0, At, B0); PG8_BAR; PG8_SCHED;
            PG8_STAGE(PG8_SB(0, 1), b2 + hstep, voffB);
            PG8_WAIT_V(6); PG8_BAR; PG8_MMA(1, 1, At, B1); PG8_BAR;
            PG8_LDB(B0, 1, 0); PG8_SCHED; PG8_LDA(At, 1, 0); PG8_STAGE(PG8_SA(0, 1), a2 + hstep, voffA);
            PG8_WAIT_L(8); PG8_BAR; PG8_WAIT_L(0); PG8_MMA(0, 0, At, B0); PG8_BAR; PG8_SCHED;
            PG8_LDB(B1, 1, 1); PG8_STAGE(PG8_SB(1, 0), b3, voffB);
            PG8_BAR; PG8_WAIT_L(0); PG8_MMA(0, 1, At, B1); PG8_BAR;
            PG8_LDA(At, 1, 1); PG8_STAGE(PG8_SA(1, 0), a3, voffA);
            PG8_BAR; PG8_WAIT_L(0); PG8_MMA(1, 0, At, B0); PG8_BAR; PG8_SCHED;
            PG8_STAGE(PG8_SB(1, 1), b3 + hstep, voffB);
            PG8_WAIT_V(6); PG8_BAR; PG8_MMA(1, 1, At, B1); PG8_BAR;
            }
        }
        if constexpr (ALIGN_EPI) { if (wr == 0) PG8_BAR; }
        if constexpr (!Epi::AFTER_DRAIN) { E(acc, cur, wr, wc, fr, fq); S.done(cur); }
        if (!has_next) break;
#pragma unroll
        for (int a = 0; a < 2; ++a)
#pragma unroll
            for (int b = 0; b < 2; ++b)
#pragma unroll
                for (int m = 0; m < 4; ++m)
#pragma unroll
                    for (int n = 0; n < 2; ++n) acc[a][b][m][n] = (f32x4){0.f, 0.f, 0.f, 0.f};
        cur = nxt; cA = nA; cB = nB; ++ui;
        if constexpr (ALIGN_EPI) { if (wr == 1) PG8_BAR; }
    }
    PG8_WAIT_V(0);
    if constexpr (!ALIGN_EPI) { if (wr == 0) PG8_BAR; }
    PG8_BAR;
    if constexpr (Epi::AFTER_DRAIN) { E.fused(acc, cur, wr, wc, fr, fq, lds, wid, lane); S.done(cur); }
#undef PG8_SA
#undef PG8_SB
#undef PG8_STAGE
#undef PG8_LDA
#undef PG8_LDB
#undef PG8_MMA
#undef PG8_WAIT_V
#undef PG8_WAIT_L
#undef PG8_BAR
#undef PG8_SCHED
}
}
#define LAS __attribute__((address_space(3)))
__device__ __forceinline__ int opaque_tid() { int t = threadIdx.x; asm volatile("" : "+v"(t)); return t; }
using pg8::bf16_t; using pg8::bf16x8; using pg8::f32x4; using pg8::u32x4; using pg8::Unit;
typedef float f32x2 __attribute__((ext_vector_type(2)));
typedef unsigned u32x2 __attribute__((ext_vector_type(2)));

constexpr int NB = 2, SEQ = 8192, M = NB * SEQ, D = 1024, DEPTH = 4, INC = 5120, DFF = 2816, NUP = 2 * DFF;
constexpr float EPS = 1e-6f, LOG2E = 1.4426950408889634f;
constexpr size_t MiB = 1u << 20;
constexpr size_t WS_LB = 1 * MiB, WS_SSQ = 2 * MiB, WS_DEC = 3 * MiB;
constexpr size_t WS_WIN = 4 * MiB, WS_WGM = 14 * MiB, WS_WHG = 15 * MiB, WS_WOUT = 16 * MiB, WS_WUP = 18 * MiB, WS_WDN = 29 * MiB;
constexpr size_t WS_XN = 36 * MiB, WS_ACT0 = 68 * MiB;
constexpr size_t WS_U = WS_ACT0, WS_V = WS_U + 16 * MiB, WS_Q = WS_V + 16 * MiB, WS_KK = WS_Q + 16 * MiB, WS_GL = WS_KK + 16 * MiB, WS_I = WS_GL + 32 * MiB,
                 WS_OG = WS_I + 16 * MiB, WS_GT = WS_OG + 16 * MiB, WS_ST = WS_GT + 64 * MiB, WS_END1 = WS_ST + 64 * MiB;
constexpr size_t WS_Y = WS_Q;
constexpr size_t WS_Z = WS_ACT0, WS_AC = WS_Z + 176 * MiB, WS_END2 = WS_AC + 88 * MiB;
constexpr size_t WS_NEED = WS_END1 > WS_END2 ? WS_END1 : WS_END2;
constexpr int LDS_BYTES = 147456;

struct Args {
    const float *x, *mix_norm, *w_in, *gm_ln_g, *gm_ln_b, *gm_ws, *gm_bs, *hg_lb, *hg_norm_g, *w_br_gm, *w_br_hg, *w_out, *ffn_norm, *w_up, *conv_w, *conv_b, *w_down, *final_norm;
    float* out; unsigned char* ws;
};

__device__ __forceinline__ float bf2f(unsigned h) { return __uint_as_float(h << 16); }
__device__ __forceinline__ unsigned f2bf(float f) { unsigned u = __float_as_uint(f); return (u + 0x7fffu + ((u >> 16) & 1u)) >> 16; }
__device__ __forceinline__ unsigned pk2(float lo, float hi) { return pg8::cvt_pk_bf16(lo, hi); }
__device__ __forceinline__ float fexp2(float x) { return __builtin_amdgcn_exp2f(x); }
__device__ __forceinline__ float frcp(float x) { return __builtin_amdgcn_rcpf(x); }
__device__ __forceinline__ float sigm(float x) { return frcp(1.f + fexp2(-LOG2E * x)); }
__device__ __forceinline__ float silu(float x) { return x * sigm(x); }
__device__ __forceinline__ float wave_sum(float v) {
#pragma unroll
    for (int o = 1; o < 64; o <<= 1) v += __shfl_xor(v, o);
    return v;
}
__device__ __forceinline__ void unpack8(const u32x4 r, float (&x)[8]) {
    x[0] = bf2f(r.x & 0xffffu); x[1] = bf2f(r.x >> 16); x[2] = bf2f(r.y & 0xffffu); x[3] = bf2f(r.y >> 16);
    x[4] = bf2f(r.z & 0xffffu); x[5] = bf2f(r.z >> 16); x[6] = bf2f(r.w & 0xffffu); x[7] = bf2f(r.w >> 16);
}
__device__ __forceinline__ float rowscale(const float* ssq, int row) {
    const f32x4* p = (const f32x4*)(ssq + (size_t)row * 16); const f32x4 s = (p[0] + p[1]) + (p[2] + p[3]);
    return rsqrtf(((s.x + s.y) + (s.z + s.w)) * (1.f / 1024.f) + EPS);
}

struct EpiIn {
    static constexpr bool PERM = true, AFTER_DRAIN = false;
    bf16_t *U, *V, *Q, *KK, *I, *OG, *GT; float* GL; const float* ssq; const float* lb;
    template <int SEG> __device__ __forceinline__ void body(const f32x4 (&acc)[2][2][4][2], const Unit& u, int wr, int wc, int fr, int fq) const {
        const int row0 = u.pm * 256 + wr * 64 + fr, pn = u.pn;
        bf16_t* base; int ldc, colt;
        if (SEG == 6) { base = GT; ldc = 2048; colt = (pn - 12) * 256; }
        else { ldc = 512; colt = (pn & 1) * 256; base = SEG == 0 ? U : SEG == 1 ? V : SEG == 2 ? Q : SEG == 3 ? KK : SEG == 4 ? I : OG; }
        const int col0 = colt + wc * 32 + 8 * fq;
#pragma unroll
        for (int ai = 0; ai < 2; ++ai)
#pragma unroll
            for (int m = 0; m < 4; ++m) {
                const int row = row0 + ai * 128 + m * 16; const float r = rowscale(ssq, row);
#pragma unroll
                for (int bj = 0; bj < 2; ++bj) {
                    const int c = col0 + bj * 128;
                    f32x4 v0 = acc[ai][bj][m][0] * r, v1 = acc[ai][bj][m][1] * r;
                    float o[8] = {v0[0], v0[1], v0[2], v0[3], v1[0], v1[1], v1[2], v1[3]};
                    if (SEG == 0 || SEG == 1) {
#pragma unroll
                        for (int e = 0; e < 8; e += 2) { f32x2 g = pg8::gelu_pk((f32x2){o[e], o[e + 1]}); o[e] = g.x; o[e + 1] = g.y; }
                    } else if (SEG == 2 || SEG == 5) {
#pragma unroll
                        for (int e = 0; e < 8; ++e) o[e] = silu(o[e]);
                    } else if (SEG == 6) {
#pragma unroll
                        for (int e = 0; e < 8; ++e) o[e] = sigm(o[e]);
                    } else if (SEG == 3) {
                        const f32x4 l0 = *(const f32x4*)(lb + c), l1 = *(const f32x4*)(lb + c + 4);
                        const float lbv[8] = {l0[0], l0[1], l0[2], l0[3], l1[0], l1[1], l1[2], l1[3]};
                        float g2[8];
#pragma unroll
                        for (int e = 0; e < 8; ++e) {
                            const float f = fminf(fmaxf(o[e], -80.f), 80.f);
                            const float ex = fexp2(-LOG2E * f), sg = frcp(1.f + ex);
                            const float fg = lbv[e] + (1.f - lbv[e]) * sg;
                            g2[e] = __builtin_amdgcn_logf(fmaxf(fg, 1e-30f));
                            o[e] = (1.f - lbv[e]) * (ex * sg);
                        }
                        float* gp = GL + (size_t)row * 512 + c;
                        *(f32x4*)gp = (f32x4){g2[0], g2[1], g2[2], g2[3]}; *(f32x4*)(gp + 4) = (f32x4){g2[4], g2[5], g2[6], g2[7]};
                    }
                    u32x4 w; w.x = pk2(o[0], o[1]); w.y = pk2(o[2], o[3]); w.z = pk2(o[4], o[5]); w.w = pk2(o[6], o[7]);
                    *(u32x4*)(base + (size_t)row * ldc + c) = w;
                }
                asm volatile("" ::: "memory");
            }
    }
    __device__ __forceinline__ void operator()(const f32x4 (&acc)[2][2][4][2], const Unit& u, int wr, int wc, int fr, int fq) const {
        const int seg = u.pn < 12 ? (u.pn >> 1) : 6;
        switch (seg) {
            case 0: body<0>(acc, u, wr, wc, fr, fq); break;
            case 1: body<1>(acc, u, wr, wc, fr, fq); break;
            case 2: body<2>(acc, u, wr, wc, fr, fq); break;
            case 3: body<3>(acc, u, wr, wc, fr, fq); break;
            case 4: body<4>(acc, u, wr, wc, fr, fq); break;
            case 5: body<5>(acc, u, wr, wc, fr, fq); break;
            default: body<6>(acc, u, wr, wc, fr, fq); break;
        }
    }
};
template <bool ADD> struct EpiBr {
    static constexpr bool PERM = true, AFTER_DRAIN = false;
    bf16_t* Y; const bf16_t* GT; int goff;
    __device__ __forceinline__ void operator()(const f32x4 (&acc)[2][2][4][2], const Unit& u, int wr, int wc, int fr, int fq) const {
        const int row0 = u.pm * 256 + wr * 64 + fr, col0 = u.pn * 256 + wc * 32 + 8 * fq;
#pragma unroll
        for (int ai = 0; ai < 2; ++ai)
#pragma unroll
            for (int m = 0; m < 4; ++m) {
                const int row = row0 + ai * 128 + m * 16;
#pragma unroll
                for (int bj = 0; bj < 2; ++bj) {
                    const int c = col0 + bj * 128;
                    float g[8]; unpack8(*(const u32x4*)(GT + (size_t)row * 2048 + goff + c), g);
                    const f32x4 v0 = acc[ai][bj][m][0], v1 = acc[ai][bj][m][1];
                    float o[8] = {v0[0] * g[0], v0[1] * g[1], v0[2] * g[2], v0[3] * g[3], v1[0] * g[4], v1[1] * g[5], v1[2] * g[6], v1[3] * g[7]};
                    bf16_t* yp = Y + (size_t)row * 1024 + c;
                    if (ADD) { float y[8]; unpack8(*(const u32x4*)yp, y);
#pragma unroll
                        for (int e = 0; e < 8; ++e) o[e] += y[e]; }
                    u32x4 w; w.x = pk2(o[0], o[1]); w.y = pk2(o[2], o[3]); w.z = pk2(o[4], o[5]); w.w = pk2(o[6], o[7]);
                    *(u32x4*)yp = w;
                }
                asm volatile("" ::: "memory");
            }
    }
};
struct EpiRes {
    static constexpr bool PERM = false, AFTER_DRAIN = false;
    float* x; bf16_t* xn; const float* g; float* ssq;
    __device__ __forceinline__ void operator()(const f32x4 (&acc)[2][2][4][2], const Unit& u, int wr, int wc, int fr, int fq) const {
        const int row0 = u.pm * 256 + wr * 64 + fr, col0 = u.pn * 256 + wc * 32 + 4 * fq;
#pragma unroll
        for (int ai = 0; ai < 2; ++ai)
#pragma unroll
            for (int m = 0; m < 4; ++m) {
                const int row = row0 + ai * 128 + m * 16; float ss = 0.f;
#pragma unroll
                for (int bj = 0; bj < 2; ++bj)
#pragma unroll
                    for (int n = 0; n < 2; ++n) {
                        const int c = col0 + bj * 128 + n * 16;
                        float* xp = x + (size_t)row * 1024 + c;
                        f32x4 xo = *(const f32x4*)xp; xo = xo + acc[ai][bj][m][n]; *(f32x4*)xp = xo;
                        ss += (xo[0] * xo[0] + xo[1] * xo[1]) + (xo[2] * xo[2] + xo[3] * xo[3]);
                        const f32x4 gv = *(const f32x4*)(g + c);
                        u32x2 w; w.x = pk2(xo[0] * gv[0], xo[1] * gv[1]); w.y = pk2(xo[2] * gv[2], xo[3] * gv[3]);
                        *(u32x2*)(xn + (size_t)row * 1024 + c) = w;
                    }
                ss += __shfl_xor(ss, 16); ss += __shfl_xor(ss, 32);
                if (fq == 0) ssq[(size_t)row * 16 + u.pn * 4 + wc] = ss;
                asm volatile("" ::: "memory");
            }
    }
};
struct EpiZ {
    static constexpr bool PERM = true, AFTER_DRAIN = false;
    bf16_t* Z; const float* ssq;
    __device__ __forceinline__ void operator()(const f32x4 (&acc)[2][2][4][2], const Unit& u, int wr, int wc, int fr, int fq) const {
        const int row0 = u.pm * 256 + wr * 64 + fr, col0 = u.pn * 256 + wc * 32 + 8 * fq;
#pragma unroll
        for (int ai = 0; ai < 2; ++ai)
#pragma unroll
            for (int m = 0; m < 4; ++m) {
                const int row = row0 + ai * 128 + m * 16; const float r = rowscale(ssq, row);
#pragma unroll
                for (int bj = 0; bj < 2; ++bj) {
                    const f32x4 v0 = acc[ai][bj][m][0] * r, v1 = acc[ai][bj][m][1] * r;
                    u32x4 w; w.x = pk2(v0[0], v0[1]); w.y = pk2(v0[2], v0[3]); w.z = pk2(v1[0], v1[1]); w.w = pk2(v1[2], v1[3]);
                    *(u32x4*)(Z + (size_t)row * NUP + col0 + bj * 128) = w;
                }
                asm volatile("" ::: "memory");
            }
    }
};

__device__ __forceinline__ void transpose_item(const float* W, int K, int N, bf16_t* WT, LAS float* scr, int item, int lane) {
    const int nblk = N / 32, kb = item / nblk, nb = item % nblk, k0 = 64 * kb, n0 = 32 * nb;
#pragma unroll 8
    for (int i = 0; i < 32; ++i) { const int kk = 2 * i + (lane >> 5); scr[kk * 33 + (lane & 31)] = W[(size_t)(k0 + kk) * N + n0 + (lane & 31)]; }
    asm volatile("s_waitcnt lgkmcnt(0)" ::: "memory");
    const int c = lane & 7;
#pragma unroll
    for (int j = 0; j < 4; ++j) { const int n = (lane >> 3) + 8 * j; const LAS float* s = scr + (8 * c) * 33 + n;
        u32x4 o; o.x = pk2(s[0 * 33], s[1 * 33]); o.y = pk2(s[2 * 33], s[3 * 33]); o.z = pk2(s[4 * 33], s[5 * 33]); o.w = pk2(s[6 * 33], s[7 * 33]);
        *(u32x4*)(WT + (size_t)(n0 + n) * K + k0 + 8 * c) = o; }
    asm volatile("s_waitcnt lgkmcnt(0)" ::: "memory");
}
__device__ __forceinline__ void convert_set(const Args& a, LAS unsigned char* lds, int set, int l) {
    const int tid = opaque_tid(), lane = tid & 63, wave = tid >> 6;
    LAS float* scr = (LAS float*)(lds + wave * 16384);
    const int gw = blockIdx.x * 8 + wave, NGW = gridDim.x * 8;
    unsigned char* ws = a.ws;
    if (set == 0) {
        constexpr int I0 = (D / 64) * (INC / 32), I1 = (512 / 64) * (D / 32), I3 = (D / 64) * (D / 32), NI = I0 + 2 * I1 + I3;
        for (int it = gw; it < NI; it += NGW) {
            int r = it;
            if (r < I0) { transpose_item(a.w_in + (size_t)l * D * INC, D, INC, (bf16_t*)(ws + WS_WIN), scr, r, lane); continue; } r -= I0;
            if (r < I1) { transpose_item(a.w_br_gm + (size_t)l * 512 * D, 512, D, (bf16_t*)(ws + WS_WGM), scr, r, lane); continue; } r -= I1;
            if (r < I1) { transpose_item(a.w_br_hg + (size_t)l * 512 * D, 512, D, (bf16_t*)(ws + WS_WHG), scr, r, lane); continue; } r -= I1;
            transpose_item(a.w_out + (size_t)l * D * D, D, D, (bf16_t*)(ws + WS_WOUT), scr, r, lane);
        }
    } else {
        constexpr int I0 = (D / 64) * (NUP / 32), I1 = (DFF / 64) * (D / 32), NI = I0 + I1;
        for (int it = gw; it < NI; it += NGW) {
            int r = it;
            if (r < I0) { transpose_item(a.w_up + (size_t)l * D * NUP, D, NUP, (bf16_t*)(ws + WS_WUP), scr, r, lane); continue; } r -= I0;
            transpose_item(a.w_down + (size_t)l * DFF * D, DFF, D, (bf16_t*)(ws + WS_WDN), scr, r, lane);
        }
    }
}

constexpr int LDQ = 136, LDV = 72, LDG = 132;
__device__ __forceinline__ bf16x8 ldfrag(const LAS bf16_t* base, int ld, int fr, int fq, int k0) { return *(const LAS bf16x8*)(base + fr * ld + k0 + fq * 8); }
#define MMA16(xf, yf, acc) __builtin_amdgcn_mfma_f32_16x16x32_bf16((xf), (yf), (acc), 0, 0, 0)

__device__ __forceinline__ void gmlp_unit(const Args& a, LAS unsigned char* lds, int unit, int l) {
    const int tid = opaque_tid(), lane = tid & 63, w = tid >> 6, fr = lane & 15, fq = lane >> 4;
    const int h = unit & 3, blk = (unit >> 2) & 63, b = unit >> 8;
    const size_t r0 = (size_t)b * SEQ + (size_t)blk * 128;
    LAS bf16_t* Vt = (LAS bf16_t*)lds;
    LAS bf16_t* Wl = Vt + 128 * LDQ;
    const bf16_t* Vg = (const bf16_t*)(a.ws + WS_V); bf16_t* Ug = (bf16_t*)(a.ws + WS_U);
    const float* lng = a.gm_ln_g + l * 512; const float* lnb = a.gm_ln_b + l * 512;
    for (int rr = 0; rr < 16; ++rr) {
        const int j = w * 16 + rr;
        float x[8]; unpack8(*(const u32x4*)(Vg + (r0 + j) * 512 + lane * 8), x);
        float s = ((x[0] + x[1]) + (x[2] + x[3])) + ((x[4] + x[5]) + (x[6] + x[7]));
        const float mean = wave_sum(s) * (1.f / 512.f);
        float q = 0.f;
#pragma unroll
        for (int e = 0; e < 8; ++e) { x[e] -= mean; q += x[e] * x[e]; }
        const float rstd = rsqrtf(wave_sum(q) * (1.f / 512.f) + EPS);
        if ((lane >> 4) == h) {
            const int d0 = (lane & 15) * 8, cg0 = h * 128 + d0;
#pragma unroll
            for (int e = 0; e < 8; ++e) Vt[(d0 + e) * LDQ + j] = (bf16_t)f2bf(x[e] * rstd * lng[cg0 + e] + lnb[cg0 + e]);
        }
    }
    const float* wsrc = a.gm_ws + (size_t)(l * 4 + h) * 16384;
#pragma unroll
    for (int it = 0; it < 8; ++it) {
        const int idx = it * 512 + tid, i = idx >> 5, j4 = (idx & 31) * 4;
        f32x4 wv = *(const f32x4*)(wsrc + i * 128 + j4);
        if ((i >> 6) < (j4 >> 6)) wv = (f32x4){0.f, 0.f, 0.f, 0.f};
        u32x2 o; o.x = pk2(wv[0], wv[1]); o.y = pk2(wv[2], wv[3]);
        *(LAS u32x2*)(Wl + i * LDQ + j4) = o;
    }
    __syncthreads();
    bf16x8 af[4];
#pragma unroll
    for (int ks = 0; ks < 4; ++ks) af[ks] = ldfrag(Wl + (w * 16) * LDQ, LDQ, fr, fq, ks * 32);
    const int i = w * 16 + fr; const float bias = a.gm_bs[(l * 4 + h) * 128 + i];
#pragma unroll
    for (int dt = 0; dt < 8; ++dt) {
        f32x4 acc = {0.f, 0.f, 0.f, 0.f};
#pragma unroll
        for (int ks = 0; ks < 4; ++ks) acc = MMA16(ldfrag(Vt + (dt * 16) * LDQ, LDQ, fr, fq, ks * 32), af[ks], acc);
        bf16_t* up = Ug + (r0 + i) * 512 + h * 128 + dt * 16 + 4 * fq;
        const u32x2 uu = *(const u32x2*)up;
        u32x2 o; o.x = pk2(bf2f(uu.x & 0xffffu) * (acc[0] + bias), bf2f(uu.x >> 16) * (acc[1] + bias));
        o.y = pk2(bf2f(uu.y & 0xffffu) * (acc[2] + bias), bf2f(uu.y >> 16) * (acc[3] + bias));
        *(u32x2*)up = o;
    }
    __syncthreads();
}

__device__ __forceinline__ void hg1_unit(const Args& a, LAS unsigned char* lds, int unit) {
    const int tid = opaque_tid(), lane = tid & 63, w = tid >> 6, fr = lane & 15, fq = lane >> 4;
    const int c = unit & 127, bh = unit >> 7, h = bh & 3, b = bh >> 2;
    const size_t r0 = (size_t)b * SEQ + (size_t)c * 64;
    LAS float* Gs = (LAS float*)lds;
    LAS float* Tot = Gs + 64 * LDG;
    LAS bf16_t* Vt = (LAS bf16_t*)(lds + 64 * LDG * 4 + 2048);
    LAS bf16_t* Kt = Vt + 128 * LDV;
    float* GLg = (float*)(a.ws + WS_GL); const bf16_t* Ig = (const bf16_t*)(a.ws + WS_I); const bf16_t* Kg = (const bf16_t*)(a.ws + WS_KK);
    const int d = tid & 127, sg = tid >> 7;
    float* gp = GLg + (r0 + sg * 16) * 512 + h * 128 + d;
    float g[16];
#pragma unroll
    for (int j = 0; j < 16; ++j) g[j] = gp[(size_t)j * 512];
#pragma unroll
    for (int j = 1; j < 16; ++j) g[j] += g[j - 1];
    Tot[sg * 128 + d] = g[15];
#pragma unroll
    for (int it = 0; it < 2; ++it) {
        const int idx = it * 512 + tid, j = idx >> 4, e0 = (idx & 15) * 8;
        const u32x4 raw = *(const u32x4*)(Ig + (r0 + j) * 512 + h * 128 + e0);
        const unsigned rw[4] = {raw.x, raw.y, raw.z, raw.w};
#pragma unroll
        for (int e = 0; e < 8; ++e) Vt[(e0 + e) * LDV + j] = (bf16_t)((rw[e >> 1] >> ((e & 1) * 16)) & 0xffffu);
    }
    __syncthreads();
    float off = 0.f;
#pragma unroll
    for (int s = 0; s < 3; ++s) off += (s < sg) ? Tot[s * 128 + d] : 0.f;
#pragma unroll
    for (int j = 0; j < 16; ++j) { g[j] += off; gp[(size_t)j * 512] = g[j]; Gs[(sg * 16 + j) * LDG + d] = g[j]; }
    __syncthreads();
#pragma unroll
    for (int it = 0; it < 2; ++it) {
        const int idx = it * 512 + tid, j = idx >> 4, d0 = (idx & 15) * 8;
        float kv[8]; unpack8(*(const u32x4*)(Kg + (r0 + j) * 512 + h * 128 + d0), kv);
#pragma unroll
        for (int e = 0; e < 8; ++e) Kt[(d0 + e) * LDV + j] = (bf16_t)f2bf(kv[e] * fexp2(Gs[63 * LDG + d0 + e] - Gs[j * LDG + d0 + e]));
    }
    if (tid < 128) ((float*)(a.ws + WS_DEC))[(size_t)unit * 128 + tid] = fexp2(Gs[63 * LDG + tid]);
    __syncthreads();
    bf16x8 af[2];
#pragma unroll
    for (int ks = 0; ks < 2; ++ks) af[ks] = ldfrag(Vt + (w * 16) * LDV, LDV, fr, fq, ks * 32);
    float* STg = (float*)(a.ws + WS_ST) + (size_t)unit * 16384;
#pragma unroll
    for (int dt = 0; dt < 8; ++dt) {
        f32x4 acc = {0.f, 0.f, 0.f, 0.f};
#pragma unroll
        for (int ks = 0; ks < 2; ++ks) acc = MMA16(ldfrag(Kt + (dt * 16) * LDV, LDV, fr, fq, ks * 32), af[ks], acc);
        *(f32x4*)(STg + (w * 16 + fr) * 128 + dt * 16 + 4 * fq) = acc;
    }
    __syncthreads();
}

__device__ __forceinline__ void hg_scan(const Args& a) {
    float* ST = (float*)(a.ws + WS_ST); const float* DEC = (const float*)(a.ws + WS_DEC);
    for (int idx = blockIdx.x * 512 + opaque_tid(); idx < 8 * 16384; idx += gridDim.x * 512) {
        const int bh = idx >> 14, ed = idx & 16383, d = ed & 127;
        float* p = ST + (size_t)bh * 128 * 16384 + ed; const float* dc = DEC + (size_t)bh * 128 * 128 + d;
        float S = 0.f;
#pragma unroll 8
        for (int c = 0; c < 128; ++c) { const float u = p[(size_t)c * 16384]; const float dec = dc[c * 128]; p[(size_t)c * 16384] = S; S = dec * S + u; }
    }
}

__device__ __forceinline__ void hg3_unit(const Args& a, LAS unsigned char* lds, int unit, int l) {
    const int tid = opaque_tid(), lane = tid & 63, w = tid >> 6, fr = lane & 15, fq = lane >> 4;
    const int c = unit & 127, bh = unit >> 7, h = bh & 3, b = bh >> 2;
    const size_t r0 = (size_t)b * SEQ + (size_t)c * 64;
    LAS bf16_t* Qh = (LAS bf16_t*)lds;
    LAS bf16_t* Qt = Qh + 64 * LDQ;
    LAS bf16_t* Kh = Qt + 64 * LDQ;
    LAS bf16_t* Vt = Kh + 160 * LDQ;
    LAS bf16_t* As = Vt + 128 * LDV;
    LAS bf16_t* Sts = Kh;
    LAS float* Os = (LAS float*)Qh;
    const float* GLg = (const float*)(a.ws + WS_GL); const bf16_t* Ig = (const bf16_t*)(a.ws + WS_I);
    const bf16_t* Qg = (const bf16_t*)(a.ws + WS_Q); const bf16_t* Kg = (const bf16_t*)(a.ws + WS_KK);
    const float* STg = (const float*)(a.ws + WS_ST) + (size_t)unit * 16384;
#pragma unroll
    for (int it = 0; it < 2; ++it) {
        const int idx = it * 512 + tid, j = idx >> 4, d0 = (idx & 15) * 8;
        const int J = __builtin_amdgcn_readfirstlane(j >> 4);
        const size_t go = (r0 + j) * 512 + h * 128 + d0;
        float qv[8], kv[8]; unpack8(*(const u32x4*)(Qg + go), qv); unpack8(*(const u32x4*)(Kg + go), kv);
        const f32x4 ga = *(const f32x4*)(GLg + go), gb = *(const f32x4*)(GLg + go + 4);
        const float gj[8] = {ga[0], ga[1], ga[2], ga[3], gb[0], gb[1], gb[2], gb[3]};
        const u32x4 raw = *(const u32x4*)(Ig + go);
        {
            u32x4 o; o.x = pk2(qv[0] * fexp2(gj[0]), qv[1] * fexp2(gj[1])); o.y = pk2(qv[2] * fexp2(gj[2]), qv[3] * fexp2(gj[3]));
            o.z = pk2(qv[4] * fexp2(gj[4]), qv[5] * fexp2(gj[5])); o.w = pk2(qv[6] * fexp2(gj[6]), qv[7] * fexp2(gj[7]));
            *(LAS u32x4*)(Qt + j * LDQ + d0) = o;
        }
#pragma unroll
        for (int I = 0; I < 4; ++I) {
            if (I >= J) {
                const size_t ro = (r0 + 16 * I) * 512 + h * 128 + d0;
                const f32x4 ra = *(const f32x4*)(GLg + ro), rb = *(const f32x4*)(GLg + ro + 4);
                const float rf[8] = {ra[0], ra[1], ra[2], ra[3], rb[0], rb[1], rb[2], rb[3]};
                float kh[8];
#pragma unroll
                for (int e = 0; e < 8; ++e) kh[e] = kv[e] * fexp2(fminf(rf[e] - gj[e], 120.f));
                u32x4 o; o.x = pk2(kh[0], kh[1]); o.y = pk2(kh[2], kh[3]); o.z = pk2(kh[4], kh[5]); o.w = pk2(kh[6], kh[7]);
                *(LAS u32x4*)(Kh + (8 * I * (I + 1) + j) * LDQ + d0) = o;
                if (I == J) {
                    u32x4 q; q.x = pk2(qv[0] * fexp2(gj[0] - rf[0]), qv[1] * fexp2(gj[1] - rf[1])); q.y = pk2(qv[2] * fexp2(gj[2] - rf[2]), qv[3] * fexp2(gj[3] - rf[3]));
                    q.z = pk2(qv[4] * fexp2(gj[4] - rf[4]), qv[5] * fexp2(gj[5] - rf[5])); q.w = pk2(qv[6] * fexp2(gj[6] - rf[6]), qv[7] * fexp2(gj[7] - rf[7]));
                    *(LAS u32x4*)(Qh + j * LDQ + d0) = q;
                }
            }
        }
        const unsigned rw[4] = {raw.x, raw.y, raw.z, raw.w};
#pragma unroll
        for (int e = 0; e < 8; ++e) Vt[(d0 + e) * LDV + j] = (bf16_t)((rw[e >> 1] >> ((e & 1) * 16)) & 0xffffu);
    }
    for (int idx = tid; idx < 64 * LDV / 8; idx += 512) *(LAS u32x4*)(As + idx * 8) = (u32x4){0u, 0u, 0u, 0u};
    __syncthreads();
#pragma unroll 1
    for (int t = w; t < 10; t += 8) {
        const int I = t >= 6 ? 3 : t >= 3 ? 2 : t >= 1 ? 1 : 0, J = t - (I * (I + 1)) / 2;
        f32x4 acc = {0.f, 0.f, 0.f, 0.f};
#pragma unroll
        for (int ks = 0; ks < 4; ++ks) acc = MMA16(ldfrag(Kh + (8 * I * (I + 1) + 16 * J) * LDQ, LDQ, fr, fq, ks * 32), ldfrag(Qh + (16 * I) * LDQ, LDQ, fr, fq, ks * 32), acc);
        if (I == J) {
#pragma unroll
            for (int r = 0; r < 4; ++r) acc[r] = (4 * fq + r <= fr) ? acc[r] : 0.f;
        }
        u32x2 o; o.x = pk2(acc[0], acc[1]); o.y = pk2(acc[2], acc[3]);
        *(LAS u32x2*)(As + (16 * I + fr) * LDV + 16 * J + 4 * fq) = o;
    }
    __syncthreads();
#pragma unroll
    for (int it = 0; it < 8; ++it) {
        const int idx = it * 512 + tid, e = idx >> 5, d4 = (idx & 31) * 4;
        const f32x4 sv = *(const f32x4*)(STg + e * 128 + d4);
        u32x2 o; o.x = pk2(sv[0], sv[1]); o.y = pk2(sv[2], sv[3]);
        *(LAS u32x2*)(Sts + e * LDQ + d4) = o;
    }
    __syncthreads();
    {
        const int it = w & 3, eb = (w >> 2) * 4;
        bf16x8 af[2], qf[4];
#pragma unroll
        for (int ks = 0; ks < 2; ++ks) af[ks] = ldfrag(As + (it * 16) * LDV, LDV, fr, fq, ks * 32);
#pragma unroll
        for (int ks = 0; ks < 4; ++ks) qf[ks] = ldfrag(Qt + (it * 16) * LDQ, LDQ, fr, fq, ks * 32);
        __syncthreads();
#pragma unroll
        for (int t = 0; t < 4; ++t) {
            const int et = eb + t; f32x4 acc = {0.f, 0.f, 0.f, 0.f};
#pragma unroll
            for (int ks = 0; ks < 2; ++ks) acc = MMA16(ldfrag(Vt + (et * 16) * LDV, LDV, fr, fq, ks * 32), af[ks], acc);
#pragma unroll
            for (int ks = 0; ks < 4; ++ks) acc = MMA16(ldfrag(Sts + (et * 16) * LDQ, LDQ, fr, fq, ks * 32), qf[ks], acc);
            *(LAS f32x4*)(Os + (it * 16 + fr) * LDG + et * 16 + 4 * fq) = acc;
        }
    }
    __syncthreads();
    {
        bf16_t* OGg = (bf16_t*)(a.ws + WS_OG);
        const f32x2 ng = *(const f32x2*)(a.hg_norm_g + l * 128 + 2 * lane);
#pragma unroll
        for (int rr = 0; rr < 8; ++rr) {
            const int i = w * 8 + rr;
            const f32x2 o = *(const LAS f32x2*)(Os + i * LDG + 2 * lane);
            const float r = rsqrtf(wave_sum(o.x * o.x + o.y * o.y) * (1.f / 128.f) + EPS);
            unsigned* op = (unsigned*)(OGg + (r0 + i) * 512 + h * 128 + 2 * lane);
            const unsigned og = *op;
            *op = pk2(o.x * r * ng.x * bf2f(og & 0xffffu), o.y * r * ng.y * bf2f(og >> 16));
        }
    }
    __syncthreads();
}

__device__ __forceinline__ void conv_act(const Args& a, int l) {
    const bf16_t* Z = (const bf16_t*)(a.ws + WS_Z); bf16_t* AC = (bf16_t*)(a.ws + WS_AC);
    const float* cw = a.conv_w + (size_t)l * 3 * NUP; const float* cb = a.conv_b + (size_t)l * NUP;
    constexpr int CCH = DFF / 8, NITEM = (M / 8) * CCH;
    for (int item = blockIdx.x * 512 + opaque_tid(); item < NITEM; item += gridDim.x * 512) {
        const int cc = item % CCH, rb = item / CCH, c = cc * 8, m0 = rb * 8, t0 = m0 & (SEQ - 1);
        float wg[3][8], wv[3][8], bg[8], bv[8];
#pragma unroll
        for (int t = 0; t < 3; ++t) {
            const f32x4 x0 = *(const f32x4*)(cw + t * NUP + c), x1 = *(const f32x4*)(cw + t * NUP + c + 4);
            const f32x4 y0 = *(const f32x4*)(cw + t * NUP + DFF + c), y1 = *(const f32x4*)(cw + t * NUP + DFF + c + 4);
#pragma unroll
            for (int e = 0; e < 4; ++e) { wg[t][e] = x0[e]; wg[t][4 + e] = x1[e]; wv[t][e] = y0[e]; wv[t][4 + e] = y1[e]; }
        }
        { const f32x4 x0 = *(const f32x4*)(cb + c), x1 = *(const f32x4*)(cb + c + 4), y0 = *(const f32x4*)(cb + DFF + c), y1 = *(const f32x4*)(cb + DFF + c + 4);
#pragma unroll
          for (int e = 0; e < 4; ++e) { bg[e] = x0[e]; bg[4 + e] = x1[e]; bv[e] = y0[e]; bv[4 + e] = y1[e]; } }
        float g2[8], g1[8], v2[8], v1[8];
        if (t0 == 0) {
#pragma unroll
            for (int e = 0; e < 8; ++e) { g2[e] = 0.f; g1[e] = 0.f; v2[e] = 0.f; v1[e] = 0.f; }
        } else {
            unpack8(*(const u32x4*)(Z + (size_t)(m0 - 2) * NUP + c), g2); unpack8(*(const u32x4*)(Z + (size_t)(m0 - 1) * NUP + c), g1);
            unpack8(*(const u32x4*)(Z + (size_t)(m0 - 2) * NUP + DFF + c), v2); unpack8(*(const u32x4*)(Z + (size_t)(m0 - 1) * NUP + DFF + c), v1);
        }
#pragma unroll
        for (int r = 0; r < 8; ++r) {
            float g0[8], v0[8];
            unpack8(*(const u32x4*)(Z + (size_t)(m0 + r) * NUP + c), g0); unpack8(*(const u32x4*)(Z + (size_t)(m0 + r) * NUP + DFF + c), v0);
            float o[8];
#pragma unroll
            for (int e = 0; e < 8; ++e) {
                const float zg = bg[e] + wg[0][e] * g2[e] + wg[1][e] * g1[e] + wg[2][e] * g0[e];
                const float zv = bv[e] + wv[0][e] * v2[e] + wv[1][e] * v1[e] + wv[2][e] * v0[e];
                o[e] = silu(zg) * zv;
                g2[e] = g1[e]; g1[e] = g0[e]; v2[e] = v1[e]; v1[e] = v0[e];
            }
            u32x4 w; w.x = pk2(o[0], o[1]); w.y = pk2(o[2], o[3]); w.z = pk2(o[4], o[5]); w.w = pk2(o[6], o[7]);
            *(u32x4*)(AC + (size_t)(m0 + r) * DFF + c) = w;
        }
    }
}

__device__ __forceinline__ void prologue(const Args& a, LAS unsigned char* lds) {
    const int tid = opaque_tid(), lane = tid & 63, wave = tid >> 6;
    if (blockIdx.x == 0) {
        float* LB = (float*)(a.ws + WS_LB);
        for (int c = tid; c < 512; c += 512) {
            const float x0 = a.hg_lb[c], x1 = a.hg_lb[512 + c], x2 = a.hg_lb[1024 + c], x3 = a.hg_lb[1536 + c];
            const float mx = fmaxf(fmaxf(x0, x1), fmaxf(x2, x3));
            const float e0 = __expf(x0 - mx), e1 = __expf(x1 - mx), e2 = __expf(x2 - mx), e3 = __expf(x3 - mx), inv = 1.f / (e0 + e1 + e2 + e3);
            const float p1 = e1 * inv, p2 = e2 * inv, p3 = e3 * inv;
            LB[c] = 0.f; LB[512 + c] = fminf(fmaxf(p1, 0.f), 0.999f); LB[1024 + c] = fminf(fmaxf(p1 + p2, 0.f), 0.999f); LB[1536 + c] = fminf(fmaxf(p1 + p2 + p3, 0.f), 0.999f);
        }
    }
    convert_set(a, lds, 0, 0);
    convert_set(a, lds, 1, 0);
    const int gw = blockIdx.x * 8 + wave, NGW = gridDim.x * 8;
    bf16_t* XN = (bf16_t*)(a.ws + WS_XN); float* ssq = (float*)(a.ws + WS_SSQ);
    for (int m = gw; m < M; m += NGW) {
        const f32x4* xr = (const f32x4*)(a.x + (size_t)m * D) + lane; f32x4* orow = (f32x4*)(a.out + (size_t)m * D) + lane;
        const f32x4* gr = (const f32x4*)a.mix_norm + lane; u32x2* xnr = (u32x2*)(XN + (size_t)m * D) + lane;
        float s = 0.f;
#pragma unroll
        for (int j = 0; j < 4; ++j) { const f32x4 v = xr[64 * j], g = gr[64 * j]; orow[64 * j] = v; s += (v.x * v.x + v.y * v.y) + (v.z * v.z + v.w * v.w);
            u32x2 o; o.x = pk2(v.x * g.x, v.y * g.y); o.y = pk2(v.z * g.z, v.w * g.w); xnr[64 * j] = o; }
        s = wave_sum(s);
        if (lane < 16) ssq[(size_t)m * 16 + lane] = lane == 0 ? s : 0.f;
    }
}
__device__ __forceinline__ void final_norm(const Args& a) {
    const int tid = opaque_tid(), lane = tid & 63, wave = tid >> 6;
    const int gw = blockIdx.x * 8 + wave, NGW = gridDim.x * 8;
    const float* ssq = (const float*)(a.ws + WS_SSQ);
    for (int m = gw; m < M; m += NGW) {
        const float r = rowscale(ssq, m);
        f32x4* orow = (f32x4*)(a.out + (size_t)m * D) + lane; const f32x4* gr = (const f32x4*)a.final_norm + lane;
#pragma unroll
        for (int j = 0; j < 4; ++j) { const f32x4 v = orow[64 * j], g = gr[64 * j]; orow[64 * j] = (f32x4){v.x * r * g.x, v.y * r * g.y, v.z * r * g.z, v.w * r * g.w}; }
    }
}

#define XB_TMO      128
#define XB_XCNT(j)  (256  + 64 * (j))
#define XB_XSUB(j)  (1280 + 64 * (j))
#define XB_XGEN(j)  (2304 + 64 * (j))
#define XB_TOP      3328
#define XB_TOPGEN   3392
#define XCD_BAR_WORDS 3456
#define XB_SPIN_CAP (1u << 18)

__device__ __forceinline__ unsigned xb_ld(unsigned* p)              { return __hip_atomic_load(p, __ATOMIC_RELAXED, __HIP_MEMORY_SCOPE_AGENT); }
__device__ __forceinline__ unsigned xb_add(unsigned* p, unsigned v) { return __hip_atomic_fetch_add(p, v, __ATOMIC_RELAXED, __HIP_MEMORY_SCOPE_AGENT); }
__device__ __forceinline__ unsigned xb_xcc_id() { return (unsigned)__builtin_amdgcn_s_getreg((3 << 11) | 20) & 0xFu; }
#define XB_SPIN(cond, bar) do { unsigned _sp = 0; while (cond) { __builtin_amdgcn_s_sleep(1); \
    if ((++_sp & 255u) == 0u) { if (xb_ld(&(bar)[XB_TMO])) break; if (_sp > XB_SPIN_CAP) { atomicAdd(&(bar)[XB_TMO], 1u); break; } } } } while (0)

struct XcdBarrier {
    unsigned* bar; unsigned x;
    volatile LAS unsigned* st;
};

__device__ __forceinline__ XcdBarrier xcd_barrier_post(unsigned* bar, volatile LAS unsigned* st) {
    XcdBarrier b; b.bar = bar; b.x = xb_xcc_id(); b.st = st;
    if (threadIdx.x == 0) (void)xb_add(&bar[XB_XCNT(b.x)], 1u);
    return b;
}
__device__ __forceinline__ void xcd_barrier_complete(unsigned* bar, unsigned x, unsigned& nloc, unsigned& nx) {
    const unsigned G = gridDim.x * gridDim.y * gridDim.z;
    unsigned sum, cnt, mine, sp = 0u;
    for (;;) {
        sum = 0u; cnt = 0u; mine = 0u;
#pragma unroll
        for (unsigned j = 0; j < 16; ++j) { const unsigned c = xb_ld(&bar[XB_XCNT(j)]); sum += c; cnt += (c > 0u) ? 1u : 0u; mine = (j == x) ? c : mine; }
        if (sum == G) break;
        __builtin_amdgcn_s_sleep(1);
        if ((++sp & 255u) == 0u) { if (xb_ld(&bar[XB_TMO])) break; if (sp > XB_SPIN_CAP) { atomicAdd(&bar[XB_TMO], 1u); break; } }
    }
    nloc = mine > 0u ? mine : 1u; nx = cnt > 0u ? cnt : 1u;
}

__device__ __forceinline__ void xcd_barrier(const XcdBarrier& b) {
    asm volatile("s_waitcnt vmcnt(0)" ::: "memory");
    __syncthreads();
    if (threadIdx.x == 0) {
        unsigned* bar = b.bar;
        __builtin_amdgcn_s_waitcnt(0);
        unsigned nloc = b.st[0], nx = b.st[1];
        if (nloc == 0u) { xcd_barrier_complete(bar, b.x, nloc, nx); b.st[0] = nloc; b.st[1] = nx; }
        const unsigned old = xb_add(&bar[XB_XSUB(b.x)], 1u);
        const unsigned gen = old / nloc;
        if (old + 1u == (gen + 1u) * nloc) {
            __builtin_amdgcn_fence(__ATOMIC_RELEASE, "agent");
            asm volatile("s_waitcnt vmcnt(0)" ::: "memory");
            const unsigned og = xb_add(&bar[XB_TOP], 1u);
            const unsigned tg = og / nx;
            if (og + 1u == (tg + 1u) * nx) xb_add(&bar[XB_TOPGEN], 1u);
            else XB_SPIN(xb_ld(&bar[XB_TOPGEN]) == tg, bar);
            __builtin_amdgcn_fence(__ATOMIC_ACQUIRE, "agent");
            xb_add(&bar[XB_XGEN(b.x)], 1u);
            asm volatile("s_waitcnt vmcnt(0)" ::: "memory");
        } else {
            XB_SPIN(xb_ld(&bar[XB_XGEN(b.x)]) == gen, bar);
            __builtin_amdgcn_fence(__ATOMIC_ACQUIRE, "agent");
            asm volatile("s_waitcnt vmcnt(0)" ::: "memory");
        }
    }
    __syncthreads();
}

__global__ void __launch_bounds__(512, 2) trunk_fwd(Args a) {
    extern __shared__ __attribute__((aligned(16))) unsigned char lds_raw[];
    LAS unsigned char* lds = (LAS unsigned char*)lds_raw;
    cg::grid_group grid = cg::this_grid();
    if (threadIdx.x < 64) ((LAS unsigned*)(lds + 131072 + 256))[threadIdx.x] = 0u;
    __syncthreads();
    XcdBarrier bar = xcd_barrier_post((unsigned*)a.ws + 4096, (volatile LAS unsigned*)(lds + 131072 + 256));
    unsigned char* ws = a.ws;
    const int G = gridDim.x, bx = blockIdx.x;
    bf16_t* XN; float* ssq;

#ifndef PH
#define PH 0xFFFF
#endif
    if (PH & 1) prologue(a, lds);
    grid.sync();
#define LAUNDER(p) asm volatile("" : "+s"(p))
#pragma unroll 1
    for (int l = 0; l < DEPTH; ++l) {
#ifndef REP_P1
#define REP_P1 1
#endif
#ifndef REP_P5
#define REP_P5 1
#endif
#pragma unroll 1
        for (int rep = 0; rep < REP_P1; ++rep)
        if (PH & 2) { LAUNDER(ws); XN = (bf16_t*)(ws + WS_XN); ssq = (float*)(ws + WS_SSQ);
            pg8::Gemm g{XN, (const bf16_t*)(ws + WS_WIN), M, INC, D}; pg8::StaticOrder S; S.init(M, INC, G, bx);
            EpiIn E{(bf16_t*)(ws + WS_U), (bf16_t*)(ws + WS_V), (bf16_t*)(ws + WS_Q), (bf16_t*)(ws + WS_KK), (bf16_t*)(ws + WS_I), (bf16_t*)(ws + WS_OG), (bf16_t*)(ws + WS_GT),
                    (float*)(ws + WS_GL), ssq, (const float*)(ws + WS_LB) + l * 512};
            pg8::gemm_phase<EpiIn, pg8::StaticOrder, true, true>(lds, g, S, E);
        }
        xcd_barrier(bar);
        if (PH & 4) for (int u = bx; u < 1536; u += G) { if (u < 1024) hg1_unit(a, lds, u); else gmlp_unit(a, lds, u - 1024, l); }
        xcd_barrier(bar);
        if (PH & 8) { hg_scan(a);
        if (l > 0) convert_set(a, lds, 1, l); }
        xcd_barrier(bar);
        if (PH & 16) for (int u = bx; u < 1024; u += G) hg3_unit(a, lds, u, l);
        xcd_barrier(bar);
        if (PH & 32) { LAUNDER(ws);
            pg8::StaticOrder S; S.init(M, D, G, bx);
            pg8::Gemm g1{(const bf16_t*)(ws + WS_U), (const bf16_t*)(ws + WS_WGM), M, D, 512};
            EpiBr<false> E1{(bf16_t*)(ws + WS_Y), (const bf16_t*)(ws + WS_GT), 0};
            pg8::gemm_phase<EpiBr<false>, pg8::StaticOrder, true, true>(lds, g1, S, E1);
            pg8::Gemm g2{(const bf16_t*)(ws + WS_OG), (const bf16_t*)(ws + WS_WHG), M, D, 512};
            EpiBr<true> E2{(bf16_t*)(ws + WS_Y), (const bf16_t*)(ws + WS_GT), 1024};
            pg8::gemm_phase<EpiBr<true>, pg8::StaticOrder, true, true>(lds, g2, S, E2);
        }
        xcd_barrier(bar);
        if (PH & 64) { LAUNDER(ws); XN = (bf16_t*)(ws + WS_XN); ssq = (float*)(ws + WS_SSQ); float* xo = a.out; LAUNDER(xo);
            pg8::Gemm g{(const bf16_t*)(ws + WS_Y), (const bf16_t*)(ws + WS_WOUT), M, D, D}; pg8::StaticOrder S; S.init(M, D, G, bx);
            EpiRes E{xo, XN, a.ffn_norm + l * D, ssq};
            pg8::gemm_phase<EpiRes, pg8::StaticOrder, true, true>(lds, g, S, E);
        }
        xcd_barrier(bar);
#pragma unroll 1
        for (int rep = 0; rep < REP_P5; ++rep)
        if (PH & 128) { LAUNDER(ws); XN = (bf16_t*)(ws + WS_XN); ssq = (float*)(ws + WS_SSQ);
            pg8::Gemm g{XN, (const bf16_t*)(ws + WS_WUP), M, NUP, D}; pg8::StaticOrder S; S.init(M, NUP, G, bx);
            EpiZ E{(bf16_t*)(ws + WS_Z), ssq};
            pg8::gemm_phase<EpiZ, pg8::StaticOrder, true, true>(lds, g, S, E);
        }
        xcd_barrier(bar);
        if (PH & 256) { conv_act(a, l);
        if (l + 1 < DEPTH) convert_set(a, lds, 0, l + 1); }
        xcd_barrier(bar);
        if (PH & 512) { LAUNDER(ws); XN = (bf16_t*)(ws + WS_XN); ssq = (float*)(ws + WS_SSQ); float* xo = a.out; LAUNDER(xo);
            pg8::Gemm g{(const bf16_t*)(ws + WS_AC), (const bf16_t*)(ws + WS_WDN), M, D, DFF}; pg8::StaticOrder S; S.init(M, D, G, bx);
            EpiRes E{xo, XN, l + 1 < DEPTH ? a.mix_norm + (l + 1) * D : a.final_norm, ssq};
            pg8::gemm_phase<EpiRes, pg8::StaticOrder, true, true>(lds, g, S, E);
        }
        xcd_barrier(bar);
    }
    if (PH & 1024) final_norm(a);
}

extern "C" void kernel_launch(void* const* d_in, const int* in_sizes, int n_in, void* d_out, int out_size, void* d_ws, size_t ws_size, hipStream_t stream) {
    static int grid = 0;
    if (grid == 0) {
        if (n_in != 18 || out_size != M * D || ws_size < WS_NEED) { fprintf(stderr, "kernel_launch: unexpected shapes (n_in %d, out %d, ws %zu < %zu)\n", n_in, out_size, ws_size, (size_t)WS_NEED); grid = -1; return; }
        int dev = 0, cus = 0, per_cu = 0;
        hipGetDevice(&dev); hipDeviceGetAttribute(&cus, hipDeviceAttributeMultiprocessorCount, dev);
        if (hipFuncSetAttribute((const void*)trunk_fwd, hipFuncAttributeMaxDynamicSharedMemorySize, LDS_BYTES) != hipSuccess) { fprintf(stderr, "kernel_launch: hipFuncSetAttribute failed\n"); grid = -1; return; }
        if (hipOccupancyMaxActiveBlocksPerMultiprocessor(&per_cu, (const void*)trunk_fwd, 512, LDS_BYTES) != hipSuccess || per_cu < 1) { fprintf(stderr, "kernel_launch: occupancy query says %d\n", per_cu); per_cu = 1; }
        (void)hipGetLastError();
        grid = cus * 1;
    }
    if (grid < 0) return;
    if (hipMemsetAsync(d_ws, 0, 65536, stream) != hipSuccess) { fprintf(stderr, "kernel_launch: memset failed\n"); return; }
    Args a{};
    const float** ap = (const float**)&a;
    for (int i = 0; i < 18; ++i) ap[i] = (const float*)d_in[i];
    a.out = (float*)d_out; a.ws = (unsigned char*)d_ws;
    void* args[] = {&a};
    hipError_t e = hipLaunchCooperativeKernel((const void*)trunk_fwd, dim3(grid), dim3(512), args, LDS_BYTES, stream);
    if (e != hipSuccess) fprintf(stderr, "cooperative launch failed: %s (grid %d)\n", hipGetErrorString(e), grid);
}
```

```cpp
#include <hip/hip_runtime.h>
#include <hip/hip_cooperative_groups.h>
#include <cstdio>
#include <cstdint>
namespace cg = cooperative_groups;
namespace pg8 {
#define PG8_LAS __attribute__((address_space(3)))
typedef unsigned short bf16_t;
typedef short bf16x8 __attribute__((ext_vector_type(8)));
typedef float f32x4 __attribute__((ext_vector_type(4)));
typedef unsigned u32x4 __attribute__((ext_vector_type(4)));
constexpr int BM = 256, BK = 64, HALF = 128, HTB = HALF * BK * 2  , STAGE_BYTES = 8 * HTB, NXCD = 8, WGM = 8;

__host__ __device__ __forceinline__ int lds_byte(int r, int c) { const int st = (r >> 4) * 2 + (c >> 5), rr = r & 15, cc = c & 31, ob = rr * 64 + cc * 2; return st * 1024 + (ob ^ (((ob >> 9) & 1) << 5)); }
__host__ __device__ __forceinline__ void stage_rc(int b, int& R, int& C) { const int st = b / 1024, sb = b % 1024, swz = sb ^ (((sb >> 9) & 1) << 5); R = (st >> 1) * 16 + swz / 64; C = (st & 1) * 32 + (swz % 64) / 2; }
__host__ __device__ __forceinline__ int perm32(int rho) { const int n = rho >> 4, i = rho & 15; return 8 * (i >> 2) + 4 * n + (i & 3); }

struct Unit { int pm, pn; };
struct Gemm { const bf16_t* A; const bf16_t* Bt; int M, N, K; };

struct StaticOrder {
    int nM, nN, nwg, G, c;
    __host__ __device__ void init(int M, int N, int G_, int c_) { nM = M / BM; nN = N / BM; nwg = nM * nN; G = G_; c = c_; }
    __host__ __device__ bool next(int i, Unit& u) const {
        const long L = (long)i * G + c; if (L >= nwg) return false;
        int wgid = (int)L; { const int q = nwg / NXCD, r = nwg % NXCD, xcd = wgid % NXCD, off = wgid / NXCD; wgid = (xcd < r ? xcd * (q + 1) : r * (q + 1) + (xcd - r) * q) + off; }
        const int nig = WGM * nN, gid = wgid / nig, fm = gid * WGM, gsz = (nM - fm) < WGM ? (nM - fm) : WGM;
        u.pm = fm + ((wgid % nig) % gsz); u.pn = (wgid % nig) / gsz; return true;
    }
    __device__ __forceinline__ void a_ready(const Unit&) const {}
    __device__ __forceinline__ void done(const Unit&) const {}
};

__device__ __forceinline__ unsigned cvt_pk_bf16(float lo, float hi) { unsigned r; asm volatile("v_cvt_pk_bf16_f32 %0, %1, %2" : "=v"(r) : "v"(lo), "v"(hi)); return r; }
typedef float f32x2 __attribute__((ext_vector_type(2)));
__device__ __forceinline__ f32x2 gelu_pk(f32x2 v) {
    const f32x2 av = __builtin_elementwise_abs(v), d = av * 0.2316418882f + 1.0f;
    f32x2 t; t.x = __builtin_amdgcn_rcpf(d.x); t.y = __builtin_amdgcn_rcpf(d.y);
    f32x2 q = t * 0.5307027145f + (-0.7265760135f); q = q * t + 0.7107068705f; q = q * t + (-0.142248368f); q = q * t + 0.127414796f; q = q * t;
    const f32x2 s = (v * v) * (-0.72134752044f);
    f32x2 e; e.x = __builtin_amdgcn_exp2f(s.x); e.y = __builtin_amdgcn_exp2f(s.y);
    const f32x2 m = v * (q * e), r = v - m;
    f32x2 o; o.x = v.x < 0.f ? m.x : r.x; o.y = v.y < 0.f ? m.y : r.y; return o;
}

template <int ACT  > struct EpiBf16 {
    static constexpr bool PERM = true, AFTER_DRAIN = false; static_assert(ACT == 0 || ACT == 1, "EpiBf16: ACT is 0 (none) or 1 (gelu_pk)");
    bf16_t* O; int ldc; const float* bias; int split_cols; size_t split_stride; float scale0;
    __device__ __forceinline__ void operator()(const f32x4 (&acc)[2][2][4][2], const Unit& u, int wr, int wc, int fr, int fq) const {
        const int row0 = u.pm * BM + wr * 64 + fr; int colt = u.pn * BM; bf16_t* base = O;
        float sc = 1.f; if (split_cols) { const int t = colt / split_cols; base += (size_t)t * split_stride; colt -= t * split_cols; if (t == 0) sc = scale0; }
        const int col0 = colt + wc * 32 + 8 * fq, bcol0 = u.pn * BM + wc * 32 + 8 * fq;
        f32x4 bv[2][2];
#pragma unroll
        for (int bj = 0; bj < 2; ++bj)
#pragma unroll
            for (int n = 0; n < 2; ++n) bv[bj][n] = bias ? *(const f32x4*)(bias + bcol0 + bj * HALF + 4 * n) : (f32x4){0.f, 0.f, 0.f, 0.f};
#pragma unroll
        for (int ai = 0; ai < 2; ++ai)
#pragma unroll
            for (int m = 0; m < 4; ++m) { bf16_t* rowp = base + (size_t)(row0 + ai * HALF + m * 16) * ldc + col0;
#pragma unroll
                for (int bj = 0; bj < 2; ++bj) { f32x4 v0 = acc[ai][bj][m][0] + bv[bj][0], v1 = acc[ai][bj][m][1] + bv[bj][1];
                    if (ACT == 1) { f32x2 a = gelu_pk((f32x2){v0[0], v0[1]}), b = gelu_pk((f32x2){v0[2], v0[3]}), c = gelu_pk((f32x2){v1[0], v1[1]}), d = gelu_pk((f32x2){v1[2], v1[3]});
                        v0 = (f32x4){a.x, a.y, b.x, b.y}; v1 = (f32x4){c.x, c.y, d.x, d.y}; }
                    v0 = v0 * sc; v1 = v1 * sc; u32x4 w; w.x = cvt_pk_bf16(v0[0], v0[1]); w.y = cvt_pk_bf16(v0[2], v0[3]); w.z = cvt_pk_bf16(v1[0], v1[1]); w.w = cvt_pk_bf16(v1[2], v1[3]);
                    *(u32x4*)(rowp + bj * HALF) = w; } }
    }
};
template <class Epi, class Sched, bool ALIGN_EPI = false, bool SP2 = false>
__device__ __forceinline__ void gemm_phase(PG8_LAS unsigned char* lds, const Gemm g, const Sched& S, const Epi& E) {
    int tid_ = threadIdx.x; asm volatile("" : "+v"(tid_)); const int tid = tid_, wid = __builtin_amdgcn_readfirstlane(tid >> 6), lane = tid & 63, wr = wid >> 2, wc = wid & 3, fr = lane & 15, fq = lane >> 4;
    const int K = g.K, nt = K / BK;
    unsigned voffA[2], voffB[2];
#pragma unroll
    for (int i = 0; i < 2; ++i) { int R, C; stage_rc(tid * 16 + i * 8192, R, C); const int Rb = Epi::PERM ? ((R & ~31) + perm32(R & 31)) : R;
        voffA[i] = (unsigned)(R * K + C) * 2u; voffB[i] = (unsigned)(Rb * K + C) * 2u; }
    const size_t kstep = (size_t)(BK * 2);
    const size_t hstep = (size_t)HALF * K * 2;
    const size_t tstep = 2 * hstep;
    const unsigned ldsw = (unsigned)wid * 1024u;
    const int aoff = lds_byte(wr * 64 + fr, fq * 8), boff = lds_byte(wc * 32 + fr, fq * 8);
#define PG8_SA(b, h) (((b) * 2 + (h)) * HTB)
#define PG8_SB(b, h) ((4 + (b) * 2 + (h)) * HTB)
#define PG8_STAGE(bufoff, gbase, voff) do { _Pragma("unroll") for (int _i = 0; _i < 2; ++_i) \
        __builtin_amdgcn_global_load_lds((const unsigned*)((const char*)(gbase) + (voff)[_i]), (PG8_LAS unsigned*)(lds + (bufoff) + ldsw + _i * 8192), 16, 0, 0); } while (0)
#define PG8_LDA(dst, b, h) do { _Pragma("unroll") for (int m = 0; m < 4; ++m) _Pragma("unroll") for (int k = 0; k < 2; ++k) dst[m][k] = *(const PG8_LAS bf16x8*)(lds + PG8_SA(b, h) + aoff + m * 2048 + k * 1024); } while (0)
#define PG8_LDB(dst, b, h) do { _Pragma("unroll") for (int n = 0; n < 2; ++n) _Pragma("unroll") for (int k = 0; k < 2; ++k) dst[n][k] = *(const PG8_LAS bf16x8*)(lds + PG8_SB(b, h) + boff + n * 2048 + k * 1024); } while (0)
#define PG8_MMA(ai, bj, At, Bt) do { __builtin_amdgcn_s_setprio(1); _Pragma("unroll") for (int m = 0; m < 4; ++m) _Pragma("unroll") for (int n = 0; n < 2; ++n) _Pragma("unroll") for (int k = 0; k < 2; ++k) \
        acc[ai][bj][m][n] = __builtin_amdgcn_mfma_f32_16x16x32_bf16(Bt[n][k], At[m][k], acc[ai][bj][m][n], 0, 0, 0); __builtin_amdgcn_s_setprio(0); } while (0)
#define PG8_WAIT_V(n) asm volatile("s_waitcnt vmcnt(" #n ")" ::: "memory")
#define PG8_WAIT_L(n) asm volatile("s_waitcnt lgkmcnt(" #n ")" ::: "memory")
#define PG8_BAR __builtin_amdgcn_s_barrier()
#define PG8_SCHED __builtin_amdgcn_sched_barrier(0)
    Unit cur, nxt; int ui = 0;
    if (!S.next(0, cur)) return;
    f32x4 acc[2][2][4][2];
#pragma unroll
    for (int a = 0; a < 2; ++a)
#pragma unroll
        for (int b = 0; b < 2; ++b)
#pragma unroll
            for (int m = 0; m < 4; ++m)
#pragma unroll
                for (int n = 0; n < 2; ++n) acc[a][b][m][n] = (f32x4){0.f, 0.f, 0.f, 0.f};
    bf16x8 At[4][2], B0[2][2], B1[2][2];
    const char* cA = (const char*)g.A + (size_t)cur.pm * tstep; const char* cB = (const char*)g.Bt + (size_t)cur.pn * tstep;
    S.a_ready(cur);
    if constexpr (SP2) {
        PG8_STAGE(PG8_SB(0, 0), cB, voffB); PG8_STAGE(PG8_SB(0, 1), cB + hstep, voffB); PG8_STAGE(PG8_SA(0, 0), cA, voffA); PG8_STAGE(PG8_SA(0, 1), cA + hstep, voffA);
        if (wr == 1) PG8_BAR;
        PG8_WAIT_V(2); PG8_BAR;
        PG8_STAGE(PG8_SB(1, 0), cB + kstep, voffB); PG8_STAGE(PG8_SA(1, 0), cA + kstep, voffA); PG8_STAGE(PG8_SB(1, 1), cB + hstep + kstep, voffB);
        PG8_WAIT_V(6); PG8_BAR;
    } else {
        PG8_STAGE(PG8_SB(0, 0), cB, voffB); PG8_STAGE(PG8_SA(0, 0), cA, voffA); PG8_STAGE(PG8_SB(0, 1), cB + hstep, voffB); PG8_STAGE(PG8_SA(0, 1), cA + hstep, voffA);
        if (wr == 1) PG8_BAR;
        PG8_WAIT_V(4); PG8_BAR;
        PG8_STAGE(PG8_SB(1, 0), cB + kstep, voffB); PG8_STAGE(PG8_SA(1, 0), cA + kstep, voffA); PG8_STAGE(PG8_SB(1, 1), cB + hstep + kstep, voffB);
        PG8_WAIT_V(6); PG8_BAR;
    }
    for (;;) {
        const bool has_next = S.next(ui + 1, nxt);
        const char* nA = has_next ? (const char*)g.A + (size_t)nxt.pm * tstep : cA; const char* nB = has_next ? (const char*)g.Bt + (size_t)nxt.pn * tstep : cB;
        for (int t = 0; t < nt; t += 2) {
            const bool last = (t == nt - 2);
            const char* a1 = cA + (size_t)(t + 1) * kstep;
            const char* a2 = last ? nA : cA + (size_t)(t + 2) * kstep; const char* b2 = last ? nB : cB + (size_t)(t + 2) * kstep;
            const char* a3 = a2 + kstep; const char* b3 = b2 + kstep;
            if (last && has_next) S.a_ready(nxt);
            if constexpr (SP2) {
            PG8_LDB(B0, 0, 0); PG8_LDB(B1, 0, 1); PG8_SCHED; PG8_LDA(At, 0, 0); PG8_STAGE(PG8_SA(1, 1), a1 + hstep, voffA);
            PG8_WAIT_V(8); PG8_WAIT_L(0); PG8_BAR; PG8_MMA(0, 0, At, B0); PG8_MMA(0, 1, At, B1); PG8_BAR; PG8_SCHED;
            PG8_LDA(At, 0, 1); PG8_STAGE(PG8_SB(0, 0), b2, voffB); PG8_STAGE(PG8_SB(0, 1), b2 + hstep, voffB); PG8_STAGE(PG8_SA(0, 0), a2, voffA);
            PG8_WAIT_V(8); PG8_WAIT_L(0); PG8_BAR; PG8_MMA(1, 0, At, B0); PG8_MMA(1, 1, At, B1); PG8_BAR; PG8_SCHED;
            PG8_LDB(B0, 1, 0); PG8_LDB(B1, 1, 1); PG8_SCHED; PG8_LDA(At, 1, 0); PG8_STAGE(PG8_SA(0, 1), a2 + hstep, voffA);
            PG8_WAIT_V(8); PG8_WAIT_L(0); PG8_BAR; PG8_MMA(0, 0, At, B0); PG8_MMA(0, 1, At, B1); PG8_BAR; PG8_SCHED;
            PG8_LDA(At, 1, 1); PG8_STAGE(PG8_SB(1, 0), b3, voffB); PG8_STAGE(PG8_SB(1, 1), b3 + hstep, voffB); PG8_STAGE(PG8_SA(1, 0), a3, voffA);
            PG8_WAIT_V(8); PG8_WAIT_L(0); PG8_BAR; PG8_MMA(1, 0, At, B0); PG8_MMA(1, 1, At, B1); PG8_BAR; PG8_SCHED;
            } else {
            PG8_LDB(B0, 0, 0); PG8_SCHED; PG8_LDA(At, 0, 0); PG8_STAGE(PG8_SA(1, 1), a1 + hstep, voffA);
            PG8_WAIT_L(8); PG8_BAR; PG8_WAIT_L(0); PG8_MMA(0, 0, At, B0); PG8_BAR; PG8_SCHED;
            PG8_LDB(B1, 0, 1); PG8_STAGE(PG8_SB(0, 0), b2, voffB);
            PG8_BAR; PG8_WAIT_L(0); PG8_MMA(0, 1, At, B1); PG8_BAR;
            PG8_LDA(At, 0, 1); PG8_STAGE(PG8_SA(0, 0), a2, voffA);
            PG8_BAR; PG8_WAIT_L(0); PG8_MMA(1, 0, At, B0); PG8_BAR; PG8_SCHED;
            PG8_STAGE(PG8_SB(0, 1), b2 + hstep, voffB);
            PG8_WAIT_V(6); PG8_BAR; PG8_MMA(1, 1, At, B1); PG8_BAR;
            PG8_LDB(B0, 1, 0); PG8_SCHED; PG8_LDA(At, 1, 0); PG8_STAGE(PG8_SA(0, 1), a2 + hstep, voffA);
            PG8_WAIT_L(8); PG8_BAR; PG8_WAIT_L(0); PG8_MMA(0, 0, At, B0); PG8_BAR; PG8_SCHED;
            PG8_LDB(B1, 1, 1); PG8_STAGE(PG8_SB(1, 0), b3, voffB);
            PG8_BAR; PG8_WAIT_L(0); PG8_MMA(0, 1, At, B1); PG8_BAR;
            PG8_LDA(At, 1, 1); PG8_STAGE(PG8_SA(1, 0), a3, voffA);
            PG8_BAR; PG8_WAIT_L(0); PG8_MMA(1, 0, At, B0); PG8_BAR; PG8_SCHED;
            PG8_STAGE(PG8_SB(1, 1), b3 + hstep, voffB);
            PG8_WAIT_V(6); PG8_BAR; PG8_MMA(1, 1, At, B1); PG8_BAR;
            }
        }
        if constexpr (ALIGN_EPI) { if (wr == 0) PG8_BAR; }
        if constexpr (!Epi::AFTER_DRAIN) { E(acc, cur, wr, wc, fr, fq); S.done(cur); }
        if (!has_next) break;
#pragma unroll
        for (int a = 0; a < 2; ++a)
#pragma unroll
            for (int b = 0; b < 2; ++b)
#pragma unroll
                for (int m = 0; m < 4; ++m)
#pragma unroll
                    for (int n = 0; n < 2; ++n) acc[a][b][m][n] = (f32x4){0.f, 0.f, 0.f, 0.f};
        cur = nxt; cA = nA; cB = nB; ++ui;
        if constexpr (ALIGN_EPI) { if (wr == 1) PG8_BAR; }
    }
    PG8_WAIT_V(0);
    if constexpr (!ALIGN_EPI) { if (wr == 0) PG8_BAR; }
    PG8_BAR;
    if constexpr (Epi::AFTER_DRAIN) { E.fused(acc, cur, wr, wc, fr, fq, lds, wid, lane); S.done(cur); }
#undef PG8_SA
#undef PG8_SB
#undef PG8_STAGE
#undef PG8_LDA
#undef PG8_LDB
#undef PG8_MMA
#undef PG8_WAIT_V
#undef PG8_WAIT_L
#undef PG8_BAR
#undef PG8_SCHED
}
}
#define LAS __attribute__((address_space(3)))
__device__ __forceinline__ int opaque_tid() { int t = threadIdx.x; asm volatile("" : "+v"(t)); return t; }
using pg8::bf16_t; using pg8::bf16x8; using pg8::f32x4; using pg8::u32x4; using pg8::Unit;
typedef float f32x2 __attribute__((ext_vector_type(2)));
typedef unsigned u32x2 __attribute__((ext_vector_type(2)));

constexpr int NB = 2, SEQ = 8192, M = NB * SEQ, D = 1024, DEPTH = 4, INC = 5120, DFF = 2816, NUP = 2 * DFF;
constexpr float EPS = 1e-6f, LOG2E = 1.4426950408889634f;
constexpr size_t MiB = 1u << 20;
constexpr size_t WS_LB = 1 * MiB, WS_SSQ = 2 * MiB, WS_DEC = 3 * MiB;
constexpr size_t WS_WIN = 4 * MiB, WS_WGM = 14 * MiB, WS_WHG = 15 * MiB, WS_WOUT = 16 * MiB, WS_WUP = 18 * MiB, WS_WDN = 29 * MiB;
constexpr size_t WS_XN = 36 * MiB, WS_ACT0 = 68 * MiB, WS_VS = 35 * MiB;
constexpr size_t WS_U = WS_ACT0, WS_V = WS_U + 16 * MiB, WS_Q = WS_V + 16 * MiB, WS_KK = WS_Q + 16 * MiB, WS_GL = WS_KK + 16 * MiB, WS_I = WS_GL + 32 * MiB,
                 WS_OG = WS_I + 16 * MiB, WS_GT = WS_OG + 16 * MiB, WS_ST = WS_GT + 64 * MiB, WS_END1 = WS_ST + 64 * MiB;
constexpr size_t WS_XN2 = WS_I;
constexpr size_t WS_Y = WS_Q;
constexpr size_t WS_Z = WS_ACT0, WS_AC = WS_Z + 176 * MiB, WS_END2 = WS_AC + 88 * MiB;
constexpr size_t WS_FFNW2 = WS_END2, WS_FFNW_STRIDE = WS_FFNW2 - WS_WUP;
constexpr size_t WS_NEED = WS_FFNW2 + 17 * MiB;
constexpr int LDS_BYTES = 147456;

#ifndef PROBE_MASK
#define PROBE_MASK 0
#endif
#ifndef ALIGN_SINGLE
#define ALIGN_SINGLE true
#endif
#ifndef ALIGN_HEAVY
#define ALIGN_HEAVY true
#endif
struct Args {
    const float *x, *mix_norm, *w_in, *gm_ln_g, *gm_ln_b, *gm_ws, *gm_bs, *hg_lb, *hg_norm_g, *w_br_gm, *w_br_hg, *w_out, *ffn_norm, *w_up, *conv_w, *conv_b, *w_down, *final_norm;
    float* out; unsigned char* ws;
};

__device__ __forceinline__ float bf2f(unsigned h) { return __uint_as_float(h << 16); }
__device__ __forceinline__ unsigned f2bf(float f) { unsigned u = __float_as_uint(f); return (u + 0x7fffu + ((u >> 16) & 1u)) >> 16; }
__device__ __forceinline__ unsigned pk2(float lo, float hi) { return pg8::cvt_pk_bf16(lo, hi); }
__device__ __forceinline__ float fexp2(float x) { return __builtin_amdgcn_exp2f(x); }
__device__ __forceinline__ float frcp(float x) { return __builtin_amdgcn_rcpf(x); }
__device__ __forceinline__ float sigm(float x) { return frcp(1.f + fexp2(-LOG2E * x)); }
__device__ __forceinline__ float silu(float x) { return x * sigm(x); }
__device__ __forceinline__ float wave_sum(float v) {
#pragma unroll
    for (int o = 1; o < 64; o <<= 1) v += __shfl_xor(v, o);
    return v;
}
__device__ __forceinline__ void unpack8(const u32x4 r, float (&x)[8]) {
    x[0] = bf2f(r.x & 0xffffu); x[1] = bf2f(r.x >> 16); x[2] = bf2f(r.y & 0xffffu); x[3] = bf2f(r.y >> 16);
    x[4] = bf2f(r.z & 0xffffu); x[5] = bf2f(r.z >> 16); x[6] = bf2f(r.w & 0xffffu); x[7] = bf2f(r.w >> 16);
}
__device__ __forceinline__ float rowscale(const float* ssq, int row) {
    const f32x4* p = (const f32x4*)(ssq + (size_t)row * 16); const f32x4 s = (p[0] + p[1]) + (p[2] + p[3]);
    return rsqrtf(((s.x + s.y) + (s.z + s.w)) * (1.f / 1024.f) + EPS);
}

constexpr int RTAB_OFF = 140288, RT_UNITS = 6;
template <class Sched> __device__ __forceinline__ void fill_rtab(const Sched& S, const float* ssq, LAS unsigned char* lds) {
    const int tid = opaque_tid(); LAS float* tab = (LAS float*)(lds + RTAB_OFF);
    float r[RT_UNITS]; bool ok[RT_UNITS];
#pragma unroll
    for (int i = 0; i < RT_UNITS; ++i) { Unit u; ok[i] = S.next(i, u); r[i] = (ok[i] && tid < 256) ? rowscale(ssq, u.pm * 256 + tid) : 0.f; }
#pragma unroll
    for (int i = 0; i < RT_UNITS; ++i) if (ok[i] && tid < 256) tab[i * 256 + tid] = r[i];
    __syncthreads();
}
struct EpiIn {
    static constexpr bool PERM = true, AFTER_DRAIN = false;
    bf16_t *U, *V, *Q, *KK, *I, *OG, *GT; float* GL; const float* ssq; const float* lb; float* VS; const LAS float* rtab; mutable int k;
    template <int SEG> __device__ __forceinline__ void body(const f32x4 (&acc)[2][2][4][2], const Unit& u, int wr, int wc, int fr, int fq) const {
        const int row0 = u.pm * 256 + wr * 64 + fr, pn = u.pn;
        bf16_t* base; int ldc, colt;
        if (SEG == 6) { base = GT; ldc = 2048; colt = (pn - 12) * 256; }
        else { ldc = 512; colt = (pn & 1) * 256; base = SEG == 0 ? U : SEG == 1 ? V : SEG == 2 ? Q : SEG == 3 ? KK : SEG == 4 ? I : OG; }
        const int col0 = colt + wc * 32 + 8 * fq;
        f32x4 lbq[2][2];
        if (SEG == 3) {
#pragma unroll
            for (int bj = 0; bj < 2; ++bj) { lbq[bj][0] = *(const f32x4*)(lb + col0 + bj * 128); lbq[bj][1] = *(const f32x4*)(lb + col0 + bj * 128 + 4); }
        }
#pragma unroll
        for (int ai = 0; ai < 2; ++ai)
#pragma unroll
            for (int m = 0; m < 4; ++m) {
                const int row = row0 + ai * 128 + m * 16; const float r = k < RT_UNITS ? rtab[k * 256 + ai * 128 + wr * 64 + m * 16 + fr] : rowscale(ssq, row);
                float st1 = 0.f, st2 = 0.f;
#pragma unroll
                for (int bj = 0; bj < 2; ++bj) {
                    const int c = col0 + bj * 128;
                    f32x4 v0 = acc[ai][bj][m][0] * r, v1 = acc[ai][bj][m][1] * r;
                    float o[8] = {v0[0], v0[1], v0[2], v0[3], v1[0], v1[1], v1[2], v1[3]};
                    if (SEG == 0 || SEG == 1) {
#pragma unroll
                        for (int e = 0; e < 8; e += 2) { f32x2 g = pg8::gelu_pk((f32x2){o[e], o[e + 1]}); o[e] = g.x; o[e + 1] = g.y; }
                        if (SEG == 1) {
#pragma unroll
                            for (int e = 0; e < 8; ++e) { st1 += o[e]; st2 += o[e] * o[e]; }
                        }
                    } else if (SEG == 2 || SEG == 5) {
#pragma unroll
                        for (int e = 0; e < 8; ++e) o[e] = silu(o[e]);
                    } else if (SEG == 6) {
#pragma unroll
                        for (int e = 0; e < 8; ++e) o[e] = sigm(o[e]);
                    } else if (SEG == 3) {
                        const f32x4 l0 = lbq[bj][0], l1 = lbq[bj][1];
                        const float lbv[8] = {l0[0], l0[1], l0[2], l0[3], l1[0], l1[1], l1[2], l1[3]};
                        float g2[8];
#pragma unroll
                        for (int e = 0; e < 8; ++e) {
                            const float f = fminf(fmaxf(o[e], -80.f), 80.f);
                            const float ex = fexp2(-LOG2E * f), sg = frcp(1.f + ex);
                            const float fg = lbv[e] + (1.f - lbv[e]) * sg;
                            g2[e] = __builtin_amdgcn_logf(fmaxf(fg, 1e-30f));
                            o[e] = (1.f - lbv[e]) * (ex * sg);
                        }
                        float* gp = GL + (size_t)row * 512 + c;
                        *(f32x4*)gp = (f32x4){g2[0], g2[1], g2[2], g2[3]}; *(f32x4*)(gp + 4) = (f32x4){g2[4], g2[5], g2[6], g2[7]};
                    }
                    u32x4 w; w.x = pk2(o[0], o[1]); w.y = pk2(o[2], o[3]); w.z = pk2(o[4], o[5]); w.w = pk2(o[6], o[7]);
                    *(u32x4*)(base + (size_t)row * ldc + c) = w;
                }
                if (SEG == 1) {
                    st1 += __shfl_xor(st1, 16); st1 += __shfl_xor(st1, 32); st2 += __shfl_xor(st2, 16); st2 += __shfl_xor(st2, 32);
                    if (fq == 0) *(f32x2*)(VS + (size_t)row * 16 + ((pn & 1) * 4 + wc) * 2) = (f32x2){st1, st2};
                }
                asm volatile("" ::: "memory");
            }
    }
    __device__ __forceinline__ void operator()(const f32x4 (&acc)[2][2][4][2], const Unit& u, int wr, int wc, int fr, int fq) const {
        const int seg = u.pn < 12 ? (u.pn >> 1) : 6;
        switch (seg) {
            case 0: body<0>(acc, u, wr, wc, fr, fq); break;
            case 1: body<1>(acc, u, wr, wc, fr, fq); break;
            case 2: body<2>(acc, u, wr, wc, fr, fq); break;
            case 3: body<3>(acc, u, wr, wc, fr, fq); break;
            case 4: body<4>(acc, u, wr, wc, fr, fq); break;
            case 5: body<5>(acc, u, wr, wc, fr, fq); break;
            default: body<6>(acc, u, wr, wc, fr, fq); break;
        }
        ++k;
    }
};
template <bool ADD> struct EpiBr {
    static constexpr bool PERM = true, AFTER_DRAIN = false;
    bf16_t* Y; const bf16_t* GT; int goff;
    __device__ __forceinline__ void operator()(const f32x4 (&acc)[2][2][4][2], const Unit& u, int wr, int wc, int fr, int fq) const {
        const int row0 = u.pm * 256 + wr * 64 + fr, col0 = u.pn * 256 + wc * 32 + 8 * fq;
        u32x4 gc[2], gn[2], yc[2], yn[2];
#pragma unroll
        for (int bj = 0; bj < 2; ++bj) { gc[bj] = *(const u32x4*)(GT + (size_t)row0 * 2048 + goff + col0 + bj * 128); if (ADD) yc[bj] = *(const u32x4*)(Y + (size_t)row0 * 1024 + col0 + bj * 128); }
#pragma unroll
        for (int gI = 0; gI < 8; ++gI) {
            const int ai = gI >> 2, m = gI & 3, row = row0 + ai * 128 + m * 16;
            if (gI < 7) { const int rn = row0 + ((gI + 1) >> 2) * 128 + ((gI + 1) & 3) * 16;
#pragma unroll
                for (int bj = 0; bj < 2; ++bj) { gn[bj] = *(const u32x4*)(GT + (size_t)rn * 2048 + goff + col0 + bj * 128); if (ADD) yn[bj] = *(const u32x4*)(Y + (size_t)rn * 1024 + col0 + bj * 128); } }
#pragma unroll
            for (int bj = 0; bj < 2; ++bj) {
                const int c = col0 + bj * 128;
                float g[8]; unpack8(gc[bj], g);
                const f32x4 v0 = acc[ai][bj][m][0], v1 = acc[ai][bj][m][1];
                float o[8] = {v0[0] * g[0], v0[1] * g[1], v0[2] * g[2], v0[3] * g[3], v1[0] * g[4], v1[1] * g[5], v1[2] * g[6], v1[3] * g[7]};
                if (ADD) { float y[8]; unpack8(yc[bj], y);
#pragma unroll
                    for (int e = 0; e < 8; ++e) o[e] += y[e]; }
                u32x4 w; w.x = pk2(o[0], o[1]); w.y = pk2(o[2], o[3]); w.z = pk2(o[4], o[5]); w.w = pk2(o[6], o[7]);
                *(u32x4*)(Y + (size_t)row * 1024 + c) = w;
            }
#pragma unroll
            for (int bj = 0; bj < 2; ++bj) { gc[bj] = gn[bj]; if (ADD) yc[bj] = yn[bj]; }
            asm volatile("" ::: "memory");
        }
    }
};
struct EpiRes {
    static constexpr bool PERM = true, AFTER_DRAIN = false;
    const bf16_t* xs; bf16_t* xb; float* ssq;
    __device__ __forceinline__ void operator()(const f32x4 (&acc)[2][2][4][2], const Unit& u, int wr, int wc, int fr, int fq) const {
        const int row0 = u.pm * 256 + wr * 64 + fr, col0 = u.pn * 256 + wc * 32 + 8 * fq;
        u32x4 cur[2], nxt[2];
#pragma unroll
        for (int bj = 0; bj < 2; ++bj) cur[bj] = *(const u32x4*)(xs + (size_t)row0 * 1024 + col0 + bj * 128);
#pragma unroll
        for (int gI = 0; gI < 8; ++gI) {
            const int ai = gI >> 2, m = gI & 3, row = row0 + ai * 128 + m * 16;
            if (gI < 7) { const int rn = row0 + ((gI + 1) >> 2) * 128 + ((gI + 1) & 3) * 16;
#pragma unroll
                for (int bj = 0; bj < 2; ++bj) nxt[bj] = *(const u32x4*)(xs + (size_t)rn * 1024 + col0 + bj * 128); }
            float ss = 0.f;
#pragma unroll
            for (int bj = 0; bj < 2; ++bj) {
                float x[8]; unpack8(cur[bj], x);
                const f32x4 v0 = acc[ai][bj][m][0], v1 = acc[ai][bj][m][1];
                u32x4 w; w.x = pk2(x[0] + v0[0], x[1] + v0[1]); w.y = pk2(x[2] + v0[2], x[3] + v0[3]); w.z = pk2(x[4] + v1[0], x[5] + v1[1]); w.w = pk2(x[6] + v1[2], x[7] + v1[3]);
                *(u32x4*)(xb + (size_t)row * 1024 + col0 + bj * 128) = w;
                float y[8]; unpack8(w, y);
#pragma unroll
                for (int e = 0; e < 8; ++e) ss += y[e] * y[e];
            }
            ss += __shfl_xor(ss, 16); ss += __shfl_xor(ss, 32);
            if (fq == 0) ssq[(size_t)row * 16 + u.pn * 4 + wc] = ss;
#pragma unroll
            for (int bj = 0; bj < 2; ++bj) cur[bj] = nxt[bj];
            asm volatile("" ::: "memory");
        }
    }
};
__device__ __forceinline__ float dpp_ror1(float v) { return __int_as_float(__builtin_amdgcn_update_dpp(__float_as_int(v), __float_as_int(v), 0x121, 0xf, 0xf, false)); }
__device__ __forceinline__ float dpp_ror2(float v) { return __int_as_float(__builtin_amdgcn_update_dpp(__float_as_int(v), __float_as_int(v), 0x122, 0xf, 0xf, false)); }
struct EpiUp {
    static constexpr bool PERM = true, AFTER_DRAIN = false;
    bf16_t* AC; bf16_t* H; const float* ssq; const float* cw; const float* cb; LAS float* wl; const LAS float* rtab; mutable int k;
    __device__ __forceinline__ void operator()(const f32x4 (&acc)[2][2][4][2], const Unit& u, int wr, int wc, int fr, int fq) const {
        const int rowb = u.pm * 256 + wr * 64 + fr, cl = u.pn * 128 + wc * 32 + 8 * fq;
        LAS float* wv = wl + (wr * 4 + wc) * 256;
        {
            const int lane = fq * 16 + fr, kind = lane >> 3, c4 = (lane & 7) * 4, cg = u.pn * 128 + wc * 32 + c4 + (kind >= 4 ? DFF : 0), kk = kind & 3;
            const f32x4 v = *(const f32x4*)((kk == 3 ? cb : cw + kk * NUP) + cg);
            *(LAS f32x4*)(wv + kind * 32 + c4) = v;
            asm volatile("s_waitcnt lgkmcnt(0)" ::: "memory");
        }
#pragma unroll
        for (int n = 0; n < 2; ++n) {
            const int c = cl + 4 * n; const LAS float* wp = wv + 8 * fq + 4 * n;
#pragma unroll
            for (int ai = 0; ai < 2; ++ai) {
                f32x4 pg1 = {0.f, 0.f, 0.f, 0.f}, pg2 = pg1, pv1 = pg1, pv2 = pg1;
#pragma unroll
                for (int m = 0; m < 4; ++m) {
                    const int row = rowb + ai * 128 + m * 16; const float r = k < RT_UNITS ? rtab[k * 256 + ai * 128 + wr * 64 + m * 16 + fr] : rowscale(ssq, row);
                    const f32x4 zg = acc[ai][0][m][n] * r, zv = acc[ai][1][m][n] * r;
                    f32x4 ag1, ag2, av1, av2, g1, g2, v1, v2;
#pragma unroll
                    for (int j = 0; j < 4; ++j) {
                        ag1[j] = dpp_ror1(zg[j]); ag2[j] = dpp_ror2(zg[j]); av1[j] = dpp_ror1(zv[j]); av2[j] = dpp_ror2(zv[j]);
                        g1[j] = fr >= 1 ? ag1[j] : pg1[j]; g2[j] = fr >= 2 ? ag2[j] : pg2[j];
                        v1[j] = fr >= 1 ? av1[j] : pv1[j]; v2[j] = fr >= 2 ? av2[j] : pv2[j];
                    }
                    const f32x4 zcg = *(const LAS f32x4*)(wp + 96) + *(const LAS f32x4*)(wp) * g2 + *(const LAS f32x4*)(wp + 32) * g1 + *(const LAS f32x4*)(wp + 64) * zg;
                    const f32x4 zcv = *(const LAS f32x4*)(wp + 224) + *(const LAS f32x4*)(wp + 128) * v2 + *(const LAS f32x4*)(wp + 160) * v1 + *(const LAS f32x4*)(wp + 192) * zv;
                    u32x2 o; o.x = pk2(silu(zcg[0]) * zcv[0], silu(zcg[1]) * zcv[1]); o.y = pk2(silu(zcg[2]) * zcv[2], silu(zcg[3]) * zcv[3]);
                    if (m != 0 || fr >= 2) *(u32x2*)(AC + (size_t)row * DFF + c) = o;
                    if ((m == 0 && fr < 2) || (m == 3 && fr >= 14)) {
                        const int slot = m == 0 ? fr : fr - 12;
                        bf16_t* hp = H + ((size_t)(row >> 6) * 4 + slot) * NUP + c;
                        u32x2 hg; hg.x = pk2(zg[0], zg[1]); hg.y = pk2(zg[2], zg[3]); *(u32x2*)hp = hg;
                        u32x2 hv; hv.x = pk2(zv[0], zv[1]); hv.y = pk2(zv[2], zv[3]); *(u32x2*)(hp + DFF) = hv;
                    }
                    pg1 = ag1; pg2 = ag2; pv1 = av1; pv2 = av2;
                    asm volatile("" ::: "memory"); __builtin_amdgcn_sched_barrier(0);
                }
            }
        }
        ++k;
    }
};

template <bool UPMAP = false> __device__ __forceinline__ void transpose_item(const float* W, int K, int N, bf16_t* WT, LAS float* scr, int item, int lane, const float* gk = nullptr) {
    const int nblk = N / 32, kb = item / nblk, nb = item % nblk, k0 = 64 * kb, n0 = 32 * nb;
    const int r0 = !UPMAP ? n0 : (n0 < DFF ? (n0 >> 7) * 256 + (n0 & 127) : ((n0 - DFF) >> 7) * 256 + 128 + ((n0 - DFF) & 127));
    f32x4 wv[8];
#pragma unroll
    for (int i = 0; i < 8; ++i) wv[i] = *(const f32x4*)(W + (size_t)(k0 + 8 * i + (lane >> 3)) * N + n0 + (lane & 7) * 4);
#pragma unroll
    for (int i = 0; i < 8; ++i) { const int kk = 8 * i + (lane >> 3); const float gsc = gk ? gk[k0 + kk] : 1.f; LAS float* sp = scr + kk * 33 + (lane & 7) * 4;
        sp[0] = wv[i][0] * gsc; sp[1] = wv[i][1] * gsc; sp[2] = wv[i][2] * gsc; sp[3] = wv[i][3] * gsc; }
    asm volatile("s_waitcnt lgkmcnt(0)" ::: "memory");
    const int c = lane & 7;
#pragma unroll
    for (int j = 0; j < 4; ++j) { const int n = (lane >> 3) + 8 * j; const LAS float* s = scr + (8 * c) * 33 + n;
        u32x4 o; o.x = pk2(s[0 * 33], s[1 * 33]); o.y = pk2(s[2 * 33], s[3 * 33]); o.z = pk2(s[4 * 33], s[5 * 33]); o.w = pk2(s[6 * 33], s[7 * 33]);
        *(u32x4*)(WT + (size_t)(r0 + n) * K + k0 + 8 * c) = o; }
    asm volatile("s_waitcnt lgkmcnt(0)" ::: "memory");
}
__device__ __forceinline__ void convert_set(const Args& a, LAS unsigned char* lds, int set, int l, int first_block = 0, int n_blocks = 0) {
    const int tid = opaque_tid(), lane = tid & 63, wave = tid >> 6;
    LAS float* scr = (LAS float*)(lds + wave * 16384);
    if (n_blocks == 0) n_blocks = gridDim.x;
    if ((int)blockIdx.x < first_block || (int)blockIdx.x >= first_block + n_blocks) return;
    const int gw = ((int)blockIdx.x - first_block) * 8 + wave, NGW = n_blocks * 8;
    unsigned char* ws = a.ws;
    if (set == 0) {
        constexpr int I0 = (D / 64) * (INC / 32), I1 = (512 / 64) * (D / 32), I3 = (D / 64) * (D / 32), NI = I0 + 2 * I1 + I3;
        for (int it = gw; it < NI; it += NGW) {
            int r = it;
            if (r < I0) { transpose_item(a.w_in + (size_t)l * D * INC, D, INC, (bf16_t*)(ws + WS_WIN), scr, r, lane, a.mix_norm + l * D); continue; } r -= I0;
            if (r < I1) { transpose_item(a.w_br_gm + (size_t)l * 512 * D, 512, D, (bf16_t*)(ws + WS_WGM), scr, r, lane); continue; } r -= I1;
            if (r < I1) { transpose_item(a.w_br_hg + (size_t)l * 512 * D, 512, D, (bf16_t*)(ws + WS_WHG), scr, r, lane); continue; } r -= I1;
            transpose_item(a.w_out + (size_t)l * D * D, D, D, (bf16_t*)(ws + WS_WOUT), scr, r, lane);
        }
    } else {
        constexpr int I0 = (D / 64) * (NUP / 32), I1 = (DFF / 64) * (D / 32), NI = I0 + I1;
        for (int it = gw; it < NI; it += NGW) {
            int r = it;
            if (r < I0) { transpose_item<true>(a.w_up + (size_t)l * D * NUP, D, NUP, (bf16_t*)(ws + WS_WUP + (l & 1) * WS_FFNW_STRIDE), scr, r, lane, a.ffn_norm + l * D); continue; } r -= I0;
            transpose_item(a.w_down + (size_t)l * DFF * D, DFF, D, (bf16_t*)(ws + WS_WDN + (l & 1) * WS_FFNW_STRIDE), scr, r, lane);
        }
    }
}

#define LDS_BARRIER() asm volatile("s_waitcnt lgkmcnt(0)\n\ts_barrier" ::: "memory")
constexpr int LDQ = 136, LDV = 72, LDG = 132;
__device__ __forceinline__ bf16x8 ldfrag(const LAS bf16_t* base, int ld, int fr, int fq, int k0) { return *(const LAS bf16x8*)(base + fr * ld + k0 + fq * 8); }
#define MMA16(xf, yf, acc) __builtin_amdgcn_mfma_f32_16x16x32_bf16((xf), (yf), (acc), 0, 0, 0)

__device__ __forceinline__ void gmlp_unit(const Args& a, LAS unsigned char* lds, int unit, int l, bool load_w) {
    const int tid = opaque_tid(), lane = tid & 63, w = tid >> 6, fr = lane & 15, fq = lane >> 4;
    const int h = unit & 3, blk = (unit >> 2) & 63, b = unit >> 8;
    const size_t r0 = (size_t)b * SEQ + (size_t)blk * 128;
    LAS bf16_t* Vt = (LAS bf16_t*)lds;
    LAS bf16_t* Wl = Vt + 128 * LDQ;
    LAS f32x2* stat = (LAS f32x2*)(Wl + 128 * LDQ);
    const bf16_t* Vg = (const bf16_t*)(a.ws + WS_V); bf16_t* Ug = (bf16_t*)(a.ws + WS_U);
    const float* lng = a.gm_ln_g + l * 512; const float* lnb = a.gm_ln_b + l * 512;
    const float* wsrc = a.gm_ws + (size_t)(l * 4 + h) * 16384;
    u32x4 vraw[4]; f32x4 wreg[8];
#pragma unroll
    for (int it = 0; it < 4; ++it) vraw[it] = *(const u32x4*)(Vg + (r0 + (it & 1) * 64 + lane) * 512 + h * 128 + ((it >> 1) * 8 + w) * 8);
#pragma unroll
    for (int it = 0; it < 8; ++it) { const int idx = it * 512 + tid; wreg[it] = load_w ? *(const f32x4*)(wsrc + (idx >> 5) * 128 + (idx & 31) * 4) : (f32x4){0.f, 0.f, 0.f, 0.f}; }
    f32x4 lg[2][2], lb2[2][2];
#pragma unroll
    for (int q = 0; q < 2; ++q) { const int cg0 = h * 128 + (q * 8 + w) * 8; lg[q][0] = *(const f32x4*)(lng + cg0); lg[q][1] = *(const f32x4*)(lng + cg0 + 4); lb2[q][0] = *(const f32x4*)(lnb + cg0); lb2[q][1] = *(const f32x4*)(lnb + cg0 + 4); }
    if (tid < 128) {
        const f32x4* vp = (const f32x4*)((const float*)(a.ws + WS_VS) + (r0 + tid) * 16);
        const f32x4 p0 = vp[0], p1 = vp[1], p2 = vp[2], p3 = vp[3];
        const float s1 = ((p0[0] + p0[2]) + (p1[0] + p1[2])) + ((p2[0] + p2[2]) + (p3[0] + p3[2])), s2 = ((p0[1] + p0[3]) + (p1[1] + p1[3])) + ((p2[1] + p2[3]) + (p3[1] + p3[3]));
        const float mean = s1 * (1.f / 512.f), var = fmaxf(s2 * (1.f / 512.f) - mean * mean, 0.f);
        stat[tid] = (f32x2){mean, rsqrtf(var + EPS)};
    }
    if (load_w)
#pragma unroll
    for (int it = 0; it < 8; ++it) {
        const int idx = it * 512 + tid, i = idx >> 5, j4 = (idx & 31) * 4;
        f32x4 wv = wreg[it];
        if ((i >> 6) < (j4 >> 6)) wv = (f32x4){0.f, 0.f, 0.f, 0.f};
        u32x2 o; o.x = pk2(wv[0], wv[1]); o.y = pk2(wv[2], wv[3]);
        *(LAS u32x2*)(Wl + i * LDQ + j4) = o;
    }
    LDS_BARRIER();
#pragma unroll
    for (int it = 0; it < 4; ++it) {
        const int j = (it & 1) * 64 + lane, d0 = ((it >> 1) * 8 + w) * 8;
        const f32x2 st = stat[j];
        float x[8]; unpack8(vraw[it], x);
#pragma unroll
        for (int e = 0; e < 8; ++e) Vt[(d0 + e) * LDQ + j] = (bf16_t)f2bf((x[e] - st.x) * st.y * lg[it >> 1][e >> 2][e & 3] + lb2[it >> 1][e >> 2][e & 3]);
    }
    LDS_BARRIER();
    bf16x8 af[4];
#pragma unroll
    for (int ks = 0; ks < 4; ++ks) af[ks] = ldfrag(Wl + (w * 16) * LDQ, LDQ, fr, fq, ks * 32);
    const int i = w * 16 + fr; const float bias = a.gm_bs[(l * 4 + h) * 128 + i];
    u32x2 ureg[8];
#pragma unroll
    for (int dt = 0; dt < 8; ++dt) ureg[dt] = *(const u32x2*)(Ug + (r0 + i) * 512 + h * 128 + dt * 16 + 4 * fq);
#pragma unroll
    for (int dt = 0; dt < 8; ++dt) {
        f32x4 acc = {0.f, 0.f, 0.f, 0.f};
#pragma unroll
        for (int ks = 0; ks < 4; ++ks) acc = MMA16(ldfrag(Vt + (dt * 16) * LDQ, LDQ, fr, fq, ks * 32), af[ks], acc);
        bf16_t* up = Ug + (r0 + i) * 512 + h * 128 + dt * 16 + 4 * fq;
        const u32x2 uu = ureg[dt];
        u32x2 o; o.x = pk2(bf2f(uu.x & 0xffffu) * (acc[0] + bias), bf2f(uu.x >> 16) * (acc[1] + bias));
        o.y = pk2(bf2f(uu.y & 0xffffu) * (acc[2] + bias), bf2f(uu.y >> 16) * (acc[3] + bias));
        *(u32x2*)up = o;
    }
    LDS_BARRIER();
}

__device__ __forceinline__ void hg1_unit(const Args& a, LAS unsigned char* lds, int unit) {
    const int tid = opaque_tid(), lane = tid & 63, w = tid >> 6, fr = lane & 15, fq = lane >> 4;
    const int c = unit & 127, bh = unit >> 7, h = bh & 3, b = bh >> 2;
    const size_t r0 = (size_t)b * SEQ + (size_t)c * 64;
    LAS float* Gs = (LAS float*)lds;
    LAS float* Tot = Gs + 64 * LDG;
    LAS bf16_t* Vt = (LAS bf16_t*)(lds + 64 * LDG * 4 + 2048);
    LAS bf16_t* Kt = Vt + 128 * LDV;
    float* GLg = (float*)(a.ws + WS_GL); const bf16_t* Ig = (const bf16_t*)(a.ws + WS_I); const bf16_t* Kg = (const bf16_t*)(a.ws + WS_KK);
    const int d = tid & 127, sg = tid >> 7;
    float* gp = GLg + (r0 + sg * 16) * 512 + h * 128 + d;
    float g[16];
#pragma unroll
    for (int j = 0; j < 16; ++j) g[j] = gp[(size_t)j * 512];
#pragma unroll
    for (int j = 1; j < 16; ++j) g[j] += g[j - 1];
    Tot[sg * 128 + d] = g[15];
    u32x4 kraw[2], vraw[2];
#pragma unroll
    for (int it = 0; it < 2; ++it) { const int idx = it * 512 + tid; const size_t go = (r0 + (idx >> 4)) * 512 + h * 128 + (idx & 15) * 8; vraw[it] = *(const u32x4*)(Ig + go); kraw[it] = *(const u32x4*)(Kg + go); }
#pragma unroll
    for (int it = 0; it < 2; ++it) {
        const int idx = it * 512 + tid, j = idx >> 4, e0 = (idx & 15) * 8;
        const u32x4 raw = vraw[it];
        const unsigned rw[4] = {raw.x, raw.y, raw.z, raw.w};
#pragma unroll
        for (int e = 0; e < 8; ++e) Vt[(e0 + e) * LDV + j] = (bf16_t)((rw[e >> 1] >> ((e & 1) * 16)) & 0xffffu);
    }
    LDS_BARRIER();
    float off = 0.f;
#pragma unroll
    for (int s = 0; s < 3; ++s) off += (s < sg) ? Tot[s * 128 + d] : 0.f;
#pragma unroll
    for (int j = 0; j < 16; ++j) { g[j] += off; gp[(size_t)j * 512] = g[j]; Gs[(sg * 16 + j) * LDG + d] = g[j]; }
    LDS_BARRIER();
#pragma unroll
    for (int it = 0; it < 2; ++it) {
        const int idx = it * 512 + tid, j = idx >> 4, d0 = (idx & 15) * 8;
        float kv[8]; unpack8(kraw[it], kv);
#pragma unroll
        for (int e = 0; e < 8; ++e) Kt[(d0 + e) * LDV + j] = (bf16_t)f2bf(kv[e] * fexp2(Gs[63 * LDG + d0 + e] - Gs[j * LDG + d0 + e]));
    }
    if (tid < 128) ((float*)(a.ws + WS_DEC))[(size_t)unit * 128 + tid] = fexp2(Gs[63 * LDG + tid]);
    LDS_BARRIER();
    bf16x8 af[2];
#pragma unroll
    for (int ks = 0; ks < 2; ++ks) af[ks] = ldfrag(Vt + (w * 16) * LDV, LDV, fr, fq, ks * 32);
    float* STg = (float*)(a.ws + WS_ST) + (size_t)unit * 16384;
#pragma unroll
    for (int dt = 0; dt < 8; ++dt) {
        f32x4 acc = {0.f, 0.f, 0.f, 0.f};
#pragma unroll
        for (int ks = 0; ks < 2; ++ks) acc = MMA16(ldfrag(Kt + (dt * 16) * LDV, LDV, fr, fq, ks * 32), af[ks], acc);
        *(f32x4*)(STg + (w * 16 + fr) * 128 + dt * 16 + 4 * fq) = acc;
    }
    LDS_BARRIER();
}

__device__ __forceinline__ void hg_scan(const Args& a) {
    float* ST = (float*)(a.ws + WS_ST); const float* DEC = (const float*)(a.ws + WS_DEC);
    for (int idx = blockIdx.x * 512 + opaque_tid(); idx < 8 * 8192; idx += gridDim.x * 512) {
        const int bh = idx >> 13, ed = (idx & 8191) * 2, d = ed & 127;
        float* p = ST + (size_t)bh * 128 * 16384 + ed; const float* dc = DEC + (size_t)bh * 128 * 128 + d;
        f32x2 S = {0.f, 0.f};
#pragma unroll 32
        for (int c = 0; c < 128; ++c) { const f32x2 u = *(const f32x2*)(p + (size_t)c * 16384); const f32x2 dec = *(const f32x2*)(dc + c * 128); *(f32x2*)(p + (size_t)c * 16384) = S; S = dec * S + u; }
    }
}

__device__ __forceinline__ void hg3_unit(const Args& a, LAS unsigned char* lds, int unit, int l) {
    const int tid = opaque_tid(), lane = tid & 63, w = tid >> 6, fr = lane & 15, fq = lane >> 4;
    const int c = unit & 127, bh = unit >> 7, h = bh & 3, b = bh >> 2;
    const size_t r0 = (size_t)b * SEQ + (size_t)c * 64;
    LAS bf16_t* Qh = (LAS bf16_t*)lds;
    LAS bf16_t* Qt = Qh + 64 * LDQ;
    LAS bf16_t* Kh = Qt + 64 * LDQ;
    LAS bf16_t* Vt = Kh + 160 * LDQ;
    LAS bf16_t* As = Vt + 128 * LDV;
    LAS bf16_t* Sts = Kh;
    LAS float* Os = (LAS float*)Qh;
    const float* GLg = (const float*)(a.ws + WS_GL); const bf16_t* Ig = (const bf16_t*)(a.ws + WS_I);
    const bf16_t* Qg = (const bf16_t*)(a.ws + WS_Q); const bf16_t* Kg = (const bf16_t*)(a.ws + WS_KK);
    const float* STg = (const float*)(a.ws + WS_ST) + (size_t)unit * 16384;
    f32x4 sreg[8]; unsigned ogreg[8];
    bf16_t* OGg = (bf16_t*)(a.ws + WS_OG);
#pragma unroll
    for (int it = 0; it < 8; ++it) { const int idx = it * 512 + tid; sreg[it] = *(const f32x4*)(STg + (idx >> 5) * 128 + (idx & 31) * 4); }
#pragma unroll
    for (int rr = 0; rr < 8; ++rr) ogreg[rr] = *(const unsigned*)(OGg + (r0 + w * 8 + rr) * 512 + h * 128 + 2 * lane);
#pragma unroll
    for (int it = 0; it < 2; ++it) {
        const int idx = it * 512 + tid, j = idx >> 4, d0 = (idx & 15) * 8;
        const int J = __builtin_amdgcn_readfirstlane(j >> 4);
        const size_t go = (r0 + j) * 512 + h * 128 + d0;
        float qv[8], kv[8]; unpack8(*(const u32x4*)(Qg + go), qv); unpack8(*(const u32x4*)(Kg + go), kv);
        const f32x4 ga = *(const f32x4*)(GLg + go), gb = *(const f32x4*)(GLg + go + 4);
        const float gj[8] = {ga[0], ga[1], ga[2], ga[3], gb[0], gb[1], gb[2], gb[3]};
        const u32x4 raw = *(const u32x4*)(Ig + go);
        {
            u32x4 o; o.x = pk2(qv[0] * fexp2(gj[0]), qv[1] * fexp2(gj[1])); o.y = pk2(qv[2] * fexp2(gj[2]), qv[3] * fexp2(gj[3]));
            o.z = pk2(qv[4] * fexp2(gj[4]), qv[5] * fexp2(gj[5])); o.w = pk2(qv[6] * fexp2(gj[6]), qv[7] * fexp2(gj[7]));
            *(LAS u32x4*)(Qt + j * LDQ + d0) = o;
        }
#pragma unroll
        for (int I = 0; I < 4; ++I) {
            if (I >= J) {
                const size_t ro = (r0 + 16 * I) * 512 + h * 128 + d0;
                const f32x4 ra = *(const f32x4*)(GLg + ro), rb = *(const f32x4*)(GLg + ro + 4);
                const float rf[8] = {ra[0], ra[1], ra[2], ra[3], rb[0], rb[1], rb[2], rb[3]};
                float kh[8];
#pragma unroll
                for (int e = 0; e < 8; ++e) kh[e] = kv[e] * fexp2(fminf(rf[e] - gj[e], 120.f));
                u32x4 o; o.x = pk2(kh[0], kh[1]); o.y = pk2(kh[2], kh[3]); o.z = pk2(kh[4], kh[5]); o.w = pk2(kh[6], kh[7]);
                *(LAS u32x4*)(Kh + (8 * I * (I + 1) + j) * LDQ + d0) = o;
                if (I == J) {
                    u32x4 q; q.x = pk2(qv[0] * fexp2(gj[0] - rf[0]), qv[1] * fexp2(gj[1] - rf[1])); q.y = pk2(qv[2] * fexp2(gj[2] - rf[2]), qv[3] * fexp2(gj[3] - rf[3]));
                    q.z = pk2(qv[4] * fexp2(gj[4] - rf[4]), qv[5] * fexp2(gj[5] - rf[5])); q.w = pk2(qv[6] * fexp2(gj[6] - rf[6]), qv[7] * fexp2(gj[7] - rf[7]));
                    *(LAS u32x4*)(Qh + j * LDQ + d0) = q;
                }
            }
        }
        const unsigned rw[4] = {raw.x, raw.y, raw.z, raw.w};
#pragma unroll
        for (int e = 0; e < 8; ++e) Vt[(d0 + e) * LDV + j] = (bf16_t)((rw[e >> 1] >> ((e & 1) * 16)) & 0xffffu);
    }
    for (int idx = tid; idx < 64 * LDV / 8; idx += 512) *(LAS u32x4*)(As + idx * 8) = (u32x4){0u, 0u, 0u, 0u};
    LDS_BARRIER();
#pragma unroll 1
    for (int t = w; t < 10; t += 8) {
        const int I = t >= 6 ? 3 : t >= 3 ? 2 : t >= 1 ? 1 : 0, J = t - (I * (I + 1)) / 2;
        f32x4 acc = {0.f, 0.f, 0.f, 0.f};
#pragma unroll
        for (int ks = 0; ks < 4; ++ks) acc = MMA16(ldfrag(Kh + (8 * I * (I + 1) + 16 * J) * LDQ, LDQ, fr, fq, ks * 32), ldfrag(Qh + (16 * I) * LDQ, LDQ, fr, fq, ks * 32), acc);
        if (I == J) {
#pragma unroll
            for (int r = 0; r < 4; ++r) acc[r] = (4 * fq + r <= fr) ? acc[r] : 0.f;
        }
        u32x2 o; o.x = pk2(acc[0], acc[1]); o.y = pk2(acc[2], acc[3]);
        *(LAS u32x2*)(As + (16 * I + fr) * LDV + 16 * J + 4 * fq) = o;
    }
    LDS_BARRIER();
#pragma unroll
    for (int it = 0; it < 8; ++it) {
        const int idx = it * 512 + tid, e = idx >> 5, d4 = (idx & 31) * 4;
        const f32x4 sv = sreg[it];
        u32x2 o; o.x = pk2(sv[0], sv[1]); o.y = pk2(sv[2], sv[3]);
        *(LAS u32x2*)(Sts + e * LDQ + d4) = o;
    }
    LDS_BARRIER();
    {
        const int it = w & 3, eb = (w >> 2) * 4;
        bf16x8 af[2], qf[4];
#pragma unroll
        for (int ks = 0; ks < 2; ++ks) af[ks] = ldfrag(As + (it * 16) * LDV, LDV, fr, fq, ks * 32);
#pragma unroll
        for (int ks = 0; ks < 4; ++ks) qf[ks] = ldfrag(Qt + (it * 16) * LDQ, LDQ, fr, fq, ks * 32);
        LDS_BARRIER();
#pragma unroll
        for (int t = 0; t < 4; ++t) {
            const int et = eb + t; f32x4 acc = {0.f, 0.f, 0.f, 0.f};
#pragma unroll
            for (int ks = 0; ks < 2; ++ks) acc = MMA16(ldfrag(Vt + (et * 16) * LDV, LDV, fr, fq, ks * 32), af[ks], acc);
#pragma unroll
            for (int ks = 0; ks < 4; ++ks) acc = MMA16(ldfrag(Sts + (et * 16) * LDQ, LDQ, fr, fq, ks * 32), qf[ks], acc);
            *(LAS f32x4*)(Os + (it * 16 + fr) * LDG + et * 16 + 4 * fq) = acc;
        }
    }
    LDS_BARRIER();
    {
        const f32x2 ng = *(const f32x2*)(a.hg_norm_g + l * 128 + 2 * lane);
#pragma unroll
        for (int rr = 0; rr < 8; ++rr) {
            const int i = w * 8 + rr;
            const f32x2 o = *(const LAS f32x2*)(Os + i * LDG + 2 * lane);
            const float r = rsqrtf(wave_sum(o.x * o.x + o.y * o.y) * (1.f / 128.f) + EPS);
            unsigned* op = (unsigned*)(OGg + (r0 + i) * 512 + h * 128 + 2 * lane);
            const unsigned og = ogreg[rr];
            *op = pk2(o.x * r * ng.x * bf2f(og & 0xffffu), o.y * r * ng.y * bf2f(og >> 16));
        }
    }
    LDS_BARRIER();
}

constexpr int HG_GC = 4, HG_NG = (SEQ / 64) / HG_GC;
__device__ __forceinline__ void hg1g_unit(const Args& a, LAS unsigned char* lds, int unit) {
    const int tid = opaque_tid(), lane = tid & 63, w = tid >> 6, fr = lane & 15, fq = lane >> 4;
    const int cg = unit % HG_NG, bh = unit / HG_NG, h = bh & 3, b = bh >> 2;
    LAS float* Gs = (LAS float*)lds;
    LAS float* Tot = Gs + 64 * LDG;
    LAS bf16_t* Vt = (LAS bf16_t*)(lds + 64 * LDG * 4 + 2048);
    LAS bf16_t* Kt = Vt + 128 * LDV;
    float* GLg = (float*)(a.ws + WS_GL); const bf16_t* Ig = (const bf16_t*)(a.ws + WS_I); const bf16_t* Kg = (const bf16_t*)(a.ws + WS_KK);
    const int d = tid & 127, sg = tid >> 7;
    f32x4 acc[8];
#pragma unroll
    for (int dt = 0; dt < 8; ++dt) acc[dt] = (f32x4){0.f, 0.f, 0.f, 0.f};
    float dsum = 0.f;
#pragma unroll 1
    for (int s = 0; s < HG_GC; ++s) {
        const size_t r0 = (size_t)b * SEQ + (size_t)(cg * HG_GC + s) * 64;
        float* gp = GLg + (r0 + sg * 16) * 512 + h * 128 + d;
        float g[16];
#pragma unroll
        for (int j = 0; j < 16; ++j) g[j] = gp[(size_t)j * 512];
        u32x4 kraw[2], vraw[2];
#pragma unroll
        for (int it = 0; it < 2; ++it) { const size_t go = (r0 + lane) * 512 + h * 128 + (it * 8 + w) * 8; vraw[it] = *(const u32x4*)(Ig + go); kraw[it] = *(const u32x4*)(Kg + go); }
#pragma unroll
        for (int j = 1; j < 16; ++j) g[j] += g[j - 1];
        Tot[sg * 128 + d] = g[15];
#pragma unroll
        for (int it = 0; it < 2; ++it) {
            const int j = lane, e0 = (it * 8 + w) * 8;
            const unsigned rw[4] = {vraw[it].x, vraw[it].y, vraw[it].z, vraw[it].w};
#pragma unroll
            for (int e = 0; e < 8; ++e) Vt[(e0 + e) * LDV + j] = (bf16_t)((rw[e >> 1] >> ((e & 1) * 16)) & 0xffffu);
        }
        LDS_BARRIER();
        float off = 0.f;
#pragma unroll
        for (int q = 0; q < 3; ++q) off += (q < sg) ? Tot[q * 128 + d] : 0.f;
#pragma unroll
        for (int j = 0; j < 16; ++j) { g[j] += off; gp[(size_t)j * 512] = g[j]; Gs[(sg * 16 + j) * LDG + d] = g[j]; }
        LDS_BARRIER();
#pragma unroll
        for (int it = 0; it < 2; ++it) {
            const int j = lane, d0 = (it * 8 + w) * 8;
            float kv[8]; unpack8(kraw[it], kv);
            const f32x4 la = *(const LAS f32x4*)(Gs + 63 * LDG + d0), lb = *(const LAS f32x4*)(Gs + 63 * LDG + d0 + 4), ja = *(const LAS f32x4*)(Gs + j * LDG + d0), jb = *(const LAS f32x4*)(Gs + j * LDG + d0 + 4);
            const float dl[8] = {la[0] - ja[0], la[1] - ja[1], la[2] - ja[2], la[3] - ja[3], lb[0] - jb[0], lb[1] - jb[1], lb[2] - jb[2], lb[3] - jb[3]};
#pragma unroll
            for (int e = 0; e < 8; ++e) Kt[(d0 + e) * LDV + j] = (bf16_t)f2bf(kv[e] * fexp2(dl[e]));
        }
        if (tid < 128) { const float g63 = Gs[63 * LDG + tid]; dsum += g63; Tot[tid] = fexp2(g63); }
        LDS_BARRIER();
        bf16x8 af[2];
#pragma unroll
        for (int ks = 0; ks < 2; ++ks) af[ks] = ldfrag(Vt + (w * 16) * LDV, LDV, fr, fq, ks * 32);
#pragma unroll
        for (int dt = 0; dt < 8; ++dt) {
            acc[dt] = acc[dt] * *(const LAS f32x4*)(Tot + dt * 16 + 4 * fq);
#pragma unroll
            for (int ks = 0; ks < 2; ++ks) acc[dt] = MMA16(ldfrag(Kt + (dt * 16) * LDV, LDV, fr, fq, ks * 32), af[ks], acc[dt]);
        }
        LDS_BARRIER();
    }
    float* TGg = (float*)(a.ws + WS_ST) + (size_t)unit * 16384;
#pragma unroll
    for (int dt = 0; dt < 8; ++dt) *(f32x4*)(TGg + (w * 16 + fr) * 128 + dt * 16 + 4 * fq) = acc[dt];
    if (tid < 128) ((float*)(a.ws + WS_DEC))[(size_t)unit * 128 + tid] = fexp2(dsum);
}
__device__ __forceinline__ void hg_gscan(const Args& a) {
    const float* TG = (const float*)(a.ws + WS_ST); float* SG = (float*)(a.ws + WS_ST + 16 * MiB); const float* DG = (const float*)(a.ws + WS_DEC);
    for (int idx = blockIdx.x * 512 + opaque_tid(); idx < 8 * 16384; idx += gridDim.x * 512) {
        const int bh = idx >> 14, ed = idx & 16383, d = ed & 127;
        const float* p = TG + (size_t)bh * HG_NG * 16384 + ed; float* q = SG + (size_t)bh * HG_NG * 16384 + ed; const float* dc = DG + (size_t)bh * HG_NG * 128 + d;
        float S = 0.f;
#pragma unroll
        for (int c = 0; c < HG_NG; ++c) { const float u = p[(size_t)c * 16384]; const float dec = dc[c * 128]; q[(size_t)c * 16384] = S; S = dec * S + u; }
    }
}
__device__ __forceinline__ void hg3g_unit(const Args& a, LAS unsigned char* lds, int unit, int l, unsigned long long& pr_acc) {
    unsigned long long pt0 = 0;
#define HP_B(bit) do { if ((PROBE_MASK) & (bit)) pt0 = __builtin_amdgcn_s_memrealtime(); } while (0)
#define HP_E(bit) do { if ((PROBE_MASK) & (bit)) pr_acc += __builtin_amdgcn_s_memrealtime() - pt0; } while (0)
    const int tid = opaque_tid(), lane = tid & 63, w = tid >> 6, fr = lane & 15, fq = lane >> 4;
    const int cg = unit % HG_NG, bh = unit / HG_NG, h = bh & 3, b = bh >> 2;
    LAS bf16_t* Qh = (LAS bf16_t*)lds;
    LAS bf16_t* Qt = Qh + 64 * LDQ;
    LAS bf16_t* Kh = Qt + 64 * LDQ;
    LAS bf16_t* Vt = Kh + 160 * LDQ;
    LAS bf16_t* As = Vt + 128 * LDV;
    LAS bf16_t* Sts = As + 64 * LDV;
    LAS float* Os = (LAS float*)Qh;
    LAS bf16_t* Kt = Kh; LAS float* DecL = (LAS float*)(Kh + 128 * LDV);
    const float* GLg = (const float*)(a.ws + WS_GL); const bf16_t* Ig = (const bf16_t*)(a.ws + WS_I);
    const bf16_t* Qg = (const bf16_t*)(a.ws + WS_Q); const bf16_t* Kg = (const bf16_t*)(a.ws + WS_KK);
    bf16_t* OGg = (bf16_t*)(a.ws + WS_OG);
    f32x4 acc[8];
    {
        const float* TGg = (const float*)(a.ws + WS_ST + 16 * MiB) + (size_t)unit * 16384;
#pragma unroll
        for (int dt = 0; dt < 8; ++dt) acc[dt] = *(const f32x4*)(TGg + (w * 16 + fr) * 128 + dt * 16 + 4 * fq);
#pragma unroll
        for (int dt = 0; dt < 8; ++dt) { u32x2 o; o.x = pk2(acc[dt][0], acc[dt][1]); o.y = pk2(acc[dt][2], acc[dt][3]); *(LAS u32x2*)(Sts + (w * 16 + fr) * LDQ + dt * 16 + 4 * fq) = o; }
    }
    u32x4 nq[2], nk[2], nv[2]; f32x4 nga[2], ngb[2]; float ng63 = 0.f;
#define HG3_LOADS(R0) do { _Pragma("unroll") for (int it_ = 0; it_ < 2; ++it_) { const size_t go_ = ((R0) + 16 * ((it_ * 8 + w) >> 2) + (lane & 15)) * 512 + h * 128 + (((it_ * 8 + w) & 3) * 4 + (lane >> 4)) * 8; \
        nq[it_] = *(const u32x4*)(Qg + go_); nk[it_] = *(const u32x4*)(Kg + go_); nv[it_] = *(const u32x4*)(Ig + go_); nga[it_] = *(const f32x4*)(GLg + go_); ngb[it_] = *(const f32x4*)(GLg + go_ + 4); \
        } \
        if (tid < 128) ng63 = GLg[((R0) + 63) * 512 + h * 128 + tid]; } while (0)
    { const size_t rr0 = (size_t)b * SEQ + (size_t)(cg * HG_GC) * 64; HG3_LOADS(rr0); }
#pragma unroll 1
    for (int s = 0; s < HG_GC; ++s) {
        const size_t r0 = (size_t)b * SEQ + (size_t)(cg * HG_GC + s) * 64;
        HP_B(0x10000);
        unsigned ogreg[8]; u32x4 ktp[2]; u32x4 cq[2], ck[2], cv[2]; f32x4 cga[2], cgb[2];
        const float g63s = ng63;
        { const u32x4* ogp = (const u32x4*)(OGg + (r0 + w * 8 + (lane >> 3)) * 512 + h * 128 + (lane & 7) * 16); const u32x4 o0 = ogp[0], o1 = ogp[1];
          ogreg[0] = o0.x; ogreg[1] = o0.y; ogreg[2] = o0.z; ogreg[3] = o0.w; ogreg[4] = o1.x; ogreg[5] = o1.y; ogreg[6] = o1.z; ogreg[7] = o1.w; }
#pragma unroll
        for (int it = 0; it < 2; ++it) { cq[it] = nq[it]; ck[it] = nk[it]; cv[it] = nv[it]; cga[it] = nga[it]; cgb[it] = ngb[it]; }
        if (s + 1 < HG_GC) { const size_t rn = r0 + 64; HG3_LOADS(rn); }
#pragma unroll
        for (int it = 0; it < 2; ++it) {
            const int J = (it * 8 + w) >> 2, j = 16 * J + (lane & 15), d0 = (((it * 8 + w) & 3) * 4 + (lane >> 4)) * 8;
            float qv[8], kv[8]; unpack8(cq[it], qv); unpack8(ck[it], kv);
            const f32x4 ga = cga[it], gb = cgb[it];
            const float gj[8] = {ga[0], ga[1], ga[2], ga[3], gb[0], gb[1], gb[2], gb[3]};
            const u32x4 raw = cv[it];
            {
                const size_t lo = (r0 + 63) * 512 + h * 128 + d0;
                const f32x4 la = *(const f32x4*)(GLg + lo), lb = *(const f32x4*)(GLg + lo + 4);
                const float gl[8] = {la[0], la[1], la[2], la[3], lb[0], lb[1], lb[2], lb[3]};
                u32x4 o; o.x = pk2(kv[0] * fexp2(gl[0] - gj[0]), kv[1] * fexp2(gl[1] - gj[1])); o.y = pk2(kv[2] * fexp2(gl[2] - gj[2]), kv[3] * fexp2(gl[3] - gj[3]));
                o.z = pk2(kv[4] * fexp2(gl[4] - gj[4]), kv[5] * fexp2(gl[5] - gj[5])); o.w = pk2(kv[6] * fexp2(gl[6] - gj[6]), kv[7] * fexp2(gl[7] - gj[7]));
                ktp[it] = o;
            }
            {
                u32x4 o; o.x = pk2(qv[0] * fexp2(gj[0]), qv[1] * fexp2(gj[1])); o.y = pk2(qv[2] * fexp2(gj[2]), qv[3] * fexp2(gj[3]));
                o.z = pk2(qv[4] * fexp2(gj[4]), qv[5] * fexp2(gj[5])); o.w = pk2(qv[6] * fexp2(gj[6]), qv[7] * fexp2(gj[7]));
                *(LAS u32x4*)(Qt + j * LDQ + d0) = o;
            }
            {
                const size_t ro = (r0 + 16 * J) * 512 + h * 128 + d0;
                const f32x4 ra = *(const f32x4*)(GLg + ro), rb = *(const f32x4*)(GLg + ro + 4);
                const float rf[8] = {ra[0], ra[1], ra[2], ra[3], rb[0], rb[1], rb[2], rb[3]};
                u32x4 q; q.x = pk2(qv[0] * fexp2(gj[0] - rf[0]), qv[1] * fexp2(gj[1] - rf[1])); q.y = pk2(qv[2] * fexp2(gj[2] - rf[2]), qv[3] * fexp2(gj[3] - rf[3]));
                q.z = pk2(qv[4] * fexp2(gj[4] - rf[4]), qv[5] * fexp2(gj[5] - rf[5])); q.w = pk2(qv[6] * fexp2(gj[6] - rf[6]), qv[7] * fexp2(gj[7] - rf[7]));
                *(LAS u32x4*)(Qh + j * LDQ + d0) = q;
            }
#pragma unroll
            for (int I = 0; I < 4; ++I) if (I >= J) {
                const size_t ro = (r0 + 16 * I) * 512 + h * 128 + d0;
                const f32x4 ra = *(const f32x4*)(GLg + ro), rb = *(const f32x4*)(GLg + ro + 4);
                const float rf[8] = {ra[0], ra[1], ra[2], ra[3], rb[0], rb[1], rb[2], rb[3]};
                float kh[8];
#pragma unroll
                for (int e = 0; e < 8; ++e) kh[e] = kv[e] * fexp2(fminf(rf[e] - gj[e], 120.f));
                u32x4 o; o.x = pk2(kh[0], kh[1]); o.y = pk2(kh[2], kh[3]); o.z = pk2(kh[4], kh[5]); o.w = pk2(kh[6], kh[7]);
                *(LAS u32x4*)(Kh + (8 * I * (I + 1) + j) * LDQ + d0) = o;
            }
            const unsigned rw[4] = {raw.x, raw.y, raw.z, raw.w};
#pragma unroll
            for (int e = 0; e < 8; ++e) Vt[(d0 + e) * LDV + j] = (bf16_t)((rw[e >> 1] >> ((e & 1) * 16)) & 0xffffu);
        }
        for (int idx = tid; idx < 64 * LDV / 8; idx += 512) *(LAS u32x4*)(As + idx * 8) = (u32x4){0u, 0u, 0u, 0u};
        LDS_BARRIER();
        HP_E(0x10000); HP_B(0x20000);
#pragma unroll 1
        for (int t = w; t < 10; t += 8) {
            const int I = t >= 6 ? 3 : t >= 3 ? 2 : t >= 1 ? 1 : 0, J = t - (I * (I + 1)) / 2;
            f32x4 sc = {0.f, 0.f, 0.f, 0.f};
#pragma unroll
            for (int ks = 0; ks < 4; ++ks) sc = MMA16(ldfrag(Kh + (8 * I * (I + 1) + 16 * J) * LDQ, LDQ, fr, fq, ks * 32), ldfrag(Qh + (16 * I) * LDQ, LDQ, fr, fq, ks * 32), sc);
            if (I == J) {
#pragma unroll
                for (int r = 0; r < 4; ++r) sc[r] = (4 * fq + r <= fr) ? sc[r] : 0.f;
            }
            u32x2 o; o.x = pk2(sc[0], sc[1]); o.y = pk2(sc[2], sc[3]);
            *(LAS u32x2*)(As + (16 * I + fr) * LDV + 16 * J + 4 * fq) = o;
        }
        LDS_BARRIER();
        HP_E(0x20000); HP_B(0x40000);
        const int it4 = w & 3, eb = (w >> 2) * 4;
        bf16x8 af[2], qf[4];
#pragma unroll
        for (int ks = 0; ks < 2; ++ks) af[ks] = ldfrag(As + (it4 * 16) * LDV, LDV, fr, fq, ks * 32);
#pragma unroll
        for (int ks = 0; ks < 4; ++ks) qf[ks] = ldfrag(Qt + (it4 * 16) * LDQ, LDQ, fr, fq, ks * 32);
#pragma unroll
        for (int it = 0; it < 2; ++it) {
            const int j = 16 * ((it * 8 + w) >> 2) + (lane & 15), d0 = (((it * 8 + w) & 3) * 4 + (lane >> 4)) * 8;
            const unsigned rw[4] = {ktp[it].x, ktp[it].y, ktp[it].z, ktp[it].w};
#pragma unroll
            for (int e = 0; e < 8; ++e) Kt[(d0 + e) * LDV + j] = (bf16_t)((rw[e >> 1] >> ((e & 1) * 16)) & 0xffffu);
        }
        if (tid < 128) DecL[tid] = fexp2(g63s);
        LDS_BARRIER();
#pragma unroll
        for (int t = 0; t < 4; ++t) {
            const int et = eb + t; f32x4 o = {0.f, 0.f, 0.f, 0.f};
#pragma unroll
            for (int ks = 0; ks < 2; ++ks) o = MMA16(ldfrag(Vt + (et * 16) * LDV, LDV, fr, fq, ks * 32), af[ks], o);
#pragma unroll
            for (int ks = 0; ks < 4; ++ks) o = MMA16(ldfrag(Sts + (et * 16) * LDQ, LDQ, fr, fq, ks * 32), qf[ks], o);
            *(LAS f32x4*)(Os + (it4 * 16 + fr) * LDG + et * 16 + 4 * fq) = o;
        }
        {
            bf16x8 vf[2];
#pragma unroll
            for (int ks = 0; ks < 2; ++ks) vf[ks] = ldfrag(Vt + (w * 16) * LDV, LDV, fr, fq, ks * 32);
#pragma unroll
            for (int dt = 0; dt < 8; ++dt) {
                acc[dt] = acc[dt] * *(const LAS f32x4*)(DecL + dt * 16 + 4 * fq);
#pragma unroll
                for (int ks = 0; ks < 2; ++ks) acc[dt] = MMA16(ldfrag(Kt + (dt * 16) * LDV, LDV, fr, fq, ks * 32), vf[ks], acc[dt]);
            }
        }
        LDS_BARRIER();
        HP_E(0x40000); HP_B(0x80000);
#pragma unroll
        for (int dt = 0; dt < 8; ++dt) { u32x2 o; o.x = pk2(acc[dt][0], acc[dt][1]); o.y = pk2(acc[dt][2], acc[dt][3]); *(LAS u32x2*)(Sts + (w * 16 + fr) * LDQ + dt * 16 + 4 * fq) = o; }
        {
            const int i = w * 8 + (lane >> 3), c0 = (lane & 7) * 16;
            f32x4 ov[4]; float ss = 0.f;
#pragma unroll
            for (int q = 0; q < 4; ++q) { ov[q] = *(const LAS f32x4*)(Os + i * LDG + c0 + 4 * q); ss += (ov[q][0] * ov[q][0] + ov[q][1] * ov[q][1]) + (ov[q][2] * ov[q][2] + ov[q][3] * ov[q][3]); }
            ss += __shfl_xor(ss, 1); ss += __shfl_xor(ss, 2); ss += __shfl_xor(ss, 4);
            const float r = rsqrtf(ss * (1.f / 128.f) + EPS);
            const float* ngp = a.hg_norm_g + l * 128 + c0;
            unsigned ow[8];
#pragma unroll
            for (int q = 0; q < 4; ++q) { const f32x4 g = *(const f32x4*)(ngp + 4 * q); const unsigned og0 = ogreg[2 * q], og1 = ogreg[2 * q + 1];
                ow[2 * q] = pk2(ov[q][0] * r * g[0] * bf2f(og0 & 0xffffu), ov[q][1] * r * g[1] * bf2f(og0 >> 16));
                ow[2 * q + 1] = pk2(ov[q][2] * r * g[2] * bf2f(og1 & 0xffffu), ov[q][3] * r * g[3] * bf2f(og1 >> 16)); }
            u32x4* op = (u32x4*)(OGg + (r0 + i) * 512 + h * 128 + c0);
            op[0] = (u32x4){ow[0], ow[1], ow[2], ow[3]}; op[1] = (u32x4){ow[4], ow[5], ow[6], ow[7]};
        }
        LDS_BARRIER();
        HP_E(0x80000);
    }
}

__device__ __forceinline__ void conv_fixup(const Args& a, int l) {
    const bf16_t* H = (const bf16_t*)(a.ws + WS_Z); bf16_t* AC = (bf16_t*)(a.ws + WS_AC);
    const float* cw = a.conv_w + (size_t)l * 3 * NUP; const float* cb = a.conv_b + (size_t)l * NUP;
    constexpr int CCH = DFF / 8, NITEM = (M / 64) * CCH;
    for (int item = blockIdx.x * 512 + opaque_tid(); item < NITEM; item += gridDim.x * 512) {
        const int cc = item % CCH, gi = item / CCH, c = cc * 8;
        const bool first = (gi & (SEQ / 64 - 1)) == 0;
        float z[2][4][8];
#pragma unroll
        for (int gv = 0; gv < 2; ++gv) {
            const bf16_t* hp = H + (size_t)gi * 4 * NUP + gv * DFF + c;
            if (first) {
#pragma unroll
                for (int e = 0; e < 8; ++e) { z[gv][0][e] = 0.f; z[gv][1][e] = 0.f; }
            } else { unpack8(*(const u32x4*)(hp - 2 * NUP), z[gv][0]); unpack8(*(const u32x4*)(hp - NUP), z[gv][1]); }
            unpack8(*(const u32x4*)hp, z[gv][2]); unpack8(*(const u32x4*)(hp + NUP), z[gv][3]);
        }
        float w[2][3][8], bb[2][8];
#pragma unroll
        for (int gv = 0; gv < 2; ++gv) {
#pragma unroll
            for (int t = 0; t < 3; ++t) { const f32x4 x0 = *(const f32x4*)(cw + t * NUP + gv * DFF + c), x1 = *(const f32x4*)(cw + t * NUP + gv * DFF + c + 4);
#pragma unroll
                for (int e = 0; e < 4; ++e) { w[gv][t][e] = x0[e]; w[gv][t][4 + e] = x1[e]; } }
            const f32x4 y0 = *(const f32x4*)(cb + gv * DFF + c), y1 = *(const f32x4*)(cb + gv * DFF + c + 4);
#pragma unroll
            for (int e = 0; e < 4; ++e) { bb[gv][e] = y0[e]; bb[gv][4 + e] = y1[e]; }
        }
#pragma unroll
        for (int r = 0; r < 2; ++r) {
            float o[8];
#pragma unroll
            for (int e = 0; e < 8; ++e) {
                const float zg = bb[0][e] + w[0][0][e] * z[0][r][e] + w[0][1][e] * z[0][r + 1][e] + w[0][2][e] * z[0][r + 2][e];
                const float zv = bb[1][e] + w[1][0][e] * z[1][r][e] + w[1][1][e] * z[1][r + 1][e] + w[1][2][e] * z[1][r + 2][e];
                o[e] = silu(zg) * zv;
            }
            u32x4 wv; wv.x = pk2(o[0], o[1]); wv.y = pk2(o[2], o[3]); wv.z = pk2(o[4], o[5]); wv.w = pk2(o[6], o[7]);
            *(u32x4*)(AC + (size_t)(gi * 64 + r) * DFF + c) = wv;
        }
    }
}

__device__ __forceinline__ void prologue(const Args& a, LAS unsigned char* lds) {
    const int tid = opaque_tid(), lane = tid & 63, wave = tid >> 6;
    if (blockIdx.x == 0) {
        float* LB = (float*)(a.ws + WS_LB);
        for (int c = tid; c < 512; c += 512) {
            const float x0 = a.hg_lb[c], x1 = a.hg_lb[512 + c], x2 = a.hg_lb[1024 + c], x3 = a.hg_lb[1536 + c];
            const float mx = fmaxf(fmaxf(x0, x1), fmaxf(x2, x3));
            const float e0 = __expf(x0 - mx), e1 = __expf(x1 - mx), e2 = __expf(x2 - mx), e3 = __expf(x3 - mx), inv = 1.f / (e0 + e1 + e2 + e3);
            const float p1 = e1 * inv, p2 = e2 * inv, p3 = e3 * inv;
            LB[c] = 0.f; LB[512 + c] = fminf(fmaxf(p1, 0.f), 0.999f); LB[1024 + c] = fminf(fmaxf(p1 + p2, 0.f), 0.999f); LB[1536 + c] = fminf(fmaxf(p1 + p2 + p3, 0.f), 0.999f);
        }
    }
    convert_set(a, lds, 0, 0);
    convert_set(a, lds, 1, 0);
    const int gw = blockIdx.x * 8 + wave, NGW = gridDim.x * 8;
    bf16_t* XN = (bf16_t*)(a.ws + WS_XN); float* ssq = (float*)(a.ws + WS_SSQ);
    for (int m0 = gw; m0 < M; m0 += 4 * NGW) {
        f32x4 v[4][4];
#pragma unroll
        for (int r = 0; r < 4; ++r) { const int m = m0 + r * NGW; if (m < M) { const f32x4* xr = (const f32x4*)(a.x + (size_t)m * D) + lane;
#pragma unroll
            for (int j = 0; j < 4; ++j) v[r][j] = xr[64 * j]; } }
#pragma unroll
        for (int r = 0; r < 4; ++r) { const int m = m0 + r * NGW; if (m < M) {
            u32x2* xnr = (u32x2*)(XN + (size_t)m * D) + lane;
            float s = 0.f;
#pragma unroll
            for (int j = 0; j < 4; ++j) { const f32x4 vv = v[r][j];
                u32x2 o; o.x = pk2(vv.x, vv.y); o.y = pk2(vv.z, vv.w); xnr[64 * j] = o;
                const f32x4 vr = {bf2f(o.x & 0xffffu), bf2f(o.x >> 16), bf2f(o.y & 0xffffu), bf2f(o.y >> 16)}; s += (vr.x * vr.x + vr.y * vr.y) + (vr.z * vr.z + vr.w * vr.w); }
            s = wave_sum(s);
            if (lane < 16) ssq[(size_t)m * 16 + lane] = lane == 0 ? s : 0.f; } }
    }
}
__device__ __forceinline__ void final_norm(const Args& a) {
    const int tid = opaque_tid(), lane = tid & 63, wave = tid >> 6;
    const int gw = blockIdx.x * 8 + wave, NGW = gridDim.x * 8;
    const float* ssq = (const float*)(a.ws + WS_SSQ);
    for (int m0 = gw; m0 < M; m0 += 4 * NGW) {
        float rs[4]; u32x2 xv[4][4];
#pragma unroll
        for (int r = 0; r < 4; ++r) { const int m = m0 + r * NGW; if (m < M) { rs[r] = rowscale(ssq, m);
            const u32x2* xr = (const u32x2*)((const bf16_t*)(a.ws + WS_XN) + (size_t)m * D) + lane;
#pragma unroll
            for (int j = 0; j < 4; ++j) xv[r][j] = xr[64 * j]; } }
#pragma unroll
        for (int r = 0; r < 4; ++r) { const int m = m0 + r * NGW; if (m < M) {
            f32x4* orow = (f32x4*)(a.out + (size_t)m * D) + lane; const f32x4* gr = (const f32x4*)a.final_norm + lane; const float rr = rs[r];
#pragma unroll
            for (int j = 0; j < 4; ++j) { const u32x2 x = xv[r][j]; const f32x4 g = gr[64 * j];
                orow[64 * j] = (f32x4){bf2f(x.x & 0xffffu) * rr * g.x, bf2f(x.x >> 16) * rr * g.y, bf2f(x.y & 0xffffu) * rr * g.z, bf2f(x.y >> 16) * rr * g.w}; } } }
    }
}

#define XB_TMO      128
#define XB_XCNT(j)  (256  + 64 * (j))
#define XB_XSUB(j)  (1280 + 64 * (j))
#define XB_XGEN(j)  (2304 + 64 * (j))
#define XB_TOP      3328
#define XB_TOPGEN   3392
#define XCD_BAR_WORDS 3456
#define XB_SPIN_CAP (1u << 20)

__device__ __forceinline__ unsigned xb_ld(unsigned* p)              { return __hip_atomic_load(p, __ATOMIC_RELAXED, __HIP_MEMORY_SCOPE_AGENT); }
__device__ __forceinline__ unsigned xb_add(unsigned* p, unsigned v) { return __hip_atomic_fetch_add(p, v, __ATOMIC_RELAXED, __HIP_MEMORY_SCOPE_AGENT); }
__device__ __forceinline__ unsigned xb_xcc_id() { return (unsigned)__builtin_amdgcn_s_getreg((3 << 11) | 20) & 0xFu; }
#define XB_SPIN(cond, bar) do { unsigned _sp = 0; while (cond) {   \
    if ((++_sp & 255u) == 0u) { if (xb_ld(&(bar)[XB_TMO])) break; if (_sp > XB_SPIN_CAP) { atomicAdd(&(bar)[XB_TMO], 1u); break; } } } } while (0)

struct XcdBarrier {
    unsigned* bar; unsigned x;
    volatile LAS unsigned* st;
};

__device__ __forceinline__ XcdBarrier xcd_barrier_post(unsigned* bar, volatile LAS unsigned* st) {
    XcdBarrier b; b.bar = bar; b.x = xb_xcc_id(); b.st = st;
    if (threadIdx.x == 0) (void)xb_add(&bar[XB_XCNT(b.x)], 1u);
    return b;
}
__device__ __forceinline__ void xcd_barrier_complete(unsigned* bar, unsigned x, unsigned& nloc, unsigned& nx) {
    const unsigned G = gridDim.x * gridDim.y * gridDim.z;
    unsigned sum, cnt, mine, sp = 0u;
    for (;;) {
        sum = 0u; cnt = 0u; mine = 0u;
#pragma unroll
        for (unsigned j = 0; j < 16; ++j) { const unsigned c = xb_ld(&bar[XB_XCNT(j)]); sum += c; cnt += (c > 0u) ? 1u : 0u; mine = (j == x) ? c : mine; }
        if (sum == G) break;
        __builtin_amdgcn_s_sleep(1);
        if ((++sp & 255u) == 0u) { if (xb_ld(&bar[XB_TMO])) break; if (sp > XB_SPIN_CAP) { atomicAdd(&bar[XB_TMO], 1u); break; } }
    }
    nloc = mine > 0u ? mine : 1u; nx = cnt > 0u ? cnt : 1u;
}

__device__ __forceinline__ void xcd_barrier(const XcdBarrier& b) {
    asm volatile("s_waitcnt vmcnt(0)" ::: "memory");
    __syncthreads();
    if (threadIdx.x == 0) {
        unsigned* bar = b.bar;
        __builtin_amdgcn_s_waitcnt(0);
        unsigned nloc = b.st[0], nx = b.st[1];
        if (nloc == 0u) { xcd_barrier_complete(bar, b.x, nloc, nx); b.st[0] = nloc; b.st[1] = nx; }
        const unsigned old = xb_add(&bar[XB_XSUB(b.x)], 1u);
        const unsigned gen = old / nloc;
        if (old + 1u == (gen + 1u) * nloc) {
            __builtin_amdgcn_fence(__ATOMIC_RELEASE, "agent");
            asm volatile("s_waitcnt vmcnt(0)" ::: "memory");
            const unsigned og = xb_add(&bar[XB_TOP], 1u);
            const unsigned tg = og / nx;
            if (og + 1u == (tg + 1u) * nx) xb_add(&bar[XB_TOPGEN], 1u);
            else XB_SPIN(xb_ld(&bar[XB_TOPGEN]) == tg, bar);
            __builtin_amdgcn_fence(__ATOMIC_ACQUIRE, "agent");
            xb_add(&bar[XB_XGEN(b.x)], 1u);
            asm volatile("s_waitcnt vmcnt(0)" ::: "memory");
        } else {
            XB_SPIN(xb_ld(&bar[XB_XGEN(b.x)]) == gen, bar);
            __builtin_amdgcn_fence(__ATOMIC_ACQUIRE, "agent");
            asm volatile("s_waitcnt vmcnt(0)" ::: "memory");
        }
    }
    __syncthreads();
}

__global__ void __launch_bounds__(512, 2) trunk_fwd(Args a) {
    extern __shared__ __attribute__((aligned(16))) unsigned char lds_raw[];
    LAS unsigned char* lds = (LAS unsigned char*)lds_raw;
    cg::grid_group grid = cg::this_grid();
    if (threadIdx.x < 64) ((LAS unsigned*)(lds + (LDS_BYTES - 256)))[threadIdx.x] = 0u;
    __syncthreads();
    XcdBarrier bar = xcd_barrier_post((unsigned*)a.ws + 4096, (volatile LAS unsigned*)(lds + (LDS_BYTES - 256)));
    unsigned char* ws = a.ws;
    const int G = gridDim.x, bx = blockIdx.x;
    bf16_t* XN; float* ssq;

#ifndef PH
#define PH 0xFFFF
#endif
#ifndef PROBE_MASK
#define PROBE_MASK 0
#endif
    unsigned long long pr_acc = 0, pr_t0 = 0;
#define PR_BEGIN(bit) do { if ((PROBE_MASK) & (bit)) pr_t0 = __builtin_amdgcn_s_memrealtime(); } while (0)
#define PR_END(bit) do { if ((PROBE_MASK) & (bit)) pr_acc += __builtin_amdgcn_s_memrealtime() - pr_t0; } while (0)
    PR_BEGIN(1);
    if (PH & 1) prologue(a, lds);
    if (a.ws == nullptr) grid.sync();
    xcd_barrier(bar);
    PR_END(1);
#define LAUNDER(p) asm volatile("" : "+s"(p))
#pragma unroll 1
    for (int l = 0; l < DEPTH; ++l) {
        PR_BEGIN(2);
#ifndef REP_P1
#define REP_P1 1
#endif
#ifndef REP_P5
#define REP_P5 1
#endif
#pragma unroll 1
        for (int rep = 0; rep < REP_P1; ++rep)
        if (PH & 2) { LAUNDER(ws); XN = (bf16_t*)(ws + WS_XN); ssq = (float*)(ws + WS_SSQ);
            pg8::Gemm g{XN, (const bf16_t*)(ws + WS_WIN), M, INC, D}; pg8::StaticOrder S; S.init(M, INC, G, bx);
            EpiIn E{(bf16_t*)(ws + WS_U), (bf16_t*)(ws + WS_V), (bf16_t*)(ws + WS_Q), (bf16_t*)(ws + WS_KK), (bf16_t*)(ws + WS_I), (bf16_t*)(ws + WS_OG), (bf16_t*)(ws + WS_GT),
                    (float*)(ws + WS_GL), ssq, (const float*)(ws + WS_LB) + l * 512, (float*)(ws + WS_VS), (const LAS float*)(lds + RTAB_OFF), 0};
            fill_rtab(S, ssq, lds);
            pg8::gemm_phase<EpiIn, pg8::StaticOrder, ALIGN_HEAVY, true>(lds, g, S, E);
        }
        xcd_barrier(bar);
        PR_END(2);
        PR_BEGIN(4);
        if (PH & 4) { int wl_h = -1; for (int u = bx; u < 8 * HG_NG + 512; u += G) { if (u < 8 * HG_NG) { PR_BEGIN(2048); hg1g_unit(a, lds, u); PR_END(2048); wl_h = -1; } else { PR_BEGIN(4096); { const int gh = (u - 8 * HG_NG) & 3; gmlp_unit(a, lds, u - 8 * HG_NG, l, gh != wl_h); wl_h = gh; } PR_END(4096); } } }
        xcd_barrier(bar);
        PR_END(4);
        PR_BEGIN(8);
        if (PH & 8) { hg_gscan(a); }
        xcd_barrier(bar);
        PR_END(8);
        PR_BEGIN(16);
        if (PH & 16) for (int u = bx; u < 8 * HG_NG; u += G) hg3g_unit(a, lds, u, l, pr_acc);
        xcd_barrier(bar);
        PR_END(16);
        PR_BEGIN(32);
        if (PH & 32) { LAUNDER(ws);
            pg8::StaticOrder S; S.init(M, D, G, bx);
            pg8::Gemm g1{(const bf16_t*)(ws + WS_U), (const bf16_t*)(ws + WS_WGM), M, D, 512};
            EpiBr<false> E1{(bf16_t*)(ws + WS_Y), (const bf16_t*)(ws + WS_GT), 0};
            pg8::gemm_phase<EpiBr<false>, pg8::StaticOrder, ALIGN_SINGLE, true>(lds, g1, S, E1);
            pg8::Gemm g2{(const bf16_t*)(ws + WS_OG), (const bf16_t*)(ws + WS_WHG), M, D, 512};
            EpiBr<true> E2{(bf16_t*)(ws + WS_Y), (const bf16_t*)(ws + WS_GT), 1024};
            pg8::gemm_phase<EpiBr<true>, pg8::StaticOrder, ALIGN_SINGLE, true>(lds, g2, S, E2);
        }
        xcd_barrier(bar);
        PR_END(32);
        PR_BEGIN(64);
        if (PH & 64) { LAUNDER(ws); XN = (bf16_t*)(ws + WS_XN); ssq = (float*)(ws + WS_SSQ);
            pg8::Gemm g{(const bf16_t*)(ws + WS_Y), (const bf16_t*)(ws + WS_WOUT), M, D, D}; pg8::StaticOrder S; S.init(M, D, G, bx);
            EpiRes E{XN, (bf16_t*)(ws + WS_XN2), ssq};
            pg8::gemm_phase<EpiRes, pg8::StaticOrder, ALIGN_SINGLE, true>(lds, g, S, E);
        }
        xcd_barrier(bar);
        PR_END(64);
        PR_BEGIN(128);
#pragma unroll 1
        for (int rep = 0; rep < REP_P5; ++rep)
        if (PH & 128) { LAUNDER(ws); XN = (bf16_t*)(ws + WS_XN); ssq = (float*)(ws + WS_SSQ);
            pg8::Gemm g{(const bf16_t*)(ws + WS_XN2), (const bf16_t*)(ws + WS_WUP + (l & 1) * WS_FFNW_STRIDE), M, NUP, D}; pg8::StaticOrder S; S.init(M, NUP, G, bx);
            EpiUp E{(bf16_t*)(ws + WS_AC), (bf16_t*)(ws + WS_Z), ssq, a.conv_w + (size_t)l * 3 * NUP, a.conv_b + (size_t)l * NUP, (LAS float*)(lds + 132096), (const LAS float*)(lds + RTAB_OFF), 0};
            if (l + 1 < DEPTH) { convert_set(a, lds, 0, l + 1, G / 2, G - G / 2); convert_set(a, lds, 1, l + 1, G / 2, G - G / 2); __syncthreads(); }
            fill_rtab(S, ssq, lds);
            pg8::gemm_phase<EpiUp, pg8::StaticOrder, ALIGN_HEAVY, true>(lds, g, S, E);
        }
        xcd_barrier(bar);
        PR_END(128);
        PR_BEGIN(256);
        if (PH & 256) { conv_fixup(a, l); }
        xcd_barrier(bar);
        PR_END(256);
        PR_BEGIN(512);
        if (PH & 512) { LAUNDER(ws); XN = (bf16_t*)(ws + WS_XN); ssq = (float*)(ws + WS_SSQ);
            pg8::Gemm g{(const bf16_t*)(ws + WS_AC), (const bf16_t*)(ws + WS_WDN + (l & 1) * WS_FFNW_STRIDE), M, D, DFF}; pg8::StaticOrder S; S.init(M, D, G, bx);
            EpiRes E{(const bf16_t*)(ws + WS_XN2), XN, ssq};
            pg8::gemm_phase<EpiRes, pg8::StaticOrder, ALIGN_SINGLE, true>(lds, g, S, E);
        }
        xcd_barrier(bar);
        PR_END(512);
    }
    if (PH & 1024) final_norm(a);
    if ((PROBE_MASK) && blockIdx.x == 0) { const unsigned long long te = __builtin_amdgcn_s_memrealtime() + 4 * pr_acc; while (__builtin_amdgcn_s_memrealtime() < te) __builtin_amdgcn_s_sleep(8); }
}

extern "C" void kernel_launch(void* const* d_in, const int* in_sizes, int n_in, void* d_out, int out_size, void* d_ws, size_t ws_size, hipStream_t stream) {
    static int grid = 0;
    if (grid == 0) {
        if (n_in != 18 || out_size != M * D || ws_size < WS_NEED) { fprintf(stderr, "kernel_launch: unexpected shapes (n_in %d, out %d, ws %zu < %zu)\n", n_in, out_size, ws_size, (size_t)WS_NEED); grid = -1; return; }
        int dev = 0, cus = 0, per_cu = 0;
        hipGetDevice(&dev); hipDeviceGetAttribute(&cus, hipDeviceAttributeMultiprocessorCount, dev);
        if (hipFuncSetAttribute((const void*)trunk_fwd, hipFuncAttributeMaxDynamicSharedMemorySize, LDS_BYTES) != hipSuccess) { fprintf(stderr, "kernel_launch: hipFuncSetAttribute failed\n"); grid = -1; return; }
        if (hipOccupancyMaxActiveBlocksPerMultiprocessor(&per_cu, (const void*)trunk_fwd, 512, LDS_BYTES) != hipSuccess || per_cu < 1) { fprintf(stderr, "kernel_launch: occupancy query says %d\n", per_cu); per_cu = 1; }
        (void)hipGetLastError();
        grid = cus * 1;
    }
    if (grid < 0) return;
    if (hipMemsetAsync(d_ws, 0, 65536, stream) != hipSuccess) { fprintf(stderr, "kernel_launch: memset failed\n"); return; }
    Args a{};
    const float** ap = (const float**)&a;
    for (int i = 0; i < 18; ++i) ap[i] = (const float*)d_in[i];
    a.out = (float*)d_out; a.ws = (unsigned char*)d_ws;
    void* args[] = {&a};
    hipError_t e = hipLaunchCooperativeKernel((const void*)trunk_fwd, dim3(grid), dim3(512), args, LDS_BYTES, stream);
    if (e != hipSuccess) fprintf(stderr, "cooperative launch failed: %s (grid %d)\n", hipGetErrorString(e), grid);
}
```

```cpp
#include <hip/hip_runtime.h>
#include <hip/hip_cooperative_groups.h>
#include <cstdio>
#include <cstdint>
namespace cg = cooperative_groups;
namespace pg8 {
#define PG8_LAS __attribute__((address_space(3)))
typedef unsigned short bf16_t;
typedef short bf16x8 __attribute__((ext_vector_type(8)));
typedef float f32x4 __attribute__((ext_vector_type(4)));
typedef unsigned u32x4 __attribute__((ext_vector_type(4)));
constexpr int BM = 256, BK = 64, HALF = 128, HTB = HALF * BK * 2  , STAGE_BYTES = 8 * HTB, NXCD = 8, WGM = 8;

__host__ __device__ __forceinline__ int lds_byte(int r, int c) { const int st = (r >> 4) * 2 + (c >> 5), rr = r & 15, cc = c & 31, ob = rr * 64 + cc * 2; return st * 1024 + (ob ^ (((ob >> 9) & 1) << 5)); }
__host__ __device__ __forceinline__ void stage_rc(int b, int& R, int& C) { const int st = b / 1024, sb = b % 1024, swz = sb ^ (((sb >> 9) & 1) << 5); R = (st >> 1) * 16 + swz / 64; C = (st & 1) * 32 + (swz % 64) / 2; }
__host__ __device__ __forceinline__ int perm32(int rho) { const int n = rho >> 4, i = rho & 15; return 8 * (i >> 2) + 4 * n + (i & 3); }

struct Unit { int pm, pn; };
struct Gemm { const bf16_t* A; const bf16_t* Bt; int M, N, K; };

struct StaticOrder {
    int nM, nN, nwg, G, c;
    __host__ __device__ void init(int M, int N, int G_, int c_) { nM = M / BM; nN = N / BM; nwg = nM * nN; G = G_; c = c_; }
    __host__ __device__ bool next(int i, Unit& u) const {
        const long L = (long)i * G + c; if (L >= nwg) return false;
        int wgid = (int)L; { const int q = nwg / NXCD, r = nwg % NXCD, xcd = wgid % NXCD, off = wgid / NXCD; wgid = (xcd < r ? xcd * (q + 1) : r * (q + 1) + (xcd - r) * q) + off; }
        const int nig = WGM * nN, gid = wgid / nig, fm = gid * WGM, gsz = (nM - fm) < WGM ? (nM - fm) : WGM;
        u.pm = fm + ((wgid % nig) % gsz); u.pn = (wgid % nig) / gsz; return true;
    }
    __device__ __forceinline__ void a_ready(const Unit&) const {}
    __device__ __forceinline__ void done(const Unit&) const {}
};

__device__ __forceinline__ unsigned cvt_pk_bf16(float lo, float hi) { unsigned r; asm volatile("v_cvt_pk_bf16_f32 %0, %1, %2" : "=v"(r) : "v"(lo), "v"(hi)); return r; }
typedef float f32x2 __attribute__((ext_vector_type(2)));
__device__ __forceinline__ f32x2 gelu_pk(f32x2 v) {
    const f32x2 av = __builtin_elementwise_abs(v), d = av * 0.2316418882f + 1.0f;
    f32x2 t; t.x = __builtin_amdgcn_rcpf(d.x); t.y = __builtin_amdgcn_rcpf(d.y);
    f32x2 q = t * 0.5307027145f + (-0.7265760135f); q = q * t + 0.7107068705f; q = q * t + (-0.142248368f); q = q * t + 0.127414796f; q = q * t;
    const f32x2 s = (v * v) * (-0.72134752044f);
    f32x2 e; e.x = __builtin_amdgcn_exp2f(s.x); e.y = __builtin_amdgcn_exp2f(s.y);
    const f32x2 m = v * (q * e), r = v - m;
    f32x2 o; o.x = v.x < 0.f ? m.x : r.x; o.y = v.y < 0.f ? m.y : r.y; return o;
}

template <int ACT  > struct EpiBf16 {
    static constexpr bool PERM = true, AFTER_DRAIN = false; static_assert(ACT == 0 || ACT == 1, "EpiBf16: ACT is 0 (none) or 1 (gelu_pk)");
    bf16_t* O; int ldc; const float* bias; int split_cols; size_t split_stride; float scale0;
    __device__ __forceinline__ void operator()(const f32x4 (&acc)[2][2][4][2], const Unit& u, int wr, int wc, int fr, int fq) const {
        const int row0 = u.pm * BM + wr * 64 + fr; int colt = u.pn * BM; bf16_t* base = O;
        float sc = 1.f; if (split_cols) { const int t = colt / split_cols; base += (size_t)t * split_stride; colt -= t * split_cols; if (t == 0) sc = scale0; }
        const int col0 = colt + wc * 32 + 8 * fq, bcol0 = u.pn * BM + wc * 32 + 8 * fq;
        f32x4 bv[2][2];
#pragma unroll
        for (int bj = 0; bj < 2; ++bj)
#pragma unroll
            for (int n = 0; n < 2; ++n) bv[bj][n] = bias ? *(const f32x4*)(bias + bcol0 + bj * HALF + 4 * n) : (f32x4){0.f, 0.f, 0.f, 0.f};
#pragma unroll
        for (int ai = 0; ai < 2; ++ai)
#pragma unroll
            for (int m = 0; m < 4; ++m) { bf16_t* rowp = base + (size_t)(row0 + ai * HALF + m * 16) * ldc + col0;
#pragma unroll
                for (int bj = 0; bj < 2; ++bj) { f32x4 v0 = acc[ai][bj][m][0] + bv[bj][0], v1 = acc[ai][bj][m][1] + bv[bj][1];
                    if (ACT == 1) { f32x2 a = gelu_pk((f32x2){v0[0], v0[1]}), b = gelu_pk((f32x2){v0[2], v0[3]}), c = gelu_pk((f32x2){v1[0], v1[1]}), d = gelu_pk((f32x2){v1[2], v1[3]});
                        v0 = (f32x4){a.x, a.y, b.x, b.y}; v1 = (f32x4){c.x, c.y, d.x, d.y}; }
                    v0 = v0 * sc; v1 = v1 * sc; u32x4 w; w.x = cvt_pk_bf16(v0[0], v0[1]); w.y = cvt_pk_bf16(v0[2], v0[3]); w.z = cvt_pk_bf16(v1[0], v1[1]); w.w = cvt_pk_bf16(v1[2], v1[3]);
                    *(u32x4*)(rowp + bj * HALF) = w; } }
    }
};
template <class Epi, class Sched, bool ALIGN_EPI = false, bool SP2 = false>
__device__ __forceinline__ void gemm_phase(PG8_LAS unsigned char* lds, const Gemm g, const Sched& S, const Epi& E) {
    int tid_ = threadIdx.x; asm volatile("" : "+v"(tid_)); const int tid = tid_, wid = __builtin_amdgcn_readfirstlane(tid >> 6), lane = tid & 63, wr = wid >> 2, wc = wid & 3, fr = lane & 15, fq = lane >> 4;
    const int K = g.K, nt = K / BK;
    unsigned voffA[2], voffB[2];
#pragma unroll
    for (int i = 0; i < 2; ++i) { int R, C; stage_rc(tid * 16 + i * 8192, R, C); const int Rb = Epi::PERM ? ((R & ~31) + perm32(R & 31)) : R;
        voffA[i] = (unsigned)(R * K + C) * 2u; voffB[i] = (unsigned)(Rb * K + C) * 2u; }
    const size_t kstep = (size_t)(BK * 2);
    const size_t hstep = (size_t)HALF * K * 2;
    const size_t tstep = 2 * hstep;
    const unsigned ldsw = (unsigned)wid * 1024u;
    const int aoff = lds_byte(wr * 64 + fr, fq * 8), boff = lds_byte(wc * 32 + fr, fq * 8);
#define PG8_SA(b, h) (((b) * 2 + (h)) * HTB)
#define PG8_SB(b, h) ((4 + (b) * 2 + (h)) * HTB)
#define PG8_STAGE(bufoff, gbase, voff) do { _Pragma("unroll") for (int _i = 0; _i < 2; ++_i) \
        __builtin_amdgcn_global_load_lds((const unsigned*)((const char*)(gbase) + (voff)[_i]), (PG8_LAS unsigned*)(lds + (bufoff) + ldsw + _i * 8192), 16, 0, 0); } while (0)
#define PG8_LDA(dst, b, h) do { _Pragma("unroll") for (int m = 0; m < 4; ++m) _Pragma("unroll") for (int k = 0; k < 2; ++k) dst[m][k] = *(const PG8_LAS bf16x8*)(lds + PG8_SA(b, h) + aoff + m * 2048 + k * 1024); } while (0)
#define PG8_LDB(dst, b, h) do { _Pragma("unroll") for (int n = 0; n < 2; ++n) _Pragma("unroll") for (int k = 0; k < 2; ++k) dst[n][k] = *(const PG8_LAS bf16x8*)(lds + PG8_SB(b, h) + boff + n * 2048 + k * 1024); } while (0)
#define PG8_MMA(ai, bj, At, Bt) do { __builtin_amdgcn_s_setprio(1); _Pragma("unroll") for (int m = 0; m < 4; ++m) _Pragma("unroll") for (int n = 0; n < 2; ++n) _Pragma("unroll") for (int k = 0; k < 2; ++k) \
        acc[ai][bj][m][n] = __builtin_amdgcn_mfma_f32_16x16x32_bf16(Bt[n][k], At[m][k], acc[ai][bj][m][n], 0, 0, 0); __builtin_amdgcn_s_setprio(0); } while (0)
#define PG8_WAIT_V(n) asm volatile("s_waitcnt vmcnt(" #n ")" ::: "memory")
#define PG8_WAIT_L(n) asm volatile("s_waitcnt lgkmcnt(" #n ")" ::: "memory")
#define PG8_BAR __builtin_amdgcn_s_barrier()
#define PG8_SCHED __builtin_amdgcn_sched_barrier(0)
    Unit cur, nxt; int ui = 0;
    if (!S.next(0, cur)) return;
    f32x4 acc[2][2][4][2];
#pragma unroll
    for (int a = 0; a < 2; ++a)
#pragma unroll
        for (int b = 0; b < 2; ++b)
#pragma unroll
            for (int m = 0; m < 4; ++m)
#pragma unroll
                for (int n = 0; n < 2; ++n) acc[a][b][m][n] = (f32x4){0.f, 0.f, 0.f, 0.f};
    bf16x8 At[4][2], B0[2][2], B1[2][2];
    const char* cA = (const char*)g.A + (size_t)cur.pm * tstep; const char* cB = (const char*)g.Bt + (size_t)cur.pn * tstep;
    S.a_ready(cur);
    if constexpr (SP2) {
        PG8_STAGE(PG8_SB(0, 0), cB, voffB); PG8_STAGE(PG8_SB(0, 1), cB + hstep, voffB); PG8_STAGE(PG8_SA(0, 0), cA, voffA); PG8_STAGE(PG8_SA(0, 1), cA + hstep, voffA);
        if (wr == 1) PG8_BAR;
        PG8_WAIT_V(2); PG8_BAR;
        PG8_STAGE(PG8_SB(1, 0), cB + kstep, voffB); PG8_STAGE(PG8_SA(1, 0), cA + kstep, voffA); PG8_STAGE(PG8_SB(1, 1), cB + hstep + kstep, voffB);
        PG8_WAIT_V(6); PG8_BAR;
    } else {
        PG8_STAGE(PG8_SB(0, 0), cB, voffB); PG8_STAGE(PG8_SA(0, 0), cA, voffA); PG8_STAGE(PG8_SB(0, 1), cB + hstep, voffB); PG8_STAGE(PG8_SA(0, 1), cA + hstep, voffA);
        if (wr == 1) PG8_BAR;
        PG8_WAIT_V(4); PG8_BAR;
        PG8_STAGE(PG8_SB(1, 0), cB + kstep, voffB); PG8_STAGE(PG8_SA(1, 0), cA + kstep, voffA); PG8_STAGE(PG8_SB(1, 1), cB + hstep + kstep, voffB);
        PG8_WAIT_V(6); PG8_BAR;
    }
    for (;;) {
        const bool has_next = S.next(ui + 1, nxt);
        const char* nA = has_next ? (const char*)g.A + (size_t)nxt.pm * tstep : cA; const char* nB = has_next ? (const char*)g.Bt + (size_t)nxt.pn * tstep : cB;
        for (int t = 0; t < nt; t += 2) {
            const bool last = (t == nt - 2);
            const char* a1 = cA + (size_t)(t + 1) * kstep;
            const char* a2 = last ? nA : cA + (size_t)(t + 2) * kstep; const char* b2 = last ? nB : cB + (size_t)(t + 2) * kstep;
            const char* a3 = a2 + kstep; const char* b3 = b2 + kstep;
            if (last && has_next) S.a_ready(nxt);
            if constexpr (SP2) {
            PG8_LDB(B0, 0, 0); PG8_LDB(B1, 0, 1); PG8_SCHED; PG8_LDA(At, 0, 0); PG8_STAGE(PG8_SA(1, 1), a1 + hstep, voffA);
            PG8_WAIT_V(8); PG8_WAIT_L(0); PG8_BAR; PG8_MMA(0, 0, At, B0); PG8_MMA(0, 1, At, B1); PG8_BAR; PG8_SCHED;
            PG8_LDA(At, 0, 1); PG8_STAGE(PG8_SB(0, 0), b2, voffB); PG8_STAGE(PG8_SB(0, 1), b2 + hstep, voffB); PG8_STAGE(PG8_SA(0, 0), a2, voffA);
            PG8_WAIT_V(8); PG8_WAIT_L(0); PG8_BAR; PG8_MMA(1, 0, At, B0); PG8_MMA(1, 1, At, B1); PG8_BAR; PG8_SCHED;
            PG8_LDB(B0, 1, 0); PG8_LDB(B1, 1, 1); PG8_SCHED; PG8_LDA(At, 1, 0); PG8_STAGE(PG8_SA(0, 1), a2 + hstep, voffA);
            PG8_WAIT_V(8); PG8_WAIT_L(0); PG8_BAR; PG8_MMA(0, 0, At, B0); PG8_MMA(0, 1, At, B1); PG8_BAR; PG8_SCHED;
            PG8_LDA(At, 1, 1); PG8_STAGE(PG8_SB(1, 0), b3, voffB); PG8_STAGE(PG8_SB(1, 1), b3 + hstep, voffB); PG8_STAGE(PG8_SA(1, 0), a3, voffA);
            PG8_WAIT_V(8); PG8_WAIT_L(0); PG8_BAR; PG8_MMA(1, 0, At, B0); PG8_MMA(1, 1, At, B1); PG8_BAR; PG8_SCHED;
            } else {
            PG8_LDB(B0, 0, 0); PG8_SCHED; PG8_LDA(At, 0, 0); PG8_STAGE(PG8_SA(1, 1), a1 + hstep, voffA);
            PG8_WAIT_L(8); PG8_BAR; PG8_WAIT_L(0); PG8_MMA(0, 0, At, B0); PG8_BAR; PG8_SCHED;
            PG8_LDB(B1, 0, 1); PG8_STAGE(PG8_SB(0, 0), b2, voffB);
            PG8_BAR; PG8_WAIT_L(0); PG8_MMA(0, 1, At, B1); PG8_BAR;
            PG8_LDA(At, 0, 1); PG8_STAGE(PG8_SA(0, 0), a2, voffA);
            PG8_BAR; PG8_WAIT_L(0); PG8_MMA(1, 0, At, B0); PG8_BAR; PG8_SCHED;
            PG8_STAGE(PG8_SB(0, 1), b2 + hstep, voffB);
            PG8_WAIT_V(6); PG8_BAR; PG8_MMA(1, 1, At, B1); PG8_BAR;
            PG8_LDB(B0, 1, 0); PG8_SCHED; PG8_LDA(At, 1, 0); PG8_STAGE(PG8_SA(0, 1), a2 + hstep, voffA);
            PG8_WAIT_L(8); PG8_BAR; PG8_WAIT_L(0); PG8_MMA(0, 0, At, B0); PG8_BAR; PG8_SCHED;
            PG8_LDB(B1, 1, 1); PG8_STAGE(PG8_SB(1, 0), b3, voffB);
            PG8_BAR; PG8_WAIT_L(0); PG8_MMA(0, 1, At, B1); PG8_BAR;
            PG8_LDA(At, 1, 1); PG8_STAGE(PG8_SA(1, 0), a3, voffA);
            PG8_BAR; PG8_WAIT_L(0); PG8_MMA(1, 0, At, B0); PG8_BAR; PG8_SCHED;
            PG8_STAGE(PG8_SB(1, 1), b3 + hstep, voffB);
            PG8_WAIT_V(6); PG8_BAR; PG8_MMA(1, 1, At, B1); PG8_BAR;
            }
        }
        if constexpr (ALIGN_EPI) { if (wr == 0) PG8_BAR; }
        if constexpr (!Epi::AFTER_DRAIN) { E(acc, cur, wr, wc, fr, fq); S.done(cur); }
        if (!has_next) break;
#pragma unroll
        for (int a = 0; a < 2; ++a)
#pragma unroll
            for (int b = 0; b < 2; ++b)
#pragma unroll
                for (int m = 0; m < 4; ++m)
#pragma unroll
                    for (int n = 0; n < 2; ++n) acc[a][b][m][n] = (f32x4){0.f, 0.f, 0.f, 0.f};
        cur = nxt; cA = nA; cB = nB; ++ui;
        if constexpr (ALIGN_EPI) { if (wr == 1) PG8_BAR; }
    }
    PG8_WAIT_V(0);
    if constexpr (!ALIGN_EPI) { if (wr == 0) PG8_BAR; }
    PG8_BAR;
    if constexpr (Epi::AFTER_DRAIN) { E.fused(acc, cur, wr, wc, fr, fq, lds, wid, lane); S.done(cur); }
#undef PG8_SA
#undef PG8_SB
#undef PG8_STAGE
#undef PG8_LDA
#undef PG8_LDB
#undef PG8_MMA
#undef PG8_WAIT_V
#undef PG8_WAIT_L
#undef PG8_BAR
#undef PG8_SCHED
}
}
#define LAS __attribute__((address_space(3)))
__device__ __forceinline__ int opaque_tid() { int t = threadIdx.x; asm volatile("" : "+v"(t)); return t; }
using pg8::bf16_t; using pg8::bf16x8; using pg8::f32x4; using pg8::u32x4; using pg8::Unit;
typedef float f32x2 __attribute__((ext_vector_type(2)));
typedef unsigned u32x2 __attribute__((ext_vector_type(2)));

constexpr int NB = 2, SEQ = 8192, M = NB * SEQ, D = 1024, DEPTH = 4, INC = 5120, DFF = 2816, NUP = 2 * DFF;
constexpr float EPS = 1e-6f, LOG2E = 1.4426950408889634f;
constexpr size_t MiB = 1u << 20;
constexpr size_t WS_LB = 1 * MiB, WS_SSQ = 2 * MiB, WS_DEC = 3 * MiB;
constexpr size_t WS_WIN = 4 * MiB, WS_WGM = 14 * MiB, WS_WHG = 15 * MiB, WS_WOUT = 16 * MiB, WS_WUP = 18 * MiB, WS_WDN = 29 * MiB;
constexpr size_t WS_XN = 36 * MiB, WS_ACT0 = 68 * MiB, WS_VS = 35 * MiB;
constexpr size_t WS_U = WS_ACT0, WS_V = WS_U + 16 * MiB, WS_Q = WS_V + 16 * MiB, WS_KK = WS_Q + 16 * MiB, WS_GL = WS_KK + 16 * MiB, WS_I = WS_GL + 32 * MiB,
                 WS_OG = WS_I + 16 * MiB, WS_GT = WS_OG + 16 * MiB, WS_ST = WS_GT + 64 * MiB, WS_END1 = WS_ST + 64 * MiB;
constexpr size_t WS_XN2 = WS_I;
constexpr size_t WS_Y = WS_Q;
constexpr size_t WS_Z = WS_ACT0, WS_AC = WS_Z + 176 * MiB, WS_END2 = WS_AC + 88 * MiB;
constexpr size_t WS_FFNW2 = WS_END2, WS_FFNW_STRIDE = WS_FFNW2 - WS_WUP;
constexpr size_t WS_NEED = WS_FFNW2 + 17 * MiB;
constexpr int LDS_BYTES = 147456;

#ifndef PROBE_MASK
#define PROBE_MASK 0
#endif
#ifndef ALIGN_SINGLE
#define ALIGN_SINGLE true
#endif
#ifndef ALIGN_HEAVY
#define ALIGN_HEAVY true
#endif
struct Args {
    const float *x, *mix_norm, *w_in, *gm_ln_g, *gm_ln_b, *gm_ws, *gm_bs, *hg_lb, *hg_norm_g, *w_br_gm, *w_br_hg, *w_out, *ffn_norm, *w_up, *conv_w, *conv_b, *w_down, *final_norm;
    float* out; unsigned char* ws;
};

__device__ __forceinline__ float bf2f(unsigned h) { return __uint_as_float(h << 16); }
__device__ __forceinline__ unsigned f2bf(float f) { unsigned u = __float_as_uint(f); return (u + 0x7fffu + ((u >> 16) & 1u)) >> 16; }
__device__ __forceinline__ unsigned pk2(float lo, float hi) { return pg8::cvt_pk_bf16(lo, hi); }
__device__ __forceinline__ float fexp2(float x) { return __builtin_amdgcn_exp2f(x); }
__device__ __forceinline__ float frcp(float x) { return __builtin_amdgcn_rcpf(x); }
__device__ __forceinline__ float sigm(float x) { return frcp(1.f + fexp2(-LOG2E * x)); }
__device__ __forceinline__ float silu(float x) { return x * sigm(x); }
__device__ __forceinline__ float wave_sum(float v) {
#pragma unroll
    for (int o = 1; o < 64; o <<= 1) v += __shfl_xor(v, o);
    return v;
}
__device__ __forceinline__ void unpack8(const u32x4 r, float (&x)[8]) {
    x[0] = bf2f(r.x & 0xffffu); x[1] = bf2f(r.x >> 16); x[2] = bf2f(r.y & 0xffffu); x[3] = bf2f(r.y >> 16);
    x[4] = bf2f(r.z & 0xffffu); x[5] = bf2f(r.z >> 16); x[6] = bf2f(r.w & 0xffffu); x[7] = bf2f(r.w >> 16);
}
__device__ __forceinline__ float rowscale(const float* ssq, int row) {
    const f32x4* p = (const f32x4*)(ssq + (size_t)row * 16); const f32x4 s = (p[0] + p[1]) + (p[2] + p[3]);
    return rsqrtf(((s.x + s.y) + (s.z + s.w)) * (1.f / 1024.f) + EPS);
}

constexpr int RTAB_OFF = 140288, RT_UNITS = 6;
template <class Sched> __device__ __forceinline__ void fill_rtab(const Sched& S, const float* ssq, LAS unsigned char* lds) {
    const int tid = opaque_tid(); LAS float* tab = (LAS float*)(lds + RTAB_OFF);
    float r[RT_UNITS]; bool ok[RT_UNITS];
#pragma unroll
    for (int i = 0; i < RT_UNITS; ++i) { Unit u; ok[i] = S.next(i, u); r[i] = (ok[i] && tid < 256) ? rowscale(ssq, u.pm * 256 + tid) : 0.f; }
#pragma unroll
    for (int i = 0; i < RT_UNITS; ++i) if (ok[i] && tid < 256) tab[i * 256 + tid] = r[i];
    __syncthreads();
}
struct EpiIn {
    static constexpr bool PERM = true, AFTER_DRAIN = false;
    bf16_t *U, *V, *Q, *KK, *I, *OG, *GT; float* GL; const float* ssq; const float* lb; float* VS; const LAS float* rtab; mutable int k;
    template <int SEG> __device__ __forceinline__ void body(const f32x4 (&acc)[2][2][4][2], const Unit& u, int wr, int wc, int fr, int fq) const {
        const int row0 = u.pm * 256 + wr * 64 + fr, pn = u.pn;
        bf16_t* base; int ldc, colt;
        if (SEG == 6) { base = GT; ldc = 2048; colt = (pn - 12) * 256; }
        else { ldc = 512; colt = (pn & 1) * 256; base = SEG == 0 ? U : SEG == 1 ? V : SEG == 2 ? Q : SEG == 3 ? KK : SEG == 4 ? I : OG; }
        const int col0 = colt + wc * 32 + 8 * fq;
        f32x4 lbq[2][2];
        if (SEG == 3) {
#pragma unroll
            for (int bj = 0; bj < 2; ++bj) { lbq[bj][0] = *(const f32x4*)(lb + col0 + bj * 128); lbq[bj][1] = *(const f32x4*)(lb + col0 + bj * 128 + 4); }
        }
#pragma unroll
        for (int ai = 0; ai < 2; ++ai)
#pragma unroll
            for (int m = 0; m < 4; ++m) {
                const int row = row0 + ai * 128 + m * 16; const float r = k < RT_UNITS ? rtab[k * 256 + ai * 128 + wr * 64 + m * 16 + fr] : rowscale(ssq, row);
                float st1 = 0.f, st2 = 0.f;
#pragma unroll
                for (int bj = 0; bj < 2; ++bj) {
                    const int c = col0 + bj * 128;
                    f32x4 v0 = acc[ai][bj][m][0] * r, v1 = acc[ai][bj][m][1] * r;
                    float o[8] = {v0[0], v0[1], v0[2], v0[3], v1[0], v1[1], v1[2], v1[3]};
                    if (SEG == 0 || SEG == 1) {
#pragma unroll
                        for (int e = 0; e < 8; e += 2) { f32x2 g = pg8::gelu_pk((f32x2){o[e], o[e + 1]}); o[e] = g.x; o[e + 1] = g.y; }
                        if (SEG == 1) {
#pragma unroll
                            for (int e = 0; e < 8; ++e) { st1 += o[e]; st2 += o[e] * o[e]; }
                        }
                    } else if (SEG == 2 || SEG == 5) {
#pragma unroll
                        for (int e = 0; e < 8; ++e) o[e] = silu(o[e]);
                    } else if (SEG == 6) {
#pragma unroll
                        for (int e = 0; e < 8; ++e) o[e] = sigm(o[e]);
                    } else if (SEG == 3) {
                        const f32x4 l0 = lbq[bj][0], l1 = lbq[bj][1];
                        const float lbv[8] = {l0[0], l0[1], l0[2], l0[3], l1[0], l1[1], l1[2], l1[3]};
                        float g2[8];
#pragma unroll
                        for (int e = 0; e < 8; ++e) {
                            const float f = fminf(fmaxf(o[e], -80.f), 80.f);
                            const float ex = fexp2(-LOG2E * f), sg = frcp(1.f + ex);
                            const float fg = lbv[e] + (1.f - lbv[e]) * sg;
                            g2[e] = __builtin_amdgcn_logf(fmaxf(fg, 1e-30f));
                            o[e] = (1.f - lbv[e]) * (ex * sg);
                        }
                        float* gp = GL + (size_t)row * 512 + c;
                        *(f32x4*)gp = (f32x4){g2[0], g2[1], g2[2], g2[3]}; *(f32x4*)(gp + 4) = (f32x4){g2[4], g2[5], g2[6], g2[7]};
                    }
                    u32x4 w; w.x = pk2(o[0], o[1]); w.y = pk2(o[2], o[3]); w.z = pk2(o[4], o[5]); w.w = pk2(o[6], o[7]);
                    *(u32x4*)(base + (size_t)row * ldc + c) = w;
                }
                if (SEG == 1) {
                    st1 += __shfl_xor(st1, 16); st1 += __shfl_xor(st1, 32); st2 += __shfl_xor(st2, 16); st2 += __shfl_xor(st2, 32);
                    if (fq == 0) *(f32x2*)(VS + (size_t)row * 16 + ((pn & 1) * 4 + wc) * 2) = (f32x2){st1, st2};
                }
                asm volatile("" ::: "memory");
            }
    }
    __device__ __forceinline__ void operator()(const f32x4 (&acc)[2][2][4][2], const Unit& u, int wr, int wc, int fr, int fq) const {
        const int seg = u.pn < 12 ? (u.pn >> 1) : 6;
        switch (seg) {
            case 0: body<0>(acc, u, wr, wc, fr, fq); break;
            case 1: body<1>(acc, u, wr, wc, fr, fq); break;
            case 2: body<2>(acc, u, wr, wc, fr, fq); break;
            case 3: body<3>(acc, u, wr, wc, fr, fq); break;
            case 4: body<4>(acc, u, wr, wc, fr, fq); break;
            case 5: body<5>(acc, u, wr, wc, fr, fq); break;
            default: body<6>(acc, u, wr, wc, fr, fq); break;
        }
        ++k;
    }
};
template <bool ADD> struct EpiBr {
    static constexpr bool PERM = true, AFTER_DRAIN = false;
    bf16_t* Y; const bf16_t* GT; int goff;
    __device__ __forceinline__ void operator()(const f32x4 (&acc)[2][2][4][2], const Unit& u, int wr, int wc, int fr, int fq) const {
        const int row0 = u.pm * 256 + wr * 64 + fr, col0 = u.pn * 256 + wc * 32 + 8 * fq;
        u32x4 gc[2], gn[2], yc[2], yn[2];
#pragma unroll
        for (int bj = 0; bj < 2; ++bj) { gc[bj] = *(const u32x4*)(GT + (size_t)row0 * 2048 + goff + col0 + bj * 128); if (ADD) yc[bj] = *(const u32x4*)(Y + (size_t)row0 * 1024 + col0 + bj * 128); }
#pragma unroll
        for (int gI = 0; gI < 8; ++gI) {
            const int ai = gI >> 2, m = gI & 3, row = row0 + ai * 128 + m * 16;
            if (gI < 7) { const int rn = row0 + ((gI + 1) >> 2) * 128 + ((gI + 1) & 3) * 16;
#pragma unroll
                for (int bj = 0; bj < 2; ++bj) { gn[bj] = *(const u32x4*)(GT + (size_t)rn * 2048 + goff + col0 + bj * 128); if (ADD) yn[bj] = *(const u32x4*)(Y + (size_t)rn * 1024 + col0 + bj * 128); } }
#pragma unroll
            for (int bj = 0; bj < 2; ++bj) {
                const int c = col0 + bj * 128;
                float g[8]; unpack8(gc[bj], g);
                const f32x4 v0 = acc[ai][bj][m][0], v1 = acc[ai][bj][m][1];
                float o[8] = {v0[0] * g[0], v0[1] * g[1], v0[2] * g[2], v0[3] * g[3], v1[0] * g[4], v1[1] * g[5], v1[2] * g[6], v1[3] * g[7]};
                if (ADD) { float y[8]; unpack8(yc[bj], y);
#pragma unroll
                    for (int e = 0; e < 8; ++e) o[e] += y[e]; }
                u32x4 w; w.x = pk2(o[0], o[1]); w.y = pk2(o[2], o[3]); w.z = pk2(o[4], o[5]); w.w = pk2(o[6], o[7]);
                *(u32x4*)(Y + (size_t)row * 1024 + c) = w;
            }
#pragma unroll
            for (int bj = 0; bj < 2; ++bj) { gc[bj] = gn[bj]; if (ADD) yc[bj] = yn[bj]; }
            asm volatile("" ::: "memory");
        }
    }
};
struct EpiRes {
    static constexpr bool PERM = true, AFTER_DRAIN = false;
    const bf16_t* xs; bf16_t* xb; float* ssq;
    __device__ __forceinline__ void operator()(const f32x4 (&acc)[2][2][4][2], const Unit& u, int wr, int wc, int fr, int fq) const {
        const int row0 = u.pm * 256 + wr * 64 + fr, col0 = u.pn * 256 + wc * 32 + 8 * fq;
        u32x4 cur[2], nxt[2];
#pragma unroll
        for (int bj = 0; bj < 2; ++bj) cur[bj] = *(const u32x4*)(xs + (size_t)row0 * 1024 + col0 + bj * 128);
#pragma unroll
        for (int gI = 0; gI < 8; ++gI) {
            const int ai = gI >> 2, m = gI & 3, row = row0 + ai * 128 + m * 16;
            if (gI < 7) { const int rn = row0 + ((gI + 1) >> 2) * 128 + ((gI + 1) & 3) * 16;
#pragma unroll
                for (int bj = 0; bj < 2; ++bj) nxt[bj] = *(const u32x4*)(xs + (size_t)rn * 1024 + col0 + bj * 128); }
            float ss = 0.f;
#pragma unroll
            for (int bj = 0; bj < 2; ++bj) {
                float x[8]; unpack8(cur[bj], x);
                const f32x4 v0 = acc[ai][bj][m][0], v1 = acc[ai][bj][m][1];
                u32x4 w; w.x = pk2(x[0] + v0[0], x[1] + v0[1]); w.y = pk2(x[2] + v0[2], x[3] + v0[3]); w.z = pk2(x[4] + v1[0], x[5] + v1[1]); w.w = pk2(x[6] + v1[2], x[7] + v1[3]);
                *(u32x4*)(xb + (size_t)row * 1024 + col0 + bj * 128) = w;
                float y[8]; unpack8(w, y);
#pragma unroll
                for (int e = 0; e < 8; ++e) ss += y[e] * y[e];
            }
            ss += __shfl_xor(ss, 16); ss += __shfl_xor(ss, 32);
            if (fq == 0) ssq[(size_t)row * 16 + u.pn * 4 + wc] = ss;
#pragma unroll
            for (int bj = 0; bj < 2; ++bj) cur[bj] = nxt[bj];
            asm volatile("" ::: "memory");
        }
    }
};
__device__ __forceinline__ float dpp_ror1(float v) { return __int_as_float(__builtin_amdgcn_update_dpp(__float_as_int(v), __float_as_int(v), 0x121, 0xf, 0xf, false)); }
__device__ __forceinline__ float dpp_ror2(float v) { return __int_as_float(__builtin_amdgcn_update_dpp(__float_as_int(v), __float_as_int(v), 0x122, 0xf, 0xf, false)); }
struct EpiUp {
    static constexpr bool PERM = true, AFTER_DRAIN = false;
    bf16_t* AC; bf16_t* H; const float* ssq; const float* cw; const float* cb; LAS float* wl; const LAS float* rtab; mutable int k;
    __device__ __forceinline__ void operator()(const f32x4 (&acc)[2][2][4][2], const Unit& u, int wr, int wc, int fr, int fq) const {
        const int rowb = u.pm * 256 + wr * 64 + fr, cl = u.pn * 128 + wc * 32 + 8 * fq;
        LAS float* wv = wl + (wr * 4 + wc) * 256;
        {
            const int lane = fq * 16 + fr, kind = lane >> 3, c4 = (lane & 7) * 4, cg = u.pn * 128 + wc * 32 + c4 + (kind >= 4 ? DFF : 0), kk = kind & 3;
            const f32x4 v = *(const f32x4*)((kk == 3 ? cb : cw + kk * NUP) + cg);
            *(LAS f32x4*)(wv + kind * 32 + c4) = v;
            asm volatile("s_waitcnt lgkmcnt(0)" ::: "memory");
        }
#pragma unroll
        for (int n = 0; n < 2; ++n) {
            const int c = cl + 4 * n; const LAS float* wp = wv + 8 * fq + 4 * n;
#pragma unroll
            for (int ai = 0; ai < 2; ++ai) {
                f32x4 pg1 = {0.f, 0.f, 0.f, 0.f}, pg2 = pg1, pv1 = pg1, pv2 = pg1;
#pragma unroll
                for (int m = 0; m < 4; ++m) {
                    const int row = rowb + ai * 128 + m * 16; const float r = k < RT_UNITS ? rtab[k * 256 + ai * 128 + wr * 64 + m * 16 + fr] : rowscale(ssq, row);
                    const f32x4 zg = acc[ai][0][m][n] * r, zv = acc[ai][1][m][n] * r;
                    f32x4 ag1, ag2, av1, av2, g1, g2, v1, v2;
#pragma unroll
                    for (int j = 0; j < 4; ++j) {
                        ag1[j] = dpp_ror1(zg[j]); ag2[j] = dpp_ror2(zg[j]); av1[j] = dpp_ror1(zv[j]); av2[j] = dpp_ror2(zv[j]);
                        g1[j] = fr >= 1 ? ag1[j] : pg1[j]; g2[j] = fr >= 2 ? ag2[j] : pg2[j];
                        v1[j] = fr >= 1 ? av1[j] : pv1[j]; v2[j] = fr >= 2 ? av2[j] : pv2[j];
                    }
                    const f32x4 zcg = *(const LAS f32x4*)(wp + 96) + *(const LAS f32x4*)(wp) * g2 + *(const LAS f32x4*)(wp + 32) * g1 + *(const LAS f32x4*)(wp + 64) * zg;
                    const f32x4 zcv = *(const LAS f32x4*)(wp + 224) + *(const LAS f32x4*)(wp + 128) * v2 + *(const LAS f32x4*)(wp + 160) * v1 + *(const LAS f32x4*)(wp + 192) * zv;
                    u32x2 o; o.x = pk2(silu(zcg[0]) * zcv[0], silu(zcg[1]) * zcv[1]); o.y = pk2(silu(zcg[2]) * zcv[2], silu(zcg[3]) * zcv[3]);
                    if (m != 0 || fr >= 2) *(u32x2*)(AC + (size_t)row * DFF + c) = o;
                    if ((m == 0 && fr < 2) || (m == 3 && fr >= 14)) {
                        const int slot = m == 0 ? fr : fr - 12;
                        bf16_t* hp = H + ((size_t)(row >> 6) * 4 + slot) * NUP + c;
                        u32x2 hg; hg.x = pk2(zg[0], zg[1]); hg.y = pk2(zg[2], zg[3]); *(u32x2*)hp = hg;
                        u32x2 hv; hv.x = pk2(zv[0], zv[1]); hv.y = pk2(zv[2], zv[3]); *(u32x2*)(hp + DFF) = hv;
                    }
                    pg1 = ag1; pg2 = ag2; pv1 = av1; pv2 = av2;
                    asm volatile("" ::: "memory"); __builtin_amdgcn_sched_barrier(0);
                }
            }
        }
        ++k;
    }
};

template <bool UPMAP = false> __device__ __forceinline__ void transpose_item(const float* W, int K, int N, bf16_t* WT, LAS float* scr, int item, int lane, const float* gk = nullptr) {
    const int nblk = N / 32, kb = item / nblk, nb = item % nblk, k0 = 64 * kb, n0 = 32 * nb;
    const int r0 = !UPMAP ? n0 : (n0 < DFF ? (n0 >> 7) * 256 + (n0 & 127) : ((n0 - DFF) >> 7) * 256 + 128 + ((n0 - DFF) & 127));
    f32x4 wv[8];
#pragma unroll
    for (int i = 0; i < 8; ++i) wv[i] = *(const f32x4*)(W + (size_t)(k0 + 8 * i + (lane >> 3)) * N + n0 + (lane & 7) * 4);
#pragma unroll
    for (int i = 0; i < 8; ++i) { const int kk = 8 * i + (lane >> 3); const float gsc = gk ? gk[k0 + kk] : 1.f; LAS float* sp = scr + kk * 33 + (lane & 7) * 4;
        sp[0] = wv[i][0] * gsc; sp[1] = wv[i][1] * gsc; sp[2] = wv[i][2] * gsc; sp[3] = wv[i][3] * gsc; }
    asm volatile("s_waitcnt lgkmcnt(0)" ::: "memory");
    const int c = lane & 7;
#pragma unroll
    for (int j = 0; j < 4; ++j) { const int n = (lane >> 3) + 8 * j; const LAS float* s = scr + (8 * c) * 33 + n;
        u32x4 o; o.x = pk2(s[0 * 33], s[1 * 33]); o.y = pk2(s[2 * 33], s[3 * 33]); o.z = pk2(s[4 * 33], s[5 * 33]); o.w = pk2(s[6 * 33], s[7 * 33]);
        *(u32x4*)(WT + (size_t)(r0 + n) * K + k0 + 8 * c) = o; }
    asm volatile("s_waitcnt lgkmcnt(0)" ::: "memory");
}
__device__ __forceinline__ void convert_set(const Args& a, LAS unsigned char* lds, int set, int l, int first_block = 0, int n_blocks = 0) {
    const int tid = opaque_tid(), lane = tid & 63, wave = tid >> 6;
    LAS float* scr = (LAS float*)(lds + wave * 16384);
    if (n_blocks == 0) n_blocks = gridDim.x;
    if ((int)blockIdx.x < first_block || (int)blockIdx.x >= first_block + n_blocks) return;
    const int gw = ((int)blockIdx.x - first_block) * 8 + wave, NGW = n_blocks * 8;
    unsigned char* ws = a.ws;
    if (set == 0) {
        constexpr int I0 = (D / 64) * (INC / 32), I1 = (512 / 64) * (D / 32), I3 = (D / 64) * (D / 32), NI = I0 + 2 * I1 + I3;
        for (int it = gw; it < NI; it += NGW) {
            int r = it;
            if (r < I0) { transpose_item(a.w_in + (size_t)l * D * INC, D, INC, (bf16_t*)(ws + WS_WIN), scr, r, lane, a.mix_norm + l * D); continue; } r -= I0;
            if (r < I1) { transpose_item(a.w_br_gm + (size_t)l * 512 * D, 512, D, (bf16_t*)(ws + WS_WGM), scr, r, lane); continue; } r -= I1;
            if (r < I1) { transpose_item(a.w_br_hg + (size_t)l * 512 * D, 512, D, (bf16_t*)(ws + WS_WHG), scr, r, lane); continue; } r -= I1;
            transpose_item(a.w_out + (size_t)l * D * D, D, D, (bf16_t*)(ws + WS_WOUT), scr, r, lane);
        }
    } else {
        constexpr int I0 = (D / 64) * (NUP / 32), I1 = (DFF / 64) * (D / 32), NI = I0 + I1;
        for (int it = gw; it < NI; it += NGW) {
            int r = it;
            if (r < I0) { transpose_item<true>(a.w_up + (size_t)l * D * NUP, D, NUP, (bf16_t*)(ws + WS_WUP + (l & 1) * WS_FFNW_STRIDE), scr, r, lane, a.ffn_norm + l * D); continue; } r -= I0;
            transpose_item(a.w_down + (size_t)l * DFF * D, DFF, D, (bf16_t*)(ws + WS_WDN + (l & 1) * WS_FFNW_STRIDE), scr, r, lane);
        }
    }
}

#define LDS_BARRIER() asm volatile("s_waitcnt lgkmcnt(0)\n\ts_barrier" ::: "memory")
constexpr int LDQ = 136, LDV = 72, LDG = 132;
__device__ __forceinline__ bf16x8 ldfrag(const LAS bf16_t* base, int ld, int fr, int fq, int k0) { return *(const LAS bf16x8*)(base + fr * ld + k0 + fq * 8); }
#define MMA16(xf, yf, acc) __builtin_amdgcn_mfma_f32_16x16x32_bf16((xf), (yf), (acc), 0, 0, 0)

__device__ __forceinline__ void gmlp_unit(const Args& a, LAS unsigned char* lds, int unit, int l) {
    const int tid = opaque_tid(), lane = tid & 63, w = tid >> 6, fr = lane & 15, fq = lane >> 4;
    const int h = unit & 3, blk = (unit >> 2) & 63, b = unit >> 8;
    const size_t r0 = (size_t)b * SEQ + (size_t)blk * 128;
    LAS bf16_t* Vt = (LAS bf16_t*)lds;
    LAS bf16_t* Wl = Vt + 128 * LDQ;
    LAS f32x2* stat = (LAS f32x2*)(Wl + 128 * LDQ);
    const bf16_t* Vg = (const bf16_t*)(a.ws + WS_V); bf16_t* Ug = (bf16_t*)(a.ws + WS_U);
    const float* lng = a.gm_ln_g + l * 512; const float* lnb = a.gm_ln_b + l * 512;
    const float* wsrc = a.gm_ws + (size_t)(l * 4 + h) * 16384;
    u32x4 vraw[4]; f32x4 wreg[8];
#pragma unroll
    for (int it = 0; it < 4; ++it) vraw[it] = *(const u32x4*)(Vg + (r0 + (it & 1) * 64 + lane) * 512 + h * 128 + ((it >> 1) * 8 + w) * 8);
#pragma unroll
    for (int it = 0; it < 8; ++it) { const int idx = it * 512 + tid; wreg[it] = *(const f32x4*)(wsrc + (idx >> 5) * 128 + (idx & 31) * 4); }
    f32x4 lg[2][2], lb2[2][2];
#pragma unroll
    for (int q = 0; q < 2; ++q) { const int cg0 = h * 128 + (q * 8 + w) * 8; lg[q][0] = *(const f32x4*)(lng + cg0); lg[q][1] = *(const f32x4*)(lng + cg0 + 4); lb2[q][0] = *(const f32x4*)(lnb + cg0); lb2[q][1] = *(const f32x4*)(lnb + cg0 + 4); }
    if (tid < 128) {
        const f32x4* vp = (const f32x4*)((const float*)(a.ws + WS_VS) + (r0 + tid) * 16);
        const f32x4 p0 = vp[0], p1 = vp[1], p2 = vp[2], p3 = vp[3];
        const float s1 = ((p0[0] + p0[2]) + (p1[0] + p1[2])) + ((p2[0] + p2[2]) + (p3[0] + p3[2])), s2 = ((p0[1] + p0[3]) + (p1[1] + p1[3])) + ((p2[1] + p2[3]) + (p3[1] + p3[3]));
        const float mean = s1 * (1.f / 512.f), var = fmaxf(s2 * (1.f / 512.f) - mean * mean, 0.f);
        stat[tid] = (f32x2){mean, rsqrtf(var + EPS)};
    }
#pragma unroll
    for (int it = 0; it < 8; ++it) {
        const int idx = it * 512 + tid, i = idx >> 5, j4 = (idx & 31) * 4;
        f32x4 wv = wreg[it];
        if ((i >> 6) < (j4 >> 6)) wv = (f32x4){0.f, 0.f, 0.f, 0.f};
        u32x2 o; o.x = pk2(wv[0], wv[1]); o.y = pk2(wv[2], wv[3]);
        *(LAS u32x2*)(Wl + i * LDQ + j4) = o;
    }
    LDS_BARRIER();
#pragma unroll
    for (int it = 0; it < 4; ++it) {
        const int j = (it & 1) * 64 + lane, d0 = ((it >> 1) * 8 + w) * 8;
        const f32x2 st = stat[j];
        float x[8]; unpack8(vraw[it], x);
#pragma unroll
        for (int e = 0; e < 8; ++e) Vt[(d0 + e) * LDQ + j] = (bf16_t)f2bf((x[e] - st.x) * st.y * lg[it >> 1][e >> 2][e & 3] + lb2[it >> 1][e >> 2][e & 3]);
    }
    LDS_BARRIER();
    bf16x8 af[4];
#pragma unroll
    for (int ks = 0; ks < 4; ++ks) af[ks] = ldfrag(Wl + (w * 16) * LDQ, LDQ, fr, fq, ks * 32);
    const int i = w * 16 + fr; const float bias = a.gm_bs[(l * 4 + h) * 128 + i];
    u32x2 ureg[8];
#pragma unroll
    for (int dt = 0; dt < 8; ++dt) ureg[dt] = *(const u32x2*)(Ug + (r0 + i) * 512 + h * 128 + dt * 16 + 4 * fq);
#pragma unroll
    for (int dt = 0; dt < 8; ++dt) {
        f32x4 acc = {0.f, 0.f, 0.f, 0.f};
#pragma unroll
        for (int ks = 0; ks < 4; ++ks) if (ks < 2 || w >= 4) acc = MMA16(ldfrag(Vt + (dt * 16) * LDQ, LDQ, fr, fq, ks * 32), af[ks], acc);
        bf16_t* up = Ug + (r0 + i) * 512 + h * 128 + dt * 16 + 4 * fq;
        const u32x2 uu = ureg[dt];
        u32x2 o; o.x = pk2(bf2f(uu.x & 0xffffu) * (acc[0] + bias), bf2f(uu.x >> 16) * (acc[1] + bias));
        o.y = pk2(bf2f(uu.y & 0xffffu) * (acc[2] + bias), bf2f(uu.y >> 16) * (acc[3] + bias));
        *(u32x2*)up = o;
    }
    LDS_BARRIER();
}

__device__ __forceinline__ void hg1_unit(const Args& a, LAS unsigned char* lds, int unit) {
    const int tid = opaque_tid(), lane = tid & 63, w = tid >> 6, fr = lane & 15, fq = lane >> 4;
    const int c = unit & 127, bh = unit >> 7, h = bh & 3, b = bh >> 2;
    const size_t r0 = (size_t)b * SEQ + (size_t)c * 64;
    LAS float* Gs = (LAS float*)lds;
    LAS float* Tot = Gs + 64 * LDG;
    LAS bf16_t* Vt = (LAS bf16_t*)(lds + 64 * LDG * 4 + 2048);
    LAS bf16_t* Kt = Vt + 128 * LDV;
    float* GLg = (float*)(a.ws + WS_GL); const bf16_t* Ig = (const bf16_t*)(a.ws + WS_I); const bf16_t* Kg = (const bf16_t*)(a.ws + WS_KK);
    const int d = tid & 127, sg = tid >> 7;
    float* gp = GLg + (r0 + sg * 16) * 512 + h * 128 + d;
    float g[16];
#pragma unroll
    for (int j = 0; j < 16; ++j) g[j] = gp[(size_t)j * 512];
#pragma unroll
    for (int j = 1; j < 16; ++j) g[j] += g[j - 1];
    Tot[sg * 128 + d] = g[15];
    u32x4 kraw[2], vraw[2];
#pragma unroll
    for (int it = 0; it < 2; ++it) { const int idx = it * 512 + tid; const size_t go = (r0 + (idx >> 4)) * 512 + h * 128 + (idx & 15) * 8; vraw[it] = *(const u32x4*)(Ig + go); kraw[it] = *(const u32x4*)(Kg + go); }
#pragma unroll
    for (int it = 0; it < 2; ++it) {
        const int idx = it * 512 + tid, j = idx >> 4, e0 = (idx & 15) * 8;
        const u32x4 raw = vraw[it];
        const unsigned rw[4] = {raw.x, raw.y, raw.z, raw.w};
#pragma unroll
        for (int e = 0; e < 8; ++e) Vt[(e0 + e) * LDV + j] = (bf16_t)((rw[e >> 1] >> ((e & 1) * 16)) & 0xffffu);
    }
    LDS_BARRIER();
    float off = 0.f;
#pragma unroll
    for (int s = 0; s < 3; ++s) off += (s < sg) ? Tot[s * 128 + d] : 0.f;
#pragma unroll
    for (int j = 0; j < 16; ++j) { g[j] += off; gp[(size_t)j * 512] = g[j]; Gs[(sg * 16 + j) * LDG + d] = g[j]; }
    LDS_BARRIER();
#pragma unroll
    for (int it = 0; it < 2; ++it) {
        const int idx = it * 512 + tid, j = idx >> 4, d0 = (idx & 15) * 8;
        float kv[8]; unpack8(kraw[it], kv);
#pragma unroll
        for (int e = 0; e < 8; ++e) Kt[(d0 + e) * LDV + j] = (bf16_t)f2bf(kv[e] * fexp2(Gs[63 * LDG + d0 + e] - Gs[j * LDG + d0 + e]));
    }
    if (tid < 128) ((float*)(a.ws + WS_DEC))[(size_t)unit * 128 + tid] = fexp2(Gs[63 * LDG + tid]);
    LDS_BARRIER();
    bf16x8 af[2];
#pragma unroll
    for (int ks = 0; ks < 2; ++ks) af[ks] = ldfrag(Vt + (w * 16) * LDV, LDV, fr, fq, ks * 32);
    float* STg = (float*)(a.ws + WS_ST) + (size_t)unit * 16384;
#pragma unroll
    for (int dt = 0; dt < 8; ++dt) {
        f32x4 acc = {0.f, 0.f, 0.f, 0.f};
#pragma unroll
        for (int ks = 0; ks < 2; ++ks) acc = MMA16(ldfrag(Kt + (dt * 16) * LDV, LDV, fr, fq, ks * 32), af[ks], acc);
        *(f32x4*)(STg + (w * 16 + fr) * 128 + dt * 16 + 4 * fq) = acc;
    }
    LDS_BARRIER();
}

__device__ __forceinline__ void hg_scan(const Args& a) {
    float* ST = (float*)(a.ws + WS_ST); const float* DEC = (const float*)(a.ws + WS_DEC);
    for (int idx = blockIdx.x * 512 + opaque_tid(); idx < 8 * 8192; idx += gridDim.x * 512) {
        const int bh = idx >> 13, ed = (idx & 8191) * 2, d = ed & 127;
        float* p = ST + (size_t)bh * 128 * 16384 + ed; const float* dc = DEC + (size_t)bh * 128 * 128 + d;
        f32x2 S = {0.f, 0.f};
#pragma unroll 32
        for (int c = 0; c < 128; ++c) { const f32x2 u = *(const f32x2*)(p + (size_t)c * 16384); const f32x2 dec = *(const f32x2*)(dc + c * 128); *(f32x2*)(p + (size_t)c * 16384) = S; S = dec * S + u; }
    }
}

__device__ __forceinline__ void hg3_unit(const Args& a, LAS unsigned char* lds, int unit, int l) {
    const int tid = opaque_tid(), lane = tid & 63, w = tid >> 6, fr = lane & 15, fq = lane >> 4;
    const int c = unit & 127, bh = unit >> 7, h = bh & 3, b = bh >> 2;
    const size_t r0 = (size_t)b * SEQ + (size_t)c * 64;
    LAS bf16_t* Qh = (LAS bf16_t*)lds;
    LAS bf16_t* Qt = Qh + 64 * LDQ;
    LAS bf16_t* Kh = Qt + 64 * LDQ;
    LAS bf16_t* Vt = Kh + 160 * LDQ;
    LAS bf16_t* As = Vt + 128 * LDV;
    LAS bf16_t* Sts = Kh;
    LAS float* Os = (LAS float*)Qh;
    const float* GLg = (const float*)(a.ws + WS_GL); const bf16_t* Ig = (const bf16_t*)(a.ws + WS_I);
    const bf16_t* Qg = (const bf16_t*)(a.ws + WS_Q); const bf16_t* Kg = (const bf16_t*)(a.ws + WS_KK);
    const float* STg = (const float*)(a.ws + WS_ST) + (size_t)unit * 16384;
    f32x4 sreg[8]; unsigned ogreg[8];
    bf16_t* OGg = (bf16_t*)(a.ws + WS_OG);
#pragma unroll
    for (int it = 0; it < 8; ++it) { const int idx = it * 512 + tid; sreg[it] = *(const f32x4*)(STg + (idx >> 5) * 128 + (idx & 31) * 4); }
#pragma unroll
    for (int rr = 0; rr < 8; ++rr) ogreg[rr] = *(const unsigned*)(OGg + (r0 + w * 8 + rr) * 512 + h * 128 + 2 * lane);
#pragma unroll
    for (int it = 0; it < 2; ++it) {
        const int idx = it * 512 + tid, j = idx >> 4, d0 = (idx & 15) * 8;
        const int J = __builtin_amdgcn_readfirstlane(j >> 4);
        const size_t go = (r0 + j) * 512 + h * 128 + d0;
        float qv[8], kv[8]; unpack8(*(const u32x4*)(Qg + go), qv); unpack8(*(const u32x4*)(Kg + go), kv);
        const f32x4 ga = *(const f32x4*)(GLg + go), gb = *(const f32x4*)(GLg + go + 4);
        const float gj[8] = {ga[0], ga[1], ga[2], ga[3], gb[0], gb[1], gb[2], gb[3]};
        const u32x4 raw = *(const u32x4*)(Ig + go);
        {
            u32x4 o; o.x = pk2(qv[0] * fexp2(gj[0]), qv[1] * fexp2(gj[1])); o.y = pk2(qv[2] * fexp2(gj[2]), qv[3] * fexp2(gj[3]));
            o.z = pk2(qv[4] * fexp2(gj[4]), qv[5] * fexp2(gj[5])); o.w = pk2(qv[6] * fexp2(gj[6]), qv[7] * fexp2(gj[7]));
            *(LAS u32x4*)(Qt + j * LDQ + d0) = o;
        }
#pragma unroll
        for (int I = 0; I < 4; ++I) {
            if (I >= J) {
                const size_t ro = (r0 + 16 * I) * 512 + h * 128 + d0;
                const f32x4 ra = *(const f32x4*)(GLg + ro), rb = *(const f32x4*)(GLg + ro + 4);
                const float rf[8] = {ra[0], ra[1], ra[2], ra[3], rb[0], rb[1], rb[2], rb[3]};
                float kh[8];
#pragma unroll
                for (int e = 0; e < 8; ++e) kh[e] = kv[e] * fexp2(fminf(rf[e] - gj[e], 120.f));
                u32x4 o; o.x = pk2(kh[0], kh[1]); o.y = pk2(kh[2], kh[3]); o.z = pk2(kh[4], kh[5]); o.w = pk2(kh[6], kh[7]);
                *(LAS u32x4*)(Kh + (8 * I * (I + 1) + j) * LDQ + d0) = o;
                if (I == J) {
                    u32x4 q; q.x = pk2(qv[0] * fexp2(gj[0] - rf[0]), qv[1] * fexp2(gj[1] - rf[1])); q.y = pk2(qv[2] * fexp2(gj[2] - rf[2]), qv[3] * fexp2(gj[3] - rf[3]));
                    q.z = pk2(qv[4] * fexp2(gj[4] - rf[4]), qv[5] * fexp2(gj[5] - rf[5])); q.w = pk2(qv[6] * fexp2(gj[6] - rf[6]), qv[7] * fexp2(gj[7] - rf[7]));
                    *(LAS u32x4*)(Qh + j * LDQ + d0) = q;
                }
            }
        }
        const unsigned rw[4] = {raw.x, raw.y, raw.z, raw.w};
#pragma unroll
        for (int e = 0; e < 8; ++e) Vt[(d0 + e) * LDV + j] = (bf16_t)((rw[e >> 1] >> ((e & 1) * 16)) & 0xffffu);
    }
    for (int idx = tid; idx < 64 * LDV / 8; idx += 512) *(LAS u32x4*)(As + idx * 8) = (u32x4){0u, 0u, 0u, 0u};
    LDS_BARRIER();
#pragma unroll 1
    for (int t = w; t < 10; t += 8) {
        const int I = t >= 6 ? 3 : t >= 3 ? 2 : t >= 1 ? 1 : 0, J = t - (I * (I + 1)) / 2;
        f32x4 acc = {0.f, 0.f, 0.f, 0.f};
#pragma unroll
        for (int ks = 0; ks < 4; ++ks) acc = MMA16(ldfrag(Kh + (8 * I * (I + 1) + 16 * J) * LDQ, LDQ, fr, fq, ks * 32), ldfrag(Qh + (16 * I) * LDQ, LDQ, fr, fq, ks * 32), acc);
        if (I == J) {
#pragma unroll
            for (int r = 0; r < 4; ++r) acc[r] = (4 * fq + r <= fr) ? acc[r] : 0.f;
        }
        u32x2 o; o.x = pk2(acc[0], acc[1]); o.y = pk2(acc[2], acc[3]);
        *(LAS u32x2*)(As + (16 * I + fr) * LDV + 16 * J + 4 * fq) = o;
    }
    LDS_BARRIER();
#pragma unroll
    for (int it = 0; it < 8; ++it) {
        const int idx = it * 512 + tid, e = idx >> 5, d4 = (idx & 31) * 4;
        const f32x4 sv = sreg[it];
        u32x2 o; o.x = pk2(sv[0], sv[1]); o.y = pk2(sv[2], sv[3]);
        *(LAS u32x2*)(Sts + e * LDQ + d4) = o;
    }
    LDS_BARRIER();
    {
        const int it = w & 3, eb = (w >> 2) * 4;
        bf16x8 af[2], qf[4];
#pragma unroll
        for (int ks = 0; ks < 2; ++ks) af[ks] = ldfrag(As + (it * 16) * LDV, LDV, fr, fq, ks * 32);
#pragma unroll
        for (int ks = 0; ks < 4; ++ks) qf[ks] = ldfrag(Qt + (it * 16) * LDQ, LDQ, fr, fq, ks * 32);
        LDS_BARRIER();
#pragma unroll
        for (int t = 0; t < 4; ++t) {
            const int et = eb + t; f32x4 acc = {0.f, 0.f, 0.f, 0.f};
#pragma unroll
            for (int ks = 0; ks < 2; ++ks) acc = MMA16(ldfrag(Vt + (et * 16) * LDV, LDV, fr, fq, ks * 32), af[ks], acc);
#pragma unroll
            for (int ks = 0; ks < 4; ++ks) acc = MMA16(ldfrag(Sts + (et * 16) * LDQ, LDQ, fr, fq, ks * 32), qf[ks], acc);
            *(LAS f32x4*)(Os + (it * 16 + fr) * LDG + et * 16 + 4 * fq) = acc;
        }
    }
    LDS_BARRIER();
    {
        const f32x2 ng = *(const f32x2*)(a.hg_norm_g + l * 128 + 2 * lane);
#pragma unroll
        for (int rr = 0; rr < 8; ++rr) {
            const int i = w * 8 + rr;
            const f32x2 o = *(const LAS f32x2*)(Os + i * LDG + 2 * lane);
            const float r = rsqrtf(wave_sum(o.x * o.x + o.y * o.y) * (1.f / 128.f) + EPS);
            unsigned* op = (unsigned*)(OGg + (r0 + i) * 512 + h * 128 + 2 * lane);
            const unsigned og = ogreg[rr];
            *op = pk2(o.x * r * ng.x * bf2f(og & 0xffffu), o.y * r * ng.y * bf2f(og >> 16));
        }
    }
    LDS_BARRIER();
}

constexpr int HG_GC = 4, HG_NG = (SEQ / 64) / HG_GC;
__device__ __forceinline__ void hg1g_unit(const Args& a, LAS unsigned char* lds, int unit) {
    const int tid = opaque_tid(), lane = tid & 63, w = tid >> 6, fr = lane & 15, fq = lane >> 4;
    const int cg = unit % HG_NG, bh = unit / HG_NG, h = bh & 3, b = bh >> 2;
    LAS float* Gs = (LAS float*)lds;
    LAS float* Tot = Gs + 64 * LDG;
    LAS bf16_t* Vt = (LAS bf16_t*)(lds + 64 * LDG * 4 + 2048);
    LAS bf16_t* Kt = Vt + 128 * LDV;
    float* GLg = (float*)(a.ws + WS_GL); const bf16_t* Ig = (const bf16_t*)(a.ws + WS_I); const bf16_t* Kg = (const bf16_t*)(a.ws + WS_KK);
    const int d = tid & 127, sg = tid >> 7;
    f32x4 acc[8];
#pragma unroll
    for (int dt = 0; dt < 8; ++dt) acc[dt] = (f32x4){0.f, 0.f, 0.f, 0.f};
    float dsum = 0.f;
#pragma unroll 1
    for (int s = 0; s < HG_GC; ++s) {
        const size_t r0 = (size_t)b * SEQ + (size_t)(cg * HG_GC + s) * 64;
        float* gp = GLg + (r0 + sg * 16) * 512 + h * 128 + d;
        float g[16];
#pragma unroll
        for (int j = 0; j < 16; ++j) g[j] = gp[(size_t)j * 512];
        u32x4 kraw[2], vraw[2];
#pragma unroll
        for (int it = 0; it < 2; ++it) { const size_t go = (r0 + lane) * 512 + h * 128 + (it * 8 + w) * 8; vraw[it] = *(const u32x4*)(Ig + go); kraw[it] = *(const u32x4*)(Kg + go); }
#pragma unroll
        for (int j = 1; j < 16; ++j) g[j] += g[j - 1];
        Tot[sg * 128 + d] = g[15];
#pragma unroll
        for (int it = 0; it < 2; ++it) {
            const int j = lane, e0 = (it * 8 + w) * 8;
            const unsigned rw[4] = {vraw[it].x, vraw[it].y, vraw[it].z, vraw[it].w};
#pragma unroll
            for (int e = 0; e < 8; ++e) Vt[(e0 + e) * LDV + j] = (bf16_t)((rw[e >> 1] >> ((e & 1) * 16)) & 0xffffu);
        }
        LDS_BARRIER();
        float off = 0.f;
#pragma unroll
        for (int q = 0; q < 3; ++q) off += (q < sg) ? Tot[q * 128 + d] : 0.f;
#pragma unroll
        for (int j = 0; j < 16; ++j) { g[j] += off; gp[(size_t)j * 512] = g[j]; Gs[(sg * 16 + j) * LDG + d] = g[j]; }
        LDS_BARRIER();
#pragma unroll
        for (int it = 0; it < 2; ++it) {
            const int j = lane, d0 = (it * 8 + w) * 8;
            float kv[8]; unpack8(kraw[it], kv);
            const f32x4 la = *(const LAS f32x4*)(Gs + 63 * LDG + d0), lb = *(const LAS f32x4*)(Gs + 63 * LDG + d0 + 4), ja = *(const LAS f32x4*)(Gs + j * LDG + d0), jb = *(const LAS f32x4*)(Gs + j * LDG + d0 + 4);
            const float dl[8] = {la[0] - ja[0], la[1] - ja[1], la[2] - ja[2], la[3] - ja[3], lb[0] - jb[0], lb[1] - jb[1], lb[2] - jb[2], lb[3] - jb[3]};
#pragma unroll
            for (int e = 0; e < 8; ++e) Kt[(d0 + e) * LDV + j] = (bf16_t)f2bf(kv[e] * fexp2(dl[e]));
        }
        if (tid < 128) { const float g63 = Gs[63 * LDG + tid]; dsum += g63; Tot[tid] = fexp2(g63); }
        LDS_BARRIER();
        bf16x8 af[2];
#pragma unroll
        for (int ks = 0; ks < 2; ++ks) af[ks] = ldfrag(Vt + (w * 16) * LDV, LDV, fr, fq, ks * 32);
#pragma unroll
        for (int dt = 0; dt < 8; ++dt) {
            acc[dt] = acc[dt] * *(const LAS f32x4*)(Tot + dt * 16 + 4 * fq);
#pragma unroll
            for (int ks = 0; ks < 2; ++ks) acc[dt] = MMA16(ldfrag(Kt + (dt * 16) * LDV, LDV, fr, fq, ks * 32), af[ks], acc[dt]);
        }
        LDS_BARRIER();
    }
    float* TGg = (float*)(a.ws + WS_ST) + (size_t)unit * 16384;
#pragma unroll
    for (int dt = 0; dt < 8; ++dt) *(f32x4*)(TGg + (w * 16 + fr) * 128 + dt * 16 + 4 * fq) = acc[dt];
    if (tid < 128) ((float*)(a.ws + WS_DEC))[(size_t)unit * 128 + tid] = fexp2(dsum);
}
__device__ __forceinline__ void hg_gscan(const Args& a) {
    const float* TG = (const float*)(a.ws + WS_ST); float* SG = (float*)(a.ws + WS_ST + 16 * MiB); const float* DG = (const float*)(a.ws + WS_DEC);
    for (int idx = blockIdx.x * 512 + opaque_tid(); idx < 8 * 16384; idx += gridDim.x * 512) {
        const int bh = idx >> 14, ed = idx & 16383, d = ed & 127;
        const float* p = TG + (size_t)bh * HG_NG * 16384 + ed; float* q = SG + (size_t)bh * HG_NG * 16384 + ed; const float* dc = DG + (size_t)bh * HG_NG * 128 + d;
        float S = 0.f;
#pragma unroll
        for (int c = 0; c < HG_NG; ++c) { const float u = p[(size_t)c * 16384]; const float dec = dc[c * 128]; q[(size_t)c * 16384] = S; S = dec * S + u; }
    }
}
__device__ __forceinline__ void hg3g_unit(const Args& a, LAS unsigned char* lds, int unit, int l, unsigned long long& pr_acc) {
    unsigned long long pt0 = 0;
#define HP_B(bit) do { if ((PROBE_MASK) & (bit)) pt0 = __builtin_amdgcn_s_memrealtime(); } while (0)
#define HP_E(bit) do { if ((PROBE_MASK) & (bit)) pr_acc += __builtin_amdgcn_s_memrealtime() - pt0; } while (0)
    const int tid = opaque_tid(), lane = tid & 63, w = tid >> 6, fr = lane & 15, fq = lane >> 4;
    const int cg = unit % HG_NG, bh = unit / HG_NG, h = bh & 3, b = bh >> 2;
    LAS bf16_t* Qh = (LAS bf16_t*)lds;
    LAS bf16_t* Qt = Qh + 64 * LDQ;
    LAS bf16_t* Kh = Qt + 64 * LDQ;
    LAS bf16_t* Vt = Kh + 160 * LDQ;
    LAS bf16_t* As = Vt + 128 * LDV;
    LAS bf16_t* Sts = As + 64 * LDV;
    LAS float* Os = (LAS float*)Qh;
    LAS bf16_t* Kt = Kh; LAS float* DecL = (LAS float*)(Kh + 128 * LDV);
    const float* GLg = (const float*)(a.ws + WS_GL); const bf16_t* Ig = (const bf16_t*)(a.ws + WS_I);
    const bf16_t* Qg = (const bf16_t*)(a.ws + WS_Q); const bf16_t* Kg = (const bf16_t*)(a.ws + WS_KK);
    bf16_t* OGg = (bf16_t*)(a.ws + WS_OG);
    f32x4 acc[8];
    {
        const float* TGg = (const float*)(a.ws + WS_ST + 16 * MiB) + (size_t)unit * 16384;
#pragma unroll
        for (int dt = 0; dt < 8; ++dt) acc[dt] = *(const f32x4*)(TGg + (w * 16 + fr) * 128 + dt * 16 + 4 * fq);
#pragma unroll
        for (int dt = 0; dt < 8; ++dt) { u32x2 o; o.x = pk2(acc[dt][0], acc[dt][1]); o.y = pk2(acc[dt][2], acc[dt][3]); *(LAS u32x2*)(Sts + (w * 16 + fr) * LDQ + dt * 16 + 4 * fq) = o; }
    }
    u32x4 nq[2], nk[2], nv[2]; f32x4 nga[2], ngb[2]; float ng63 = 0.f;
#define HG3_LOADS(R0) do { _Pragma("unroll") for (int it_ = 0; it_ < 2; ++it_) { const size_t go_ = ((R0) + 16 * ((it_ * 8 + w) >> 2) + (lane & 15)) * 512 + h * 128 + (((it_ * 8 + w) & 3) * 4 + (lane >> 4)) * 8; \
        nq[it_] = *(const u32x4*)(Qg + go_); nk[it_] = *(const u32x4*)(Kg + go_); nv[it_] = *(const u32x4*)(Ig + go_); nga[it_] = *(const f32x4*)(GLg + go_); ngb[it_] = *(const f32x4*)(GLg + go_ + 4); \
        } \
        if (tid < 128) ng63 = GLg[((R0) + 63) * 512 + h * 128 + tid]; } while (0)
    { const size_t rr0 = (size_t)b * SEQ + (size_t)(cg * HG_GC) * 64; HG3_LOADS(rr0); }
#pragma unroll 1
    for (int s = 0; s < HG_GC; ++s) {
        const size_t r0 = (size_t)b * SEQ + (size_t)(cg * HG_GC + s) * 64;
        HP_B(0x10000);
        unsigned ogreg[8]; u32x4 ktp[2]; u32x4 cq[2], ck[2], cv[2]; f32x4 cga[2], cgb[2];
        const float g63s = ng63;
        { const u32x4* ogp = (const u32x4*)(OGg + (r0 + w * 8 + (lane >> 3)) * 512 + h * 128 + (lane & 7) * 16); const u32x4 o0 = ogp[0], o1 = ogp[1];
          ogreg[0] = o0.x; ogreg[1] = o0.y; ogreg[2] = o0.z; ogreg[3] = o0.w; ogreg[4] = o1.x; ogreg[5] = o1.y; ogreg[6] = o1.z; ogreg[7] = o1.w; }
#pragma unroll
        for (int it = 0; it < 2; ++it) { cq[it] = nq[it]; ck[it] = nk[it]; cv[it] = nv[it]; cga[it] = nga[it]; cgb[it] = ngb[it]; }
        if (s + 1 < HG_GC) { const size_t rn = r0 + 64; HG3_LOADS(rn); }
#pragma unroll
        for (int it = 0; it < 2; ++it) {
            const int J = (it * 8 + w) >> 2, j = 16 * J + (lane & 15), d0 = (((it * 8 + w) & 3) * 4 + (lane >> 4)) * 8;
            float qv[8], kv[8]; unpack8(cq[it], qv); unpack8(ck[it], kv);
            const f32x4 ga = cga[it], gb = cgb[it];
            const float gj[8] = {ga[0], ga[1], ga[2], ga[3], gb[0], gb[1], gb[2], gb[3]};
            const u32x4 raw = cv[it];
            {
                const size_t lo = (r0 + 63) * 512 + h * 128 + d0;
                const f32x4 la = *(const f32x4*)(GLg + lo), lb = *(const f32x4*)(GLg + lo + 4);
                const float gl[8] = {la[0], la[1], la[2], la[3], lb[0], lb[1], lb[2], lb[3]};
                u32x4 o; o.x = pk2(kv[0] * fexp2(gl[0] - gj[0]), kv[1] * fexp2(gl[1] - gj[1])); o.y = pk2(kv[2] * fexp2(gl[2] - gj[2]), kv[3] * fexp2(gl[3] - gj[3]));
                o.z = pk2(kv[4] * fexp2(gl[4] - gj[4]), kv[5] * fexp2(gl[5] - gj[5])); o.w = pk2(kv[6] * fexp2(gl[6] - gj[6]), kv[7] * fexp2(gl[7] - gj[7]));
                ktp[it] = o;
            }
            {
                u32x4 o; o.x = pk2(qv[0] * fexp2(gj[0]), qv[1] * fexp2(gj[1])); o.y = pk2(qv[2] * fexp2(gj[2]), qv[3] * fexp2(gj[3]));
                o.z = pk2(qv[4] * fexp2(gj[4]), qv[5] * fexp2(gj[5])); o.w = pk2(qv[6] * fexp2(gj[6]), qv[7] * fexp2(gj[7]));
                *(LAS u32x4*)(Qt + j * LDQ + d0) = o;
            }
            {
                const size_t ro = (r0 + 16 * J) * 512 + h * 128 + d0;
                const f32x4 ra = *(const f32x4*)(GLg + ro), rb = *(const f32x4*)(GLg + ro + 4);
                const float rf[8] = {ra[0], ra[1], ra[2], ra[3], rb[0], rb[1], rb[2], rb[3]};
                u32x4 q; q.x = pk2(qv[0] * fexp2(gj[0] - rf[0]), qv[1] * fexp2(gj[1] - rf[1])); q.y = pk2(qv[2] * fexp2(gj[2] - rf[2]), qv[3] * fexp2(gj[3] - rf[3]));
                q.z = pk2(qv[4] * fexp2(gj[4] - rf[4]), qv[5] * fexp2(gj[5] - rf[5])); q.w = pk2(qv[6] * fexp2(gj[6] - rf[6]), qv[7] * fexp2(gj[7] - rf[7]));
                *(LAS u32x4*)(Qh + j * LDQ + d0) = q;
            }
#pragma unroll
            for (int I = 0; I < 4; ++I) if (I >= J) {
                const size_t ro = (r0 + 16 * I) * 512 + h * 128 + d0;
                const f32x4 ra = *(const f32x4*)(GLg + ro), rb = *(const f32x4*)(GLg + ro + 4);
                const float rf[8] = {ra[0], ra[1], ra[2], ra[3], rb[0], rb[1], rb[2], rb[3]};
                float kh[8];
#pragma unroll
                for (int e = 0; e < 8; ++e) kh[e] = kv[e] * fexp2(fminf(rf[e] - gj[e], 120.f));
                u32x4 o; o.x = pk2(kh[0], kh[1]); o.y = pk2(kh[2], kh[3]); o.z = pk2(kh[4], kh[5]); o.w = pk2(kh[6], kh[7]);
                *(LAS u32x4*)(Kh + (8 * I * (I + 1) + j) * LDQ + d0) = o;
            }
            const unsigned rw[4] = {raw.x, raw.y, raw.z, raw.w};
#pragma unroll
            for (int e = 0; e < 8; ++e) Vt[(d0 + e) * LDV + j] = (bf16_t)((rw[e >> 1] >> ((e & 1) * 16)) & 0xffffu);
        }
        for (int idx = tid; idx < 64 * LDV / 8; idx += 512) *(LAS u32x4*)(As + idx * 8) = (u32x4){0u, 0u, 0u, 0u};
        LDS_BARRIER();
        HP_E(0x10000); HP_B(0x20000);
#pragma unroll 1
        for (int t = w; t < 10; t += 8) {
            const int I = t >= 6 ? 3 : t >= 3 ? 2 : t >= 1 ? 1 : 0, J = t - (I * (I + 1)) / 2;
            f32x4 sc = {0.f, 0.f, 0.f, 0.f};
#pragma unroll
            for (int ks = 0; ks < 4; ++ks) sc = MMA16(ldfrag(Kh + (8 * I * (I + 1) + 16 * J) * LDQ, LDQ, fr, fq, ks * 32), ldfrag(Qh + (16 * I) * LDQ, LDQ, fr, fq, ks * 32), sc);
            if (I == J) {
#pragma unroll
                for (int r = 0; r < 4; ++r) sc[r] = (4 * fq + r <= fr) ? sc[r] : 0.f;
            }
            u32x2 o; o.x = pk2(sc[0], sc[1]); o.y = pk2(sc[2], sc[3]);
            *(LAS u32x2*)(As + (16 * I + fr) * LDV + 16 * J + 4 * fq) = o;
        }
        LDS_BARRIER();
        HP_E(0x20000); HP_B(0x40000);
        const int it4 = w & 3, eb = (w >> 2) * 4;
        bf16x8 af[2], qf[4];
#pragma unroll
        for (int ks = 0; ks < 2; ++ks) af[ks] = ldfrag(As + (it4 * 16) * LDV, LDV, fr, fq, ks * 32);
#pragma unroll
        for (int ks = 0; ks < 4; ++ks) qf[ks] = ldfrag(Qt + (it4 * 16) * LDQ, LDQ, fr, fq, ks * 32);
#pragma unroll
        for (int it = 0; it < 2; ++it) {
            const int j = 16 * ((it * 8 + w) >> 2) + (lane & 15), d0 = (((it * 8 + w) & 3) * 4 + (lane >> 4)) * 8;
            const unsigned rw[4] = {ktp[it].x, ktp[it].y, ktp[it].z, ktp[it].w};
#pragma unroll
            for (int e = 0; e < 8; ++e) Kt[(d0 + e) * LDV + j] = (bf16_t)((rw[e >> 1] >> ((e & 1) * 16)) & 0xffffu);
        }
        if (tid < 128) DecL[tid] = fexp2(g63s);
        LDS_BARRIER();
#pragma unroll
        for (int t = 0; t < 4; ++t) {
            const int et = eb + t; f32x4 o = {0.f, 0.f, 0.f, 0.f};
#pragma unroll
            for (int ks = 0; ks < 2; ++ks) if (ks == 0 || it4 >= 2) o = MMA16(ldfrag(Vt + (et * 16) * LDV, LDV, fr, fq, ks * 32), af[ks], o);
#pragma unroll
            for (int ks = 0; ks < 4; ++ks) o = MMA16(ldfrag(Sts + (et * 16) * LDQ, LDQ, fr, fq, ks * 32), qf[ks], o);
            *(LAS f32x4*)(Os + (it4 * 16 + fr) * LDG + et * 16 + 4 * fq) = o;
        }
        {
            bf16x8 vf[2];
#pragma unroll
            for (int ks = 0; ks < 2; ++ks) vf[ks] = ldfrag(Vt + (w * 16) * LDV, LDV, fr, fq, ks * 32);
#pragma unroll
            for (int dt = 0; dt < 8; ++dt) {
                acc[dt] = acc[dt] * *(const LAS f32x4*)(DecL + dt * 16 + 4 * fq);
#pragma unroll
                for (int ks = 0; ks < 2; ++ks) acc[dt] = MMA16(ldfrag(Kt + (dt * 16) * LDV, LDV, fr, fq, ks * 32), vf[ks], acc[dt]);
            }
        }
        LDS_BARRIER();
        HP_E(0x40000); HP_B(0x80000);
#pragma unroll
        for (int dt = 0; dt < 8; ++dt) { u32x2 o; o.x = pk2(acc[dt][0], acc[dt][1]); o.y = pk2(acc[dt][2], acc[dt][3]); *(LAS u32x2*)(Sts + (w * 16 + fr) * LDQ + dt * 16 + 4 * fq) = o; }
        {
            const int i = w * 8 + (lane >> 3), c0 = (lane & 7) * 16;
            f32x4 ov[4]; float ss = 0.f;
#pragma unroll
            for (int q = 0; q < 4; ++q) { ov[q] = *(const LAS f32x4*)(Os + i * LDG + c0 + 4 * q); ss += (ov[q][0] * ov[q][0] + ov[q][1] * ov[q][1]) + (ov[q][2] * ov[q][2] + ov[q][3] * ov[q][3]); }
            ss += __shfl_xor(ss, 1); ss += __shfl_xor(ss, 2); ss += __shfl_xor(ss, 4);
            const float r = rsqrtf(ss * (1.f / 128.f) + EPS);
            const float* ngp = a.hg_norm_g + l * 128 + c0;
            unsigned ow[8];
#pragma unroll
            for (int q = 0; q < 4; ++q) { const f32x4 g = *(const f32x4*)(ngp + 4 * q); const unsigned og0 = ogreg[2 * q], og1 = ogreg[2 * q + 1];
                ow[2 * q] = pk2(ov[q][0] * r * g[0] * bf2f(og0 & 0xffffu), ov[q][1] * r * g[1] * bf2f(og0 >> 16));
                ow[2 * q + 1] = pk2(ov[q][2] * r * g[2] * bf2f(og1 & 0xffffu), ov[q][3] * r * g[3] * bf2f(og1 >> 16)); }
            u32x4* op = (u32x4*)(OGg + (r0 + i) * 512 + h * 128 + c0);
            op[0] = (u32x4){ow[0], ow[1], ow[2], ow[3]}; op[1] = (u32x4){ow[4], ow[5], ow[6], ow[7]};
        }
        LDS_BARRIER();
        HP_E(0x80000);
    }
}

__device__ __forceinline__ void conv_fixup(const Args& a, int l) {
    const bf16_t* H = (const bf16_t*)(a.ws + WS_Z); bf16_t* AC = (bf16_t*)(a.ws + WS_AC);
    const float* cw = a.conv_w + (size_t)l * 3 * NUP; const float* cb = a.conv_b + (size_t)l * NUP;
    constexpr int CCH = DFF / 8, NITEM = (M / 64) * CCH;
    for (int item = blockIdx.x * 512 + opaque_tid(); item < NITEM; item += gridDim.x * 512) {
        const int cc = item % CCH, gi = item / CCH, c = cc * 8;
        const bool first = (gi & (SEQ / 64 - 1)) == 0;
        float z[2][4][8];
#pragma unroll
        for (int gv = 0; gv < 2; ++gv) {
            const bf16_t* hp = H + (size_t)gi * 4 * NUP + gv * DFF + c;
            if (first) {
#pragma unroll
                for (int e = 0; e < 8; ++e) { z[gv][0][e] = 0.f; z[gv][1][e] = 0.f; }
            } else { unpack8(*(const u32x4*)(hp - 2 * NUP), z[gv][0]); unpack8(*(const u32x4*)(hp - NUP), z[gv][1]); }
            unpack8(*(const u32x4*)hp, z[gv][2]); unpack8(*(const u32x4*)(hp + NUP), z[gv][3]);
        }
        float w[2][3][8], bb[2][8];
#pragma unroll
        for (int gv = 0; gv < 2; ++gv) {
#pragma unroll
            for (int t = 0; t < 3; ++t) { const f32x4 x0 = *(const f32x4*)(cw + t * NUP + gv * DFF + c), x1 = *(const f32x4*)(cw + t * NUP + gv * DFF + c + 4);
#pragma unroll
                for (int e = 0; e < 4; ++e) { w[gv][t][e] = x0[e]; w[gv][t][4 + e] = x1[e]; } }
            const f32x4 y0 = *(const f32x4*)(cb + gv * DFF + c), y1 = *(const f32x4*)(cb + gv * DFF + c + 4);
#pragma unroll
            for (int e = 0; e < 4; ++e) { bb[gv][e] = y0[e]; bb[gv][4 + e] = y1[e]; }
        }
#pragma unroll
        for (int r = 0; r < 2; ++r) {
            float o[8];
#pragma unroll
            for (int e = 0; e < 8; ++e) {
                const float zg = bb[0][e] + w[0][0][e] * z[0][r][e] + w[0][1][e] * z[0][r + 1][e] + w[0][2][e] * z[0][r + 2][e];
                const float zv = bb[1][e] + w[1][0][e] * z[1][r][e] + w[1][1][e] * z[1][r + 1][e] + w[1][2][e] * z[1][r + 2][e];
                o[e] = silu(zg) * zv;
            }
            u32x4 wv; wv.x = pk2(o[0], o[1]); wv.y = pk2(o[2], o[3]); wv.z = pk2(o[4], o[5]); wv.w = pk2(o[6], o[7]);
            *(u32x4*)(AC + (size_t)(gi * 64 + r) * DFF + c) = wv;
        }
    }
}

__device__ __forceinline__ void prologue(const Args& a, LAS unsigned char* lds) {
    const int tid = opaque_tid(), lane = tid & 63, wave = tid >> 6;
    if (blockIdx.x == 0) {
        float* LB = (float*)(a.ws + WS_LB);
        for (int c = tid; c < 512; c += 512) {
            const float x0 = a.hg_lb[c], x1 = a.hg_lb[512 + c], x2 = a.hg_lb[1024 + c], x3 = a.hg_lb[1536 + c];
            const float mx = fmaxf(fmaxf(x0, x1), fmaxf(x2, x3));
            const float e0 = __expf(x0 - mx), e1 = __expf(x1 - mx), e2 = __expf(x2 - mx), e3 = __expf(x3 - mx), inv = 1.f / (e0 + e1 + e2 + e3);
            const float p1 = e1 * inv, p2 = e2 * inv, p3 = e3 * inv;
            LB[c] = 0.f; LB[512 + c] = fminf(fmaxf(p1, 0.f), 0.999f); LB[1024 + c] = fminf(fmaxf(p1 + p2, 0.f), 0.999f); LB[1536 + c] = fminf(fmaxf(p1 + p2 + p3, 0.f), 0.999f);
        }
    }
    convert_set(a, lds, 0, 0);
    convert_set(a, lds, 1, 0);
    const int gw = blockIdx.x * 8 + wave, NGW = gridDim.x * 8;
    bf16_t* XN = (bf16_t*)(a.ws + WS_XN); float* ssq = (float*)(a.ws + WS_SSQ);
    for (int m0 = gw; m0 < M; m0 += 4 * NGW) {
        f32x4 v[4][4];
#pragma unroll
        for (int r = 0; r < 4; ++r) { const int m = m0 + r * NGW; if (m < M) { const f32x4* xr = (const f32x4*)(a.x + (size_t)m * D) + lane;
#pragma unroll
            for (int j = 0; j < 4; ++j) v[r][j] = xr[64 * j]; } }
#pragma unroll
        for (int r = 0; r < 4; ++r) { const int m = m0 + r * NGW; if (m < M) {
            u32x2* xnr = (u32x2*)(XN + (size_t)m * D) + lane;
            float s = 0.f;
#pragma unroll
            for (int j = 0; j < 4; ++j) { const f32x4 vv = v[r][j];
                u32x2 o; o.x = pk2(vv.x, vv.y); o.y = pk2(vv.z, vv.w); xnr[64 * j] = o;
                const f32x4 vr = {bf2f(o.x & 0xffffu), bf2f(o.x >> 16), bf2f(o.y & 0xffffu), bf2f(o.y >> 16)}; s += (vr.x * vr.x + vr.y * vr.y) + (vr.z * vr.z + vr.w * vr.w); }
            s = wave_sum(s);
            if (lane < 16) ssq[(size_t)m * 16 + lane] = lane == 0 ? s : 0.f; } }
    }
}
__device__ __forceinline__ void final_norm(const Args& a) {
    const int tid = opaque_tid(), lane = tid & 63, wave = tid >> 6;
    const int gw = blockIdx.x * 8 + wave, NGW = gridDim.x * 8;
    const float* ssq = (const float*)(a.ws + WS_SSQ);
    for (int m0 = gw; m0 < M; m0 += 4 * NGW) {
        float rs[4]; u32x2 xv[4][4];
#pragma unroll
        for (int r = 0; r < 4; ++r) { const int m = m0 + r * NGW; if (m < M) { rs[r] = rowscale(ssq, m);
            const u32x2* xr = (const u32x2*)((const bf16_t*)(a.ws + WS_XN) + (size_t)m * D) + lane;
#pragma unroll
            for (int j = 0; j < 4; ++j) xv[r][j] = xr[64 * j]; } }
#pragma unroll
        for (int r = 0; r < 4; ++r) { const int m = m0 + r * NGW; if (m < M) {
            f32x4* orow = (f32x4*)(a.out + (size_t)m * D) + lane; const f32x4* gr = (const f32x4*)a.final_norm + lane; const float rr = rs[r];
#pragma unroll
            for (int j = 0; j < 4; ++j) { const u32x2 x = xv[r][j]; const f32x4 g = gr[64 * j];
                orow[64 * j] = (f32x4){bf2f(x.x & 0xffffu) * rr * g.x, bf2f(x.x >> 16) * rr * g.y, bf2f(x.y & 0xffffu) * rr * g.z, bf2f(x.y >> 16) * rr * g.w}; } } }
    }
}

#define XB_TMO      128
#define XB_XCNT(j)  (256  + 64 * (j))
#define XB_XSUB(j)  (1280 + 64 * (j))
#define XB_XGEN(j)  (2304 + 64 * (j))
#define XB_TOP      3328
#define XB_TOPGEN   3392
#define XCD_BAR_WORDS 3456
#define XB_SPIN_CAP (1u << 20)

__device__ __forceinline__ unsigned xb_ld(unsigned* p)              { return __hip_atomic_load(p, __ATOMIC_RELAXED, __HIP_MEMORY_SCOPE_AGENT); }
__device__ __forceinline__ unsigned xb_add(unsigned* p, unsigned v) { return __hip_atomic_fetch_add(p, v, __ATOMIC_RELAXED, __HIP_MEMORY_SCOPE_AGENT); }
__device__ __forceinline__ unsigned xb_xcc_id() { return (unsigned)__builtin_amdgcn_s_getreg((3 << 11) | 20) & 0xFu; }
#define XB_SPIN(cond, bar) do { unsigned _sp = 0; while (cond) {   \
    if ((++_sp & 255u) == 0u) { if (xb_ld(&(bar)[XB_TMO])) break; if (_sp > XB_SPIN_CAP) { atomicAdd(&(bar)[XB_TMO], 1u); break; } } } } while (0)

struct XcdBarrier {
    unsigned* bar; unsigned x;
    volatile LAS unsigned* st;
};

__device__ __forceinline__ XcdBarrier xcd_barrier_post(unsigned* bar, volatile LAS unsigned* st) {
    XcdBarrier b; b.bar = bar; b.x = xb_xcc_id(); b.st = st;
    if (threadIdx.x == 0) (void)xb_add(&bar[XB_XCNT(b.x)], 1u);
    return b;
}
__device__ __forceinline__ void xcd_barrier_complete(unsigned* bar, unsigned x, unsigned& nloc, unsigned& nx) {
    const unsigned G = gridDim.x * gridDim.y * gridDim.z;
    unsigned sum, cnt, mine, sp = 0u;
    for (;;) {
        sum = 0u; cnt = 0u; mine = 0u;
#pragma unroll
        for (unsigned j = 0; j < 16; ++j) { const unsigned c = xb_ld(&bar[XB_XCNT(j)]); sum += c; cnt += (c > 0u) ? 1u : 0u; mine = (j == x) ? c : mine; }
        if (sum == G) break;
        __builtin_amdgcn_s_sleep(1);
        if ((++sp & 255u) == 0u) { if (xb_ld(&bar[XB_TMO])) break; if (sp > XB_SPIN_CAP) { atomicAdd(&bar[XB_TMO], 1u); break; } }
    }
    nloc = mine > 0u ? mine : 1u; nx = cnt > 0u ? cnt : 1u;
}

__device__ __forceinline__ void xcd_barrier(const XcdBarrier& b) {
    asm volatile("s_waitcnt vmcnt(0)" ::: "memory");
    __syncthreads();
    if (threadIdx.x == 0) {
        unsigned* bar = b.bar;
        __builtin_amdgcn_s_waitcnt(0);
        unsigned nloc = b.st[0], nx = b.st[1];
        if (nloc == 0u) { xcd_barrier_complete(bar, b.x, nloc, nx); b.st[0] = nloc; b.st[1] = nx; }
        const unsigned old = xb_add(&bar[XB_XSUB(b.x)], 1u);
        const unsigned gen = old / nloc;
        if (old + 1u == (gen + 1u) * nloc) {
            __builtin_amdgcn_fence(__ATOMIC_RELEASE, "agent");
            asm volatile("s_waitcnt vmcnt(0)" ::: "memory");
            const unsigned og = xb_add(&bar[XB_TOP], 1u);
            const unsigned tg = og / nx;
            if (og + 1u == (tg + 1u) * nx) xb_add(&bar[XB_TOPGEN], 1u);
            else XB_SPIN(xb_ld(&bar[XB_TOPGEN]) == tg, bar);
            __builtin_amdgcn_fence(__ATOMIC_ACQUIRE, "agent");
            xb_add(&bar[XB_XGEN(b.x)], 1u);
            asm volatile("s_waitcnt vmcnt(0)" ::: "memory");
        } else {
            XB_SPIN(xb_ld(&bar[XB_XGEN(b.x)]) == gen, bar);
            __builtin_amdgcn_fence(__ATOMIC_ACQUIRE, "agent");
            asm volatile("s_waitcnt vmcnt(0)" ::: "memory");
        }
    }
    __syncthreads();
}

__global__ void __launch_bounds__(512, 2) trunk_fwd(Args a) {
    extern __shared__ __attribute__((aligned(16))) unsigned char lds_raw[];
    LAS unsigned char* lds = (LAS unsigned char*)lds_raw;
    cg::grid_group grid = cg::this_grid();
    if (threadIdx.x < 64) ((LAS unsigned*)(lds + (LDS_BYTES - 256)))[threadIdx.x] = 0u;
    __syncthreads();
    XcdBarrier bar = xcd_barrier_post((unsigned*)a.ws + 4096, (volatile LAS unsigned*)(lds + (LDS_BYTES - 256)));
    unsigned char* ws = a.ws;
    const int G = gridDim.x, bx = blockIdx.x;
    bf16_t* XN; float* ssq;

#ifndef PH
#define PH 0xFFFF
#endif
#ifndef PROBE_MASK
#define PROBE_MASK 0
#endif
    unsigned long long pr_acc = 0, pr_t0 = 0;
#define PR_BEGIN(bit) do { if ((PROBE_MASK) & (bit)) pr_t0 = __builtin_amdgcn_s_memrealtime(); } while (0)
#define PR_END(bit) do { if ((PROBE_MASK) & (bit)) pr_acc += __builtin_amdgcn_s_memrealtime() - pr_t0; } while (0)
    PR_BEGIN(1);
    if (PH & 1) prologue(a, lds);
    if (a.ws == nullptr) grid.sync();
    xcd_barrier(bar);
    PR_END(1);
#define LAUNDER(p) asm volatile("" : "+s"(p))
#pragma unroll 1
    for (int l = 0; l < DEPTH; ++l) {
        PR_BEGIN(2);
#ifndef REP_P1
#define REP_P1 1
#endif
#ifndef REP_P5
#define REP_P5 1
#endif
#pragma unroll 1
        for (int rep = 0; rep < REP_P1; ++rep)
        if (PH & 2) { LAUNDER(ws); XN = (bf16_t*)(ws + WS_XN); ssq = (float*)(ws + WS_SSQ);
            pg8::Gemm g{XN, (const bf16_t*)(ws + WS_WIN), M, INC, D}; pg8::StaticOrder S; S.init(M, INC, G, bx);
            EpiIn E{(bf16_t*)(ws + WS_U), (bf16_t*)(ws + WS_V), (bf16_t*)(ws + WS_Q), (bf16_t*)(ws + WS_KK), (bf16_t*)(ws + WS_I), (bf16_t*)(ws + WS_OG), (bf16_t*)(ws + WS_GT),
                    (float*)(ws + WS_GL), ssq, (const float*)(ws + WS_LB) + l * 512, (float*)(ws + WS_VS), (const LAS float*)(lds + RTAB_OFF), 0};
            fill_rtab(S, ssq, lds);
            pg8::gemm_phase<EpiIn, pg8::StaticOrder, ALIGN_HEAVY, true>(lds, g, S, E);
        }
        xcd_barrier(bar);
        PR_END(2);
        PR_BEGIN(4);
        if (PH & 4) for (int u = bx; u < 8 * HG_NG + 512; u += G) { if (u < 8 * HG_NG) { PR_BEGIN(2048); hg1g_unit(a, lds, u); PR_END(2048); } else { PR_BEGIN(4096); gmlp_unit(a, lds, u - 8 * HG_NG, l); PR_END(4096); } }
        xcd_barrier(bar);
        PR_END(4);
        PR_BEGIN(8);
        if (PH & 8) { hg_gscan(a); }
        xcd_barrier(bar);
        PR_END(8);
        PR_BEGIN(16);
        if (PH & 16) for (int u = bx; u < 8 * HG_NG; u += G) hg3g_unit(a, lds, u, l, pr_acc);
        xcd_barrier(bar);
        PR_END(16);
        PR_BEGIN(32);
        if (PH & 32) { LAUNDER(ws);
            pg8::StaticOrder S; S.init(M, D, G, bx);
            pg8::Gemm g1{(const bf16_t*)(ws + WS_U), (const bf16_t*)(ws + WS_WGM), M, D, 512};
            EpiBr<false> E1{(bf16_t*)(ws + WS_Y), (const bf16_t*)(ws + WS_GT), 0};
            pg8::gemm_phase<EpiBr<false>, pg8::StaticOrder, ALIGN_SINGLE, true>(lds, g1, S, E1);
            pg8::Gemm g2{(const bf16_t*)(ws + WS_OG), (const bf16_t*)(ws + WS_WHG), M, D, 512};
            EpiBr<true> E2{(bf16_t*)(ws + WS_Y), (const bf16_t*)(ws + WS_GT), 1024};
            pg8::gemm_phase<EpiBr<true>, pg8::StaticOrder, ALIGN_SINGLE, true>(lds, g2, S, E2);
        }
        xcd_barrier(bar);
        PR_END(32);
        PR_BEGIN(64);
        if (PH & 64) { LAUNDER(ws); XN = (bf16_t*)(ws + WS_XN); ssq = (float*)(ws + WS_SSQ);
            pg8::Gemm g{(const bf16_t*)(ws + WS_Y), (const bf16_t*)(ws + WS_WOUT), M, D, D}; pg8::StaticOrder S; S.init(M, D, G, bx);
            EpiRes E{XN, (bf16_t*)(ws + WS_XN2), ssq};
            pg8::gemm_phase<EpiRes, pg8::StaticOrder, ALIGN_SINGLE, true>(lds, g, S, E);
        }
        xcd_barrier(bar);
        PR_END(64);
        PR_BEGIN(128);
#pragma unroll 1
        for (int rep = 0; rep < REP_P5; ++rep)
        if (PH & 128) { LAUNDER(ws); XN = (bf16_t*)(ws + WS_XN); ssq = (float*)(ws + WS_SSQ);
            pg8::Gemm g{(const bf16_t*)(ws + WS_XN2), (const bf16_t*)(ws + WS_WUP + (l & 1) * WS_FFNW_STRIDE), M, NUP, D}; pg8::StaticOrder S; S.init(M, NUP, G, bx);
            EpiUp E{(bf16_t*)(ws + WS_AC), (bf16_t*)(ws + WS_Z), ssq, a.conv_w + (size_t)l * 3 * NUP, a.conv_b + (size_t)l * NUP, (LAS float*)(lds + 132096), (const LAS float*)(lds + RTAB_OFF), 0};
            if (l + 1 < DEPTH) { convert_set(a, lds, 0, l + 1, G / 2, G - G / 2); convert_set(a, lds, 1, l + 1, G / 2, G - G / 2); __syncthreads(); }
            fill_rtab(S, ssq, lds);
            pg8::gemm_phase<EpiUp, pg8::StaticOrder, ALIGN_HEAVY, true>(lds, g, S, E);
        }
        xcd_barrier(bar);
        PR_END(128);
        PR_BEGIN(256);
        if (PH & 256) { conv_fixup(a, l); }
        xcd_barrier(bar);
        PR_END(256);
        PR_BEGIN(512);
        if (PH & 512) { LAUNDER(ws); XN = (bf16_t*)(ws + WS_XN); ssq = (float*)(ws + WS_SSQ);
            pg8::Gemm g{(const bf16_t*)(ws + WS_AC), (const bf16_t*)(ws + WS_WDN + (l & 1) * WS_FFNW_STRIDE), M, D, DFF}; pg8::StaticOrder S; S.init(M, D, G, bx);
            EpiRes E{(const bf16_t*)(ws + WS_XN2), XN, ssq};
            pg8::gemm_phase<EpiRes, pg8::StaticOrder, ALIGN_SINGLE, true>(lds, g, S, E);
        }
        xcd_barrier(bar);
        PR_END(512);
    }
    if (PH & 1024) final_norm(a);
    if ((PROBE_MASK) && blockIdx.x == 0) { const unsigned long long te = __builtin_amdgcn_s_memrealtime() + 4 * pr_acc; while (__builtin_amdgcn_s_memrealtime() < te) __builtin_amdgcn_s_sleep(8); }
}

extern "C" void kernel_launch(void* const* d_in, const int* in_sizes, int n_in, void* d_out, int out_size, void* d_ws, size_t ws_size, hipStream_t stream) {
    static int grid = 0;
    if (grid == 0) {
        if (n_in != 18 || out_size != M * D || ws_size < WS_NEED) { fprintf(stderr, "kernel_launch: unexpected shapes (n_in %d, out %d, ws %zu < %zu)\n", n_in, out_size, ws_size, (size_t)WS_NEED); grid = -1; return; }
        int dev = 0, cus = 0, per_cu = 0;
        hipGetDevice(&dev); hipDeviceGetAttribute(&cus, hipDeviceAttributeMultiprocessorCount, dev);
        if (hipFuncSetAttribute((const void*)trunk_fwd, hipFuncAttributeMaxDynamicSharedMemorySize, LDS_BYTES) != hipSuccess) { fprintf(stderr, "kernel_launch: hipFuncSetAttribute failed\n"); grid = -1; return; }
        if (hipOccupancyMaxActiveBlocksPerMultiprocessor(&per_cu, (const void*)trunk_fwd, 512, LDS_BYTES) != hipSuccess || per_cu < 1) { fprintf(stderr, "kernel_launch: occupancy query says %d\n", per_cu); per_cu = 1; }
        (void)hipGetLastError();
        grid = cus * 1;
    }
    if (grid < 0) return;
    if (hipMemsetAsync(d_ws, 0, 65536, stream) != hipSuccess) { fprintf(stderr, "kernel_launch: memset failed\n"); return; }
    Args a{};
    const float** ap = (const float**)&a;
    for (int i = 0; i < 18; ++i) ap[i] = (const float*)d_in[i];
    a.out = (float*)d_out; a.ws = (unsigned char*)d_ws;
    void* args[] = {&a};
    hipError_t e = hipLaunchCooperativeKernel((const void*)trunk_fwd, dim3(grid), dim3(512), args, LDS_BYTES, stream);
    if (e != hipSuccess) fprintf(stderr, "cooperative launch failed: %s (grid %d)\n", hipGetErrorString(e), grid);
}
```

```cpp
#include <hip/hip_runtime.h>
#include <hip/hip_cooperative_groups.h>
#include <cstdio>
#include <cstdint>
namespace cg = cooperative_groups;
namespace pg8 {
#define PG8_LAS __attribute__((address_space(3)))
typedef unsigned short bf16_t;
typedef short bf16x8 __attribute__((ext_vector_type(8)));
typedef float f32x4 __attribute__((ext_vector_type(4)));
typedef unsigned u32x4 __attribute__((ext_vector_type(4)));
constexpr int BM = 256, BK = 64, HALF = 128, HTB = HALF * BK * 2  , STAGE_BYTES = 8 * HTB, NXCD = 8, WGM = 8;

__host__ __device__ __forceinline__ int lds_byte(int r, int c) { const int st = (r >> 4) * 2 + (c >> 5), rr = r & 15, cc = c & 31, ob = rr * 64 + cc * 2; return st * 1024 + (ob ^ (((ob >> 9) & 1) << 5)); }
__host__ __device__ __forceinline__ void stage_rc(int b, int& R, int& C) { const int st = b / 1024, sb = b % 1024, swz = sb ^ (((sb >> 9) & 1) << 5); R = (st >> 1) * 16 + swz / 64; C = (st & 1) * 32 + (swz % 64) / 2; }
__host__ __device__ __forceinline__ int perm32(int rho) { const int n = rho >> 4, i = rho & 15; return 8 * (i >> 2) + 4 * n + (i & 3); }

struct Unit { int pm, pn; };
struct Gemm { const bf16_t* A; const bf16_t* Bt; int M, N, K; };

struct StaticOrder {
    int nM, nN, nwg, G, c;
    __host__ __device__ void init(int M, int N, int G_, int c_) { nM = M / BM; nN = N / BM; nwg = nM * nN; G = G_; c = c_; }
    __host__ __device__ bool next(int i, Unit& u) const {
        const long L = (long)i * G + c; if (L >= nwg) return false;
        int wgid = (int)L; { const int q = nwg / NXCD, r = nwg % NXCD, xcd = wgid % NXCD, off = wgid / NXCD; wgid = (xcd < r ? xcd * (q + 1) : r * (q + 1) + (xcd - r) * q) + off; }
        const int nig = WGM * nN, gid = wgid / nig, fm = gid * WGM, gsz = (nM - fm) < WGM ? (nM - fm) : WGM;
        u.pm = fm + ((wgid % nig) % gsz); u.pn = (wgid % nig) / gsz; return true;
    }
    __device__ __forceinline__ void a_ready(const Unit&) const {}
    __device__ __forceinline__ void done(const Unit&) const {}
};

__device__ __forceinline__ unsigned cvt_pk_bf16(float lo, float hi) { unsigned r; asm volatile("v_cvt_pk_bf16_f32 %0, %1, %2" : "=v"(r) : "v"(lo), "v"(hi)); return r; }
typedef float f32x2 __attribute__((ext_vector_type(2)));
__device__ __forceinline__ f32x2 gelu_pk(f32x2 v) {
    const f32x2 av = __builtin_elementwise_abs(v), d = av * 0.2316418882f + 1.0f;
    f32x2 t; t.x = __builtin_amdgcn_rcpf(d.x); t.y = __builtin_amdgcn_rcpf(d.y);
    f32x2 q = t * 0.5307027145f + (-0.7265760135f); q = q * t + 0.7107068705f; q = q * t + (-0.142248368f); q = q * t + 0.127414796f; q = q * t;
    const f32x2 s = (v * v) * (-0.72134752044f);
    f32x2 e; e.x = __builtin_amdgcn_exp2f(s.x); e.y = __builtin_amdgcn_exp2f(s.y);
    const f32x2 m = v * (q * e), r = v - m;
    f32x2 o; o.x = v.x < 0.f ? m.x : r.x; o.y = v.y < 0.f ? m.y : r.y; return o;
}

template <int ACT  > struct EpiBf16 {
    static constexpr bool PERM = true, AFTER_DRAIN = false; static_assert(ACT == 0 || ACT == 1, "EpiBf16: ACT is 0 (none) or 1 (gelu_pk)");
    bf16_t* O; int ldc; const float* bias; int split_cols; size_t split_stride; float scale0;
    __device__ __forceinline__ void operator()(const f32x4 (&acc)[2][2][4][2], const Unit& u, int wr, int wc, int fr, int fq) const {
        const int row0 = u.pm * BM + wr * 64 + fr; int colt = u.pn * BM; bf16_t* base = O;
        float sc = 1.f; if (split_cols) { const int t = colt / split_cols; base += (size_t)t * split_stride; colt -= t * split_cols; if (t == 0) sc = scale0; }
        const int col0 = colt + wc * 32 + 8 * fq, bcol0 = u.pn * BM + wc * 32 + 8 * fq;
        f32x4 bv[2][2];
#pragma unroll
        for (int bj = 0; bj < 2; ++bj)
#pragma unroll
            for (int n = 0; n < 2; ++n) bv[bj][n] = bias ? *(const f32x4*)(bias + bcol0 + bj * HALF + 4 * n) : (f32x4){0.f, 0.f, 0.f, 0.f};
#pragma unroll
        for (int ai = 0; ai < 2; ++ai)
#pragma unroll
            for (int m = 0; m < 4; ++m) { bf16_t* rowp = base + (size_t)(row0 + ai * HALF + m * 16) * ldc + col0;
#pragma unroll
                for (int bj = 0; bj < 2; ++bj) { f32x4 v0 = acc[ai][bj][m][0] + bv[bj][0], v1 = acc[ai][bj][m][1] + bv[bj][1];
                    if (ACT == 1) { f32x2 a = gelu_pk((f32x2){v0[0], v0[1]}), b = gelu_pk((f32x2){v0[2], v0[3]}), c = gelu_pk((f32x2){v1[0], v1[1]}), d = gelu_pk((f32x2){v1[2], v1[3]});
                        v0 = (f32x4){a.x, a.y, b.x, b.y}; v1 = (f32x4){c.x, c.y, d.x, d.y}; }
                    v0 = v0 * sc; v1 = v1 * sc; u32x4 w; w.x = cvt_pk_bf16(v0[0], v0[1]); w.y = cvt_pk_bf16(v0[2], v0[3]); w.z = cvt_pk_bf16(v1[0], v1[1]); w.w = cvt_pk_bf16(v1[2], v1[3]);
                    *(u32x4*)(rowp + bj * HALF) = w; } }
    }
};
template <class Epi, class Sched, bool ALIGN_EPI = false, bool SP2 = false>
__device__ __forceinline__ void gemm_phase(PG8_LAS unsigned char* lds, const Gemm g, const Sched& S, const Epi& E) {
    int tid_ = threadIdx.x; asm volatile("" : "+v"(tid_)); const int tid = tid_, wid = __builtin_amdgcn_readfirstlane(tid >> 6), lane = tid & 63, wr = wid >> 2, wc = wid & 3, fr = lane & 15, fq = lane >> 4;
    const int K = g.K, nt = K / BK;
    unsigned voffA[2], voffB[2];
#pragma unroll
    for (int i = 0; i < 2; ++i) { int R, C; stage_rc(tid * 16 + i * 8192, R, C); const int Rb = Epi::PERM ? ((R & ~31) + perm32(R & 31)) : R;
        voffA[i] = (unsigned)(R * K + C) * 2u; voffB[i] = (unsigned)(Rb * K + C) * 2u; }
    const size_t kstep = (size_t)(BK * 2);
    const size_t hstep = (size_t)HALF * K * 2;
    const size_t tstep = 2 * hstep;
    const unsigned ldsw = (unsigned)wid * 1024u;
    const int aoff = lds_byte(wr * 64 + fr, fq * 8), boff = lds_byte(wc * 32 + fr, fq * 8);
#define PG8_SA(b, h) (((b) * 2 + (h)) * HTB)
#define PG8_SB(b, h) ((4 + (b) * 2 + (h)) * HTB)
#define PG8_STAGE(bufoff, gbase, voff) do { _Pragma("unroll") for (int _i = 0; _i < 2; ++_i) \
        __builtin_amdgcn_global_load_lds((const unsigned*)((const char*)(gbase) + (voff)[_i]), (PG8_LAS unsigned*)(lds + (bufoff) + ldsw + _i * 8192), 16, 0, 0); } while (0)
#define PG8_LDA(dst, b, h) do { _Pragma("unroll") for (int m = 0; m < 4; ++m) _Pragma("unroll") for (int k = 0; k < 2; ++k) dst[m][k] = *(const PG8_LAS bf16x8*)(lds + PG8_SA(b, h) + aoff + m * 2048 + k * 1024); } while (0)
#define PG8_LDB(dst, b, h) do { _Pragma("unroll") for (int n = 0; n < 2; ++n) _Pragma("unroll") for (int k = 0; k < 2; ++k) dst[n][k] = *(const PG8_LAS bf16x8*)(lds + PG8_SB(b, h) + boff + n * 2048 + k * 1024); } while (0)
#define PG8_MMA(ai, bj, At, Bt) do { __builtin_amdgcn_s_setprio(1); _Pragma("unroll") for (int m = 0; m < 4; ++m) _Pragma("unroll") for (int n = 0; n < 2; ++n) _Pragma("unroll") for (int k = 0; k < 2; ++k) \
        acc[ai][bj][m][n] = __builtin_amdgcn_mfma_f32_16x16x32_bf16(Bt[n][k], At[m][k], acc[ai][bj][m][n], 0, 0, 0); __builtin_amdgcn_s_setprio(0); } while (0)
#define PG8_WAIT_V(n) asm volatile("s_waitcnt vmcnt(" #n ")" ::: "memory")
#define PG8_WAIT_L(n) asm volatile("s_waitcnt lgkmcnt(" #n ")" ::: "memory")
#define PG8_BAR __builtin_amdgcn_s_barrier()
#define PG8_SCHED __builtin_amdgcn_sched_barrier(0)
    Unit cur, nxt; int ui = 0;
    if (!S.next(0, cur)) return;
    f32x4 acc[2][2][4][2];
#pragma unroll
    for (int a = 0; a < 2; ++a)
#pragma unroll
        for (int b = 0; b < 2; ++b)
#pragma unroll
            for (int m = 0; m < 4; ++m)
#pragma unroll
                for (int n = 0; n < 2; ++n) acc[a][b][m][n] = (f32x4){0.f, 0.f, 0.f, 0.f};
    bf16x8 At[4][2], B0[2][2], B1[2][2];
    const char* cA = (const char*)g.A + (size_t)cur.pm * tstep; const char* cB = (const char*)g.Bt + (size_t)cur.pn * tstep;
    S.a_ready(cur);
    if constexpr (SP2) {
        PG8_STAGE(PG8_SB(0, 0), cB, voffB); PG8_STAGE(PG8_SB(0, 1), cB + hstep, voffB); PG8_STAGE(PG8_SA(0, 0), cA, voffA); PG8_STAGE(PG8_SA(0, 1), cA + hstep, voffA);
        if (wr == 1) PG8_BAR;
        PG8_WAIT_V(2); PG8_BAR;
        PG8_STAGE(PG8_SB(1, 0), cB + kstep, voffB); PG8_STAGE(PG8_SA(1, 0), cA + kstep, voffA); PG8_STAGE(PG8_SB(1, 1), cB + hstep + kstep, voffB);
        PG8_WAIT_V(6); PG8_BAR;
    } else {
        PG8_STAGE(PG8_SB(0, 0), cB, voffB); PG8_STAGE(PG8_SA(0, 0), cA, voffA); PG8_STAGE(PG8_SB(0, 1), cB + hstep, voffB); PG8_STAGE(PG8_SA(0, 1), cA + hstep, voffA);
        if (wr == 1) PG8_BAR;
        PG8_WAIT_V(4); PG8_BAR;
        PG8_STAGE(PG8_SB(1, 0), cB + kstep, voffB); PG8_STAGE(PG8_SA(1, 0), cA + kstep, voffA); PG8_STAGE(PG8_SB(1, 1), cB + hstep + kstep, voffB);
        PG8_WAIT_V(6); PG8_BAR;
    }
    for (;;) {
        const bool has_next = S.next(ui + 1, nxt);
        const char* nA = has_next ? (const char*)g.A + (size_t)nxt.pm * tstep : cA; const char* nB = has_next ? (const char*)g.Bt + (size_t)nxt.pn * tstep : cB;
        for (int t = 0; t < nt; t += 2) {
            const bool last = (t == nt - 2);
            const char* a1 = cA + (size_t)(t + 1) * kstep;
            const char* a2 = last ? nA : cA + (size_t)(t + 2) * kstep; const char* b2 = last ? nB : cB + (size_t)(t + 2) * kstep;
            const char* a3 = a2 + kstep; const char* b3 = b2 + kstep;
            if (last && has_next) S.a_ready(nxt);
            if constexpr (SP2) {
            PG8_LDB(B0, 0, 0); PG8_LDB(B1, 0, 1); PG8_SCHED; PG8_LDA(At, 0, 0); PG8_STAGE(PG8_SA(1, 1), a1 + hstep, voffA);
            PG8_WAIT_V(8); PG8_WAIT_L(0); PG8_BAR; PG8_MMA(0, 0, At, B0); PG8_MMA(0, 1, At, B1); PG8_BAR; PG8_SCHED;
            PG8_LDA(At, 0, 1); PG8_STAGE(PG8_SB(0, 0), b2, voffB); PG8_STAGE(PG8_SB(0, 1), b2 + hstep, voffB); PG8_STAGE(PG8_SA(0, 0), a2, voffA);
            PG8_WAIT_V(8); PG8_WAIT_L(0); PG8_BAR; PG8_MMA(1, 0, At, B0); PG8_MMA(1, 1, At, B1); PG8_BAR; PG8_SCHED;
            PG8_LDB(B0, 1, 0); PG8_LDB(B1, 1, 1); PG8_SCHED; PG8_LDA(At, 1, 0); PG8_STAGE(PG8_SA(0, 1), a2 + hstep, voffA);
            PG8_WAIT_V(8); PG8_WAIT_L(0); PG8_BAR; PG8_MMA(0, 0, At, B0); PG8_MMA(0, 1, At, B1); PG8_BAR; PG8_SCHED;
            PG8_LDA(At, 1, 1); PG8_STAGE(PG8_SB(1, 0), b3, voffB); PG8_STAGE(PG8_SB(1, 1), b3 + hstep, voffB); PG8_STAGE(PG8_SA(1, 0), a3, voffA);
            PG8_WAIT_V(8); PG8_WAIT_L(0); PG8_BAR; PG8_MMA(1, 0, At, B0); PG8_MMA(1, 1, At, B1); PG8_BAR; PG8_SCHED;
            } else {
            PG8_LDB(B0, 0, 0); PG8_SCHED; PG8_LDA(At, 0, 0); PG8_STAGE(PG8_SA(1, 1), a1 + hstep, voffA);
            PG8_WAIT_L(8); PG8_BAR; PG8_WAIT_L(0); PG8_MMA(0, 0, At, B0); PG8_BAR; PG8_SCHED;
            PG8_LDB(B1, 0, 1); PG8_STAGE(PG8_SB(0, 0), b2, voffB);
            PG8_BAR; PG8_WAIT_L(0); PG8_MMA(0, 1, At, B1); PG8_BAR;
            PG8_LDA(At, 0, 1); PG8_STAGE(PG8_SA(0, 0), a2, voffA);
            PG8_BAR; PG8_WAIT_L(0); PG8_MMA(1, 0, At, B0); PG8_BAR; PG8_SCHED;
            PG8_STAGE(PG8_SB(0, 1), b2 + hstep, voffB);
            PG8_WAIT_V(6); PG8_BAR; PG8_MMA(1, 1, At, B1); PG8_BAR;
            PG8_LDB(B0, 1, 0); PG8_SCHED; PG8_LDA(At, 1, 0); PG8_STAGE(PG8_SA(0, 1), a2 + hstep, voffA);
            PG8_WAIT_L(8); PG8_BAR; PG8_WAIT_L(0); PG8_MMA(0, 0, At, B0); PG8_BAR; PG8_SCHED;
            PG8_LDB(B1, 1, 1); PG8_STAGE(PG8_SB(1, 0), b3, voffB);
            PG8_BAR; PG8_WAIT_L(0); PG8_MMA(0, 1, At, B1); PG8_BAR;
            PG8_LDA(At, 1, 1); PG8_STAGE(PG8_SA(1, 0), a3, voffA);
            PG8_BAR; PG8_WAIT_L(0); PG8_MMA(1, 0, At, B0); PG8_BAR; PG8_SCHED;
            PG8_STAGE(PG8_SB(1, 1), b3 + hstep, voffB);
            PG8_WAIT_V(6); PG8_BAR; PG8_MMA(1, 1, At, B1); PG8_BAR;
            }
        }
        if constexpr (ALIGN_EPI) { if (wr == 0) PG8_BAR; }
        if constexpr (!Epi::AFTER_DRAIN) { E(acc, cur, wr, wc, fr, fq); S.done(cur); }
        if (!has_next) break;
#pragma unroll
        for (int a = 0; a < 2; ++a)
#pragma unroll
            for (int b = 0; b < 2; ++b)
#pragma unroll
                for (int m = 0; m < 4; ++m)
#pragma unroll
                    for (int n = 0; n < 2; ++n) acc[a][b][m][n] = (f32x4){0.f, 0.f, 0.f, 0.f};
        cur = nxt; cA = nA; cB = nB; ++ui;
        if constexpr (ALIGN_EPI) { if (wr == 1) PG8_BAR; }
    }
    PG8_WAIT_V(0);
    if constexpr (!ALIGN_EPI) { if (wr == 0) PG8_BAR; }
    PG8_BAR;
    if constexpr (Epi::AFTER_DRAIN) { E.fused(acc, cur, wr, wc, fr, fq, lds, wid, lane); S.done(cur); }
#undef PG8_SA
#undef PG8_SB
#undef PG8_STAGE
#undef PG8_LDA
#undef PG8_LDB
#undef PG8_MMA
#undef PG8_WAIT_V
#undef PG8_WAIT_L
#undef PG8_BAR
#undef PG8_SCHED
}
}
#define LAS __attribute__((address_space(3)))
__device__ __forceinline__ int opaque_tid() { int t = threadIdx.x; asm volatile("" : "+v"(t)); return t; }
using pg8::bf16_t; using pg8::bf16x8; using pg8::f32x4; using pg8::u32x4; using pg8::Unit;
typedef float f32x2 __attribute__((ext_vector_type(2)));
typedef unsigned u32x2 __attribute__((ext_vector_type(2)));

constexpr int NB = 2, SEQ = 8192, M = NB * SEQ, D = 1024, DEPTH = 4, INC = 5120, DFF = 2816, NUP = 2 * DFF;
constexpr float EPS = 1e-6f, LOG2E = 1.4426950408889634f;
constexpr size_t MiB = 1u << 20;
constexpr size_t WS_LB = 1 * MiB, WS_SSQ = 2 * MiB, WS_DEC = 3 * MiB;
constexpr size_t WS_WIN = 4 * MiB, WS_WGM = 14 * MiB, WS_WHG = 15 * MiB, WS_WOUT = 16 * MiB, WS_WUP = 18 * MiB, WS_WDN = 29 * MiB;
constexpr size_t WS_XN = 36 * MiB, WS_ACT0 = 68 * MiB, WS_VS = 35 * MiB;
constexpr size_t WS_U = WS_ACT0, WS_V = WS_U + 16 * MiB, WS_Q = WS_V + 16 * MiB, WS_KK = WS_Q + 16 * MiB, WS_GL = WS_KK + 16 * MiB, WS_I = WS_GL + 32 * MiB,
                 WS_OG = WS_I + 16 * MiB, WS_GT = WS_OG + 16 * MiB, WS_ST = WS_GT + 64 * MiB, WS_END1 = WS_ST + 64 * MiB;
constexpr size_t WS_XN2 = WS_I;
constexpr size_t WS_Y = WS_Q;
constexpr size_t WS_Z = WS_ACT0, WS_AC = WS_Z + 176 * MiB, WS_END2 = WS_AC + 88 * MiB;
constexpr size_t WS_FFNW2 = WS_END2, WS_FFNW_STRIDE = WS_FFNW2 - WS_WUP;
constexpr size_t WS_NEED = WS_FFNW2 + 17 * MiB;
constexpr int LDS_BYTES = 147456;

#ifndef PROBE_MASK
#define PROBE_MASK 0
#endif
#ifndef ALIGN_SINGLE
#define ALIGN_SINGLE true
#endif
#ifndef ALIGN_HEAVY
#define ALIGN_HEAVY true
#endif
struct Args {
    const float *x, *mix_norm, *w_in, *gm_ln_g, *gm_ln_b, *gm_ws, *gm_bs, *hg_lb, *hg_norm_g, *w_br_gm, *w_br_hg, *w_out, *ffn_norm, *w_up, *conv_w, *conv_b, *w_down, *final_norm;
    float* out; unsigned char* ws;
};

__device__ __forceinline__ float bf2f(unsigned h) { return __uint_as_float(h << 16); }
__device__ __forceinline__ unsigned f2bf(float f) { unsigned u = __float_as_uint(f); return (u + 0x7fffu + ((u >> 16) & 1u)) >> 16; }
__device__ __forceinline__ unsigned pk2(float lo, float hi) { return pg8::cvt_pk_bf16(lo, hi); }
__device__ __forceinline__ float fexp2(float x) { return __builtin_amdgcn_exp2f(x); }
__device__ __forceinline__ float frcp(float x) { return __builtin_amdgcn_rcpf(x); }
__device__ __forceinline__ float sigm(float x) { return frcp(1.f + fexp2(-LOG2E * x)); }
__device__ __forceinline__ float silu(float x) { return x * sigm(x); }
__device__ __forceinline__ float wave_sum(float v) {
#pragma unroll
    for (int o = 1; o < 64; o <<= 1) v += __shfl_xor(v, o);
    return v;
}
__device__ __forceinline__ void unpack8(const u32x4 r, float (&x)[8]) {
    x[0] = bf2f(r.x & 0xffffu); x[1] = bf2f(r.x >> 16); x[2] = bf2f(r.y & 0xffffu); x[3] = bf2f(r.y >> 16);
    x[4] = bf2f(r.z & 0xffffu); x[5] = bf2f(r.z >> 16); x[6] = bf2f(r.w & 0xffffu); x[7] = bf2f(r.w >> 16);
}
__device__ __forceinline__ float rowscale(const float* ssq, int row) {
    const f32x4* p = (const f32x4*)(ssq + (size_t)row * 16); const f32x4 s = (p[0] + p[1]) + (p[2] + p[3]);
    return rsqrtf(((s.x + s.y) + (s.z + s.w)) * (1.f / 1024.f) + EPS);
}

constexpr int RTAB_OFF = 140288, RT_UNITS = 6;
template <class Sched> __device__ __forceinline__ void fill_rtab(const Sched& S, const float* ssq, LAS unsigned char* lds) {
    const int tid = opaque_tid(); LAS float* tab = (LAS float*)(lds + RTAB_OFF);
    float r[RT_UNITS]; bool ok[RT_UNITS];
#pragma unroll
    for (int i = 0; i < RT_UNITS; ++i) { Unit u; ok[i] = S.next(i, u); r[i] = (ok[i] && tid < 256) ? rowscale(ssq, u.pm * 256 + tid) : 0.f; }
#pragma unroll
    for (int i = 0; i < RT_UNITS; ++i) if (ok[i] && tid < 256) tab[i * 256 + tid] = r[i];
    __syncthreads();
}
struct EpiIn {
    static constexpr bool PERM = true, AFTER_DRAIN = false;
    bf16_t *U, *V, *Q, *KK, *I, *OG, *GT; float* GL; const float* ssq; const float* lb; float* VS; const LAS float* rtab; mutable int k;
    template <int SEG> __device__ __forceinline__ void body(const f32x4 (&acc)[2][2][4][2], const Unit& u, int wr, int wc, int fr, int fq) const {
        const int row0 = u.pm * 256 + wr * 64 + fr, pn = u.pn;
        bf16_t* base; int ldc, colt;
        if (SEG == 6) { base = GT; ldc = 2048; colt = (pn - 12) * 256; }
        else { ldc = 512; colt = (pn & 1) * 256; base = SEG == 0 ? U : SEG == 1 ? V : SEG == 2 ? Q : SEG == 3 ? KK : SEG == 4 ? I : OG; }
        const int col0 = colt + wc * 32 + 8 * fq;
        f32x4 lbq[2][2];
        if (SEG == 3) {
#pragma unroll
            for (int bj = 0; bj < 2; ++bj) { lbq[bj][0] = *(const f32x4*)(lb + col0 + bj * 128); lbq[bj][1] = *(const f32x4*)(lb + col0 + bj * 128 + 4); }
        }
#pragma unroll
        for (int ai = 0; ai < 2; ++ai)
#pragma unroll
            for (int m = 0; m < 4; ++m) {
                const int row = row0 + ai * 128 + m * 16; const float r = k < RT_UNITS ? rtab[k * 256 + ai * 128 + wr * 64 + m * 16 + fr] : rowscale(ssq, row);
                float st1 = 0.f, st2 = 0.f;
#pragma unroll
                for (int bj = 0; bj < 2; ++bj) {
                    const int c = col0 + bj * 128;
                    f32x4 v0 = acc[ai][bj][m][0] * r, v1 = acc[ai][bj][m][1] * r;
                    float o[8] = {v0[0], v0[1], v0[2], v0[3], v1[0], v1[1], v1[2], v1[3]};
                    if (SEG == 0 || SEG == 1) {
#pragma unroll
                        for (int e = 0; e < 8; e += 2) { f32x2 g = pg8::gelu_pk((f32x2){o[e], o[e + 1]}); o[e] = g.x; o[e + 1] = g.y; }
                        if (SEG == 1) {
#pragma unroll
                            for (int e = 0; e < 8; ++e) { st1 += o[e]; st2 += o[e] * o[e]; }
                        }
                    } else if (SEG == 2 || SEG == 5) {
#pragma unroll
                        for (int e = 0; e < 8; ++e) o[e] = silu(o[e]);
                    } else if (SEG == 6) {
#pragma unroll
                        for (int e = 0; e < 8; ++e) o[e] = sigm(o[e]);
                    } else if (SEG == 3) {
                        const f32x4 l0 = lbq[bj][0], l1 = lbq[bj][1];
                        const float lbv[8] = {l0[0], l0[1], l0[2], l0[3], l1[0], l1[1], l1[2], l1[3]};
                        float g2[8];
#pragma unroll
                        for (int e = 0; e < 8; ++e) {
                            const float f = fminf(fmaxf(o[e], -80.f), 80.f);
                            const float ex = fexp2(-LOG2E * f), sg = frcp(1.f + ex);
                            const float fg = lbv[e] + (1.f - lbv[e]) * sg;
                            g2[e] = __builtin_amdgcn_logf(fmaxf(fg, 1e-30f));
                            o[e] = (1.f - lbv[e]) * (ex * sg);
                        }
                        float* gp = GL + (size_t)row * 512 + c;
                        *(f32x4*)gp = (f32x4){g2[0], g2[1], g2[2], g2[3]}; *(f32x4*)(gp + 4) = (f32x4){g2[4], g2[5], g2[6], g2[7]};
                    }
                    u32x4 w; w.x = pk2(o[0], o[1]); w.y = pk2(o[2], o[3]); w.z = pk2(o[4], o[5]); w.w = pk2(o[6], o[7]);
                    *(u32x4*)(base + (size_t)row * ldc + c) = w;
                }
                if (SEG == 1) {
                    st1 += __shfl_xor(st1, 16); st1 += __shfl_xor(st1, 32); st2 += __shfl_xor(st2, 16); st2 += __shfl_xor(st2, 32);
                    if (fq == 0) *(f32x2*)(VS + (size_t)row * 16 + ((pn & 1) * 4 + wc) * 2) = (f32x2){st1, st2};
                }
                asm volatile("" ::: "memory");
            }
    }
    __device__ __forceinline__ void operator()(const f32x4 (&acc)[2][2][4][2], const Unit& u, int wr, int wc, int fr, int fq) const {
        const int seg = u.pn < 12 ? (u.pn >> 1) : 6;
        switch (seg) {
            case 0: body<0>(acc, u, wr, wc, fr, fq); break;
            case 1: body<1>(acc, u, wr, wc, fr, fq); break;
            case 2: body<2>(acc, u, wr, wc, fr, fq); break;
            case 3: body<3>(acc, u, wr, wc, fr, fq); break;
            case 4: body<4>(acc, u, wr, wc, fr, fq); break;
            case 5: body<5>(acc, u, wr, wc, fr, fq); break;
            default: body<6>(acc, u, wr, wc, fr, fq); break;
        }
        ++k;
    }
};
template <bool ADD> struct EpiBr {
    static constexpr bool PERM = true, AFTER_DRAIN = false;
    bf16_t* Y; const bf16_t* GT; int goff;
    __device__ __forceinline__ void operator()(const f32x4 (&acc)[2][2][4][2], const Unit& u, int wr, int wc, int fr, int fq) const {
        const int row0 = u.pm * 256 + wr * 64 + fr, col0 = u.pn * 256 + wc * 32 + 8 * fq;
        u32x4 gc[2], gn[2], yc[2], yn[2];
#pragma unroll
        for (int bj = 0; bj < 2; ++bj) { gc[bj] = *(const u32x4*)(GT + (size_t)row0 * 2048 + goff + col0 + bj * 128); if (ADD) yc[bj] = *(const u32x4*)(Y + (size_t)row0 * 1024 + col0 + bj * 128); }
#pragma unroll
        for (int gI = 0; gI < 8; ++gI) {
            const int ai = gI >> 2, m = gI & 3, row = row0 + ai * 128 + m * 16;
            if (gI < 7) { const int rn = row0 + ((gI + 1) >> 2) * 128 + ((gI + 1) & 3) * 16;
#pragma unroll
                for (int bj = 0; bj < 2; ++bj) { gn[bj] = *(const u32x4*)(GT + (size_t)rn * 2048 + goff + col0 + bj * 128); if (ADD) yn[bj] = *(const u32x4*)(Y + (size_t)rn * 1024 + col0 + bj * 128); } }
#pragma unroll
            for (int bj = 0; bj < 2; ++bj) {
                const int c = col0 + bj * 128;
                float g[8]; unpack8(gc[bj], g);
                const f32x4 v0 = acc[ai][bj][m][0], v1 = acc[ai][bj][m][1];
                float o[8] = {v0[0] * g[0], v0[1] * g[1], v0[2] * g[2], v0[3] * g[3], v1[0] * g[4], v1[1] * g[5], v1[2] * g[6], v1[3] * g[7]};
                if (ADD) { float y[8]; unpack8(yc[bj], y);
#pragma unroll
                    for (int e = 0; e < 8; ++e) o[e] += y[e]; }
                u32x4 w; w.x = pk2(o[0], o[1]); w.y = pk2(o[2], o[3]); w.z = pk2(o[4], o[5]); w.w = pk2(o[6], o[7]);
                *(u32x4*)(Y + (size_t)row * 1024 + c) = w;
            }
#pragma unroll
            for (int bj = 0; bj < 2; ++bj) { gc[bj] = gn[bj]; if (ADD) yc[bj] = yn[bj]; }
            asm volatile("" ::: "memory");
        }
    }
};
struct EpiRes {
    static constexpr bool PERM = true, AFTER_DRAIN = false;
    const bf16_t* xs; bf16_t* xb; float* ssq;
    __device__ __forceinline__ void operator()(const f32x4 (&acc)[2][2][4][2], const Unit& u, int wr, int wc, int fr, int fq) const {
        const int row0 = u.pm * 256 + wr * 64 + fr, col0 = u.pn * 256 + wc * 32 + 8 * fq;
        u32x4 cur[2], nxt[2];
#pragma unroll
        for (int bj = 0; bj < 2; ++bj) cur[bj] = *(const u32x4*)(xs + (size_t)row0 * 1024 + col0 + bj * 128);
#pragma unroll
        for (int gI = 0; gI < 8; ++gI) {
            const int ai = gI >> 2, m = gI & 3, row = row0 + ai * 128 + m * 16;
            if (gI < 7) { const int rn = row0 + ((gI + 1) >> 2) * 128 + ((gI + 1) & 3) * 16;
#pragma unroll
                for (int bj = 0; bj < 2; ++bj) nxt[bj] = *(const u32x4*)(xs + (size_t)rn * 1024 + col0 + bj * 128); }
            float ss = 0.f;
#pragma unroll
            for (int bj = 0; bj < 2; ++bj) {
                float x[8]; unpack8(cur[bj], x);
                const f32x4 v0 = acc[ai][bj][m][0], v1 = acc[ai][bj][m][1];
                u32x4 w; w.x = pk2(x[0] + v0[0], x[1] + v0[1]); w.y = pk2(x[2] + v0[2], x[3] + v0[3]); w.z = pk2(x[4] + v1[0], x[5] + v1[1]); w.w = pk2(x[6] + v1[2], x[7] + v1[3]);
                *(u32x4*)(xb + (size_t)row * 1024 + col0 + bj * 128) = w;
                float y[8]; unpack8(w, y);
#pragma unroll
                for (int e = 0; e < 8; ++e) ss += y[e] * y[e];
            }
            ss += __shfl_xor(ss, 16); ss += __shfl_xor(ss, 32);
            if (fq == 0) ssq[(size_t)row * 16 + u.pn * 4 + wc] = ss;
#pragma unroll
            for (int bj = 0; bj < 2; ++bj) cur[bj] = nxt[bj];
            asm volatile("" ::: "memory");
        }
    }
};
__device__ __forceinline__ float dpp_ror1(float v) { return __int_as_float(__builtin_amdgcn_update_dpp(__float_as_int(v), __float_as_int(v), 0x121, 0xf, 0xf, false)); }
__device__ __forceinline__ float dpp_ror2(float v) { return __int_as_float(__builtin_amdgcn_update_dpp(__float_as_int(v), __float_as_int(v), 0x122, 0xf, 0xf, false)); }
struct EpiUp {
    static constexpr bool PERM = true, AFTER_DRAIN = false;
    bf16_t* AC; bf16_t* H; const float* ssq; const float* cw; const float* cb; LAS float* wl; const LAS float* rtab; mutable int k;
    __device__ __forceinline__ void operator()(const f32x4 (&acc)[2][2][4][2], const Unit& u, int wr, int wc, int fr, int fq) const {
        const int rowb = u.pm * 256 + wr * 64 + fr, cl = u.pn * 128 + wc * 32 + 8 * fq;
        LAS float* wv = wl + (wr * 4 + wc) * 256;
        {
            const int lane = fq * 16 + fr, kind = lane >> 3, c4 = (lane & 7) * 4, cg = u.pn * 128 + wc * 32 + c4 + (kind >= 4 ? DFF : 0), kk = kind & 3;
            const f32x4 v = *(const f32x4*)((kk == 3 ? cb : cw + kk * NUP) + cg);
            *(LAS f32x4*)(wv + kind * 32 + c4) = v;
            asm volatile("s_waitcnt lgkmcnt(0)" ::: "memory");
        }
#pragma unroll
        for (int n = 0; n < 2; ++n) {
            const int c = cl + 4 * n; const LAS float* wp = wv + 8 * fq + 4 * n;
#pragma unroll
            for (int ai = 0; ai < 2; ++ai) {
                f32x4 pg1 = {0.f, 0.f, 0.f, 0.f}, pg2 = pg1, pv1 = pg1, pv2 = pg1;
#pragma unroll
                for (int m = 0; m < 4; ++m) {
                    const int row = rowb + ai * 128 + m * 16; const float r = k < RT_UNITS ? rtab[k * 256 + ai * 128 + wr * 64 + m * 16 + fr] : rowscale(ssq, row);
                    const f32x4 zg = acc[ai][0][m][n] * r, zv = acc[ai][1][m][n] * r;
                    f32x4 ag1, ag2, av1, av2, g1, g2, v1, v2;
#pragma unroll
                    for (int j = 0; j < 4; ++j) {
                        ag1[j] = dpp_ror1(zg[j]); ag2[j] = dpp_ror2(zg[j]); av1[j] = dpp_ror1(zv[j]); av2[j] = dpp_ror2(zv[j]);
                        g1[j] = fr >= 1 ? ag1[j] : pg1[j]; g2[j] = fr >= 2 ? ag2[j] : pg2[j];
                        v1[j] = fr >= 1 ? av1[j] : pv1[j]; v2[j] = fr >= 2 ? av2[j] : pv2[j];
                    }
                    const f32x4 zcg = *(const LAS f32x4*)(wp + 96) + *(const LAS f32x4*)(wp) * g2 + *(const LAS f32x4*)(wp + 32) * g1 + *(const LAS f32x4*)(wp + 64) * zg;
                    const f32x4 zcv = *(const LAS f32x4*)(wp + 224) + *(const LAS f32x4*)(wp + 128) * v2 + *(const LAS f32x4*)(wp + 160) * v1 + *(const LAS f32x4*)(wp + 192) * zv;
                    u32x2 o; o.x = pk2(silu(zcg[0]) * zcv[0], silu(zcg[1]) * zcv[1]); o.y = pk2(silu(zcg[2]) * zcv[2], silu(zcg[3]) * zcv[3]);
                    if (m != 0 || fr >= 2) *(u32x2*)(AC + (size_t)row * DFF + c) = o;
                    if ((m == 0 && fr < 2) || (m == 3 && fr >= 14)) {
                        const int slot = m == 0 ? fr : fr - 12;
                        bf16_t* hp = H + ((size_t)(row >> 6) * 4 + slot) * NUP + c;
                        u32x2 hg; hg.x = pk2(zg[0], zg[1]); hg.y = pk2(zg[2], zg[3]); *(u32x2*)hp = hg;
                        u32x2 hv; hv.x = pk2(zv[0], zv[1]); hv.y = pk2(zv[2], zv[3]); *(u32x2*)(hp + DFF) = hv;
                    }
                    pg1 = ag1; pg2 = ag2; pv1 = av1; pv2 = av2;
                    asm volatile("" ::: "memory"); __builtin_amdgcn_sched_barrier(0);
                }
            }
        }
        ++k;
    }
};

template <bool UPMAP = false> __device__ __forceinline__ void transpose_item(const float* W, int K, int N, bf16_t* WT, LAS float* scr, int item, int lane, const float* gk = nullptr) {
    const int nblk = N / 32, kb = item / nblk, nb = item % nblk, k0 = 64 * kb, n0 = 32 * nb;
    const int r0 = !UPMAP ? n0 : (n0 < DFF ? (n0 >> 7) * 256 + (n0 & 127) : ((n0 - DFF) >> 7) * 256 + 128 + ((n0 - DFF) & 127));
    f32x4 wv[8];
#pragma unroll
    for (int i = 0; i < 8; ++i) wv[i] = *(const f32x4*)(W + (size_t)(k0 + 8 * i + (lane >> 3)) * N + n0 + (lane & 7) * 4);
#pragma unroll
    for (int i = 0; i < 8; ++i) { const int kk = 8 * i + (lane >> 3); const float gsc = gk ? gk[k0 + kk] : 1.f; LAS float* sp = scr + kk * 33 + (lane & 7) * 4;
        sp[0] = wv[i][0] * gsc; sp[1] = wv[i][1] * gsc; sp[2] = wv[i][2] * gsc; sp[3] = wv[i][3] * gsc; }
    asm volatile("s_waitcnt lgkmcnt(0)" ::: "memory");
    const int c = lane & 7;
#pragma unroll
    for (int j = 0; j < 4; ++j) { const int n = (lane >> 3) + 8 * j; const LAS float* s = scr + (8 * c) * 33 + n;
        u32x4 o; o.x = pk2(s[0 * 33], s[1 * 33]); o.y = pk2(s[2 * 33], s[3 * 33]); o.z = pk2(s[4 * 33], s[5 * 33]); o.w = pk2(s[6 * 33], s[7 * 33]);
        *(u32x4*)(WT + (size_t)(r0 + n) * K + k0 + 8 * c) = o; }
    asm volatile("s_waitcnt lgkmcnt(0)" ::: "memory");
}
__device__ __forceinline__ void convert_set(const Args& a, LAS unsigned char* lds, int set, int l, int first_block = 0, int n_blocks = 0) {
    const int tid = opaque_tid(), lane = tid & 63, wave = tid >> 6;
    LAS float* scr = (LAS float*)(lds + wave * 16384);
    if (n_blocks == 0) n_blocks = gridDim.x;
    if ((int)blockIdx.x < first_block || (int)blockIdx.x >= first_block + n_blocks) return;
    const int gw = ((int)blockIdx.x - first_block) * 8 + wave, NGW = n_blocks * 8;
    unsigned char* ws = a.ws;
    if (set == 0) {
        constexpr int I0 = (D / 64) * (INC / 32), I1 = (512 / 64) * (D / 32), I3 = (D / 64) * (D / 32), NI = I0 + 2 * I1 + I3;
        for (int it = gw; it < NI; it += NGW) {
            int r = it;
            if (r < I0) { transpose_item(a.w_in + (size_t)l * D * INC, D, INC, (bf16_t*)(ws + WS_WIN), scr, r, lane, a.mix_norm + l * D); continue; } r -= I0;
            if (r < I1) { transpose_item(a.w_br_gm + (size_t)l * 512 * D, 512, D, (bf16_t*)(ws + WS_WGM), scr, r, lane); continue; } r -= I1;
            if (r < I1) { transpose_item(a.w_br_hg + (size_t)l * 512 * D, 512, D, (bf16_t*)(ws + WS_WHG), scr, r, lane); continue; } r -= I1;
            transpose_item(a.w_out + (size_t)l * D * D, D, D, (bf16_t*)(ws + WS_WOUT), scr, r, lane);
        }
    } else {
        constexpr int I0 = (D / 64) * (NUP / 32), I1 = (DFF / 64) * (D / 32), NI = I0 + I1;
        for (int it = gw; it < NI; it += NGW) {
            int r = it;
            if (r < I0) { transpose_item<true>(a.w_up + (size_t)l * D * NUP, D, NUP, (bf16_t*)(ws + WS_WUP + (l & 1) * WS_FFNW_STRIDE), scr, r, lane, a.ffn_norm + l * D); continue; } r -= I0;
            transpose_item(a.w_down + (size_t)l * DFF * D, DFF, D, (bf16_t*)(ws + WS_WDN + (l & 1) * WS_FFNW_STRIDE), scr, r, lane);
        }
    }
}

#define LDS_BARRIER() asm volatile("s_waitcnt lgkmcnt(0)\n\ts_barrier" ::: "memory")
constexpr int LDQ = 136, LDV = 72, LDG = 132;
__device__ __forceinline__ bf16x8 ldfrag(const LAS bf16_t* base, int ld, int fr, int fq, int k0) { return *(const LAS bf16x8*)(base + fr * ld + k0 + fq * 8); }
#define MMA16(xf, yf, acc) __builtin_amdgcn_mfma_f32_16x16x32_bf16((xf), (yf), (acc), 0, 0, 0)

__device__ __forceinline__ void gmlp_unit(const Args& a, LAS unsigned char* lds, int unit, int l, bool load_w) {
    const int tid = opaque_tid(), lane = tid & 63, w = tid >> 6, fr = lane & 15, fq = lane >> 4;
    const int h = unit & 3, blk = (unit >> 2) & 63, b = unit >> 8;
    const size_t r0 = (size_t)b * SEQ + (size_t)blk * 128;
    LAS bf16_t* Vt = (LAS bf16_t*)lds;
    LAS bf16_t* Wl = Vt + 128 * LDQ;
    LAS f32x2* stat = (LAS f32x2*)(Wl + 128 * LDQ);
    const bf16_t* Vg = (const bf16_t*)(a.ws + WS_V); bf16_t* Ug = (bf16_t*)(a.ws + WS_U);
    const float* lng = a.gm_ln_g + l * 512; const float* lnb = a.gm_ln_b + l * 512;
    const float* wsrc = a.gm_ws + (size_t)(l * 4 + h) * 16384;
    u32x4 vraw[4]; f32x4 wreg[8];
#pragma unroll
    for (int it = 0; it < 4; ++it) vraw[it] = *(const u32x4*)(Vg + (r0 + (it & 1) * 64 + lane) * 512 + h * 128 + ((it >> 1) * 8 + w) * 8);
#pragma unroll
    for (int it = 0; it < 8; ++it) { const int idx = it * 512 + tid; wreg[it] = load_w ? *(const f32x4*)(wsrc + (idx >> 5) * 128 + (idx & 31) * 4) : (f32x4){0.f, 0.f, 0.f, 0.f}; }
    f32x4 lg[2][2], lb2[2][2];
#pragma unroll
    for (int q = 0; q < 2; ++q) { const int cg0 = h * 128 + (q * 8 + w) * 8; lg[q][0] = *(const f32x4*)(lng + cg0); lg[q][1] = *(const f32x4*)(lng + cg0 + 4); lb2[q][0] = *(const f32x4*)(lnb + cg0); lb2[q][1] = *(const f32x4*)(lnb + cg0 + 4); }
    if (tid < 128) {
        const f32x4* vp = (const f32x4*)((const float*)(a.ws + WS_VS) + (r0 + tid) * 16);
        const f32x4 p0 = vp[0], p1 = vp[1], p2 = vp[2], p3 = vp[3];
        const float s1 = ((p0[0] + p0[2]) + (p1[0] + p1[2])) + ((p2[0] + p2[2]) + (p3[0] + p3[2])), s2 = ((p0[1] + p0[3]) + (p1[1] + p1[3])) + ((p2[1] + p2[3]) + (p3[1] + p3[3]));
        const float mean = s1 * (1.f / 512.f), var = fmaxf(s2 * (1.f / 512.f) - mean * mean, 0.f);
        stat[tid] = (f32x2){mean, rsqrtf(var + EPS)};
    }
    if (load_w)
#pragma unroll
    for (int it = 0; it < 8; ++it) {
        const int idx = it * 512 + tid, i = idx >> 5, j4 = (idx & 31) * 4;
        f32x4 wv = wreg[it];
        if ((i >> 6) < (j4 >> 6)) wv = (f32x4){0.f, 0.f, 0.f, 0.f};
        u32x2 o; o.x = pk2(wv[0], wv[1]); o.y = pk2(wv[2], wv[3]);
        *(LAS u32x2*)(Wl + i * LDQ + j4) = o;
    }
    LDS_BARRIER();
#pragma unroll
    for (int it = 0; it < 4; ++it) {
        const int j = (it & 1) * 64 + lane, d0 = ((it >> 1) * 8 + w) * 8;
        const f32x2 st = stat[j];
        float x[8]; unpack8(vraw[it], x);
#pragma unroll
        for (int e = 0; e < 8; ++e) Vt[(d0 + e) * LDQ + j] = (bf16_t)f2bf((x[e] - st.x) * st.y * lg[it >> 1][e >> 2][e & 3] + lb2[it >> 1][e >> 2][e & 3]);
    }
    LDS_BARRIER();
    bf16x8 af[4];
#pragma unroll
    for (int ks = 0; ks < 4; ++ks) af[ks] = ldfrag(Wl + (w * 16) * LDQ, LDQ, fr, fq, ks * 32);
    const int i = w * 16 + fr; const float bias = a.gm_bs[(l * 4 + h) * 128 + i];
    u32x2 ureg[8];
#pragma unroll
    for (int dt = 0; dt < 8; ++dt) ureg[dt] = *(const u32x2*)(Ug + (r0 + i) * 512 + h * 128 + dt * 16 + 4 * fq);
#pragma unroll
    for (int dt = 0; dt < 8; ++dt) {
        f32x4 acc = {0.f, 0.f, 0.f, 0.f};
#pragma unroll
        for (int ks = 0; ks < 4; ++ks) if (ks < 2 || w >= 4) acc = MMA16(ldfrag(Vt + (dt * 16) * LDQ, LDQ, fr, fq, ks * 32), af[ks], acc);
        bf16_t* up = Ug + (r0 + i) * 512 + h * 128 + dt * 16 + 4 * fq;
        const u32x2 uu = ureg[dt];
        u32x2 o; o.x = pk2(bf2f(uu.x & 0xffffu) * (acc[0] + bias), bf2f(uu.x >> 16) * (acc[1] + bias));
        o.y = pk2(bf2f(uu.y & 0xffffu) * (acc[2] + bias), bf2f(uu.y >> 16) * (acc[3] + bias));
        *(u32x2*)up = o;
    }
    LDS_BARRIER();
}

__device__ __forceinline__ void hg1_unit(const Args& a, LAS unsigned char* lds, int unit) {
    const int tid = opaque_tid(), lane = tid & 63, w = tid >> 6, fr = lane & 15, fq = lane >> 4;
    const int c = unit & 127, bh = unit >> 7, h = bh & 3, b = bh >> 2;
    const size_t r0 = (size_t)b * SEQ + (size_t)c * 64;
    LAS float* Gs = (LAS float*)lds;
    LAS float* Tot = Gs + 64 * LDG;
    LAS bf16_t* Vt = (LAS bf16_t*)(lds + 64 * LDG * 4 + 2048);
    LAS bf16_t* Kt = Vt + 128 * LDV;
    float* GLg = (float*)(a.ws + WS_GL); const bf16_t* Ig = (const bf16_t*)(a.ws + WS_I); const bf16_t* Kg = (const bf16_t*)(a.ws + WS_KK);
    const int d = tid & 127, sg = tid >> 7;
    float* gp = GLg + (r0 + sg * 16) * 512 + h * 128 + d;
    float g[16];
#pragma unroll
    for (int j = 0; j < 16; ++j) g[j] = gp[(size_t)j * 512];
#pragma unroll
    for (int j = 1; j < 16; ++j) g[j] += g[j - 1];
    Tot[sg * 128 + d] = g[15];
    u32x4 kraw[2], vraw[2];
#pragma unroll
    for (int it = 0; it < 2; ++it) { const int idx = it * 512 + tid; const size_t go = (r0 + (idx >> 4)) * 512 + h * 128 + (idx & 15) * 8; vraw[it] = *(const u32x4*)(Ig + go); kraw[it] = *(const u32x4*)(Kg + go); }
#pragma unroll
    for (int it = 0; it < 2; ++it) {
        const int idx = it * 512 + tid, j = idx >> 4, e0 = (idx & 15) * 8;
        const u32x4 raw = vraw[it];
        const unsigned rw[4] = {raw.x, raw.y, raw.z, raw.w};
#pragma unroll
        for (int e = 0; e < 8; ++e) Vt[(e0 + e) * LDV + j] = (bf16_t)((rw[e >> 1] >> ((e & 1) * 16)) & 0xffffu);
    }
    LDS_BARRIER();
    float off = 0.f;
#pragma unroll
    for (int s = 0; s < 3; ++s) off += (s < sg) ? Tot[s * 128 + d] : 0.f;
#pragma unroll
    for (int j = 0; j < 16; ++j) { g[j] += off; gp[(size_t)j * 512] = g[j]; Gs[(sg * 16 + j) * LDG + d] = g[j]; }
    LDS_BARRIER();
#pragma unroll
    for (int it = 0; it < 2; ++it) {
        const int idx = it * 512 + tid, j = idx >> 4, d0 = (idx & 15) * 8;
        float kv[8]; unpack8(kraw[it], kv);
#pragma unroll
        for (int e = 0; e < 8; ++e) Kt[(d0 + e) * LDV + j] = (bf16_t)f2bf(kv[e] * fexp2(Gs[63 * LDG + d0 + e] - Gs[j * LDG + d0 + e]));
    }
    if (tid < 128) ((float*)(a.ws + WS_DEC))[(size_t)unit * 128 + tid] = fexp2(Gs[63 * LDG + tid]);
    LDS_BARRIER();
    bf16x8 af[2];
#pragma unroll
    for (int ks = 0; ks < 2; ++ks) af[ks] = ldfrag(Vt + (w * 16) * LDV, LDV, fr, fq, ks * 32);
    float* STg = (float*)(a.ws + WS_ST) + (size_t)unit * 16384;
#pragma unroll
    for (int dt = 0; dt < 8; ++dt) {
        f32x4 acc = {0.f, 0.f, 0.f, 0.f};
#pragma unroll
        for (int ks = 0; ks < 2; ++ks) acc = MMA16(ldfrag(Kt + (dt * 16) * LDV, LDV, fr, fq, ks * 32), af[ks], acc);
        *(f32x4*)(STg + (w * 16 + fr) * 128 + dt * 16 + 4 * fq) = acc;
    }
    LDS_BARRIER();
}

__device__ __forceinline__ void hg_scan(const Args& a) {
    float* ST = (float*)(a.ws + WS_ST); const float* DEC = (const float*)(a.ws + WS_DEC);
    for (int idx = blockIdx.x * 512 + opaque_tid(); idx < 8 * 8192; idx += gridDim.x * 512) {
        const int bh = idx >> 13, ed = (idx & 8191) * 2, d = ed & 127;
        float* p = ST + (size_t)bh * 128 * 16384 + ed; const float* dc = DEC + (size_t)bh * 128 * 128 + d;
        f32x2 S = {0.f, 0.f};
#pragma unroll 32
        for (int c = 0; c < 128; ++c) { const f32x2 u = *(const f32x2*)(p + (size_t)c * 16384); const f32x2 dec = *(const f32x2*)(dc + c * 128); *(f32x2*)(p + (size_t)c * 16384) = S; S = dec * S + u; }
    }
}

__device__ __forceinline__ void hg3_unit(const Args& a, LAS unsigned char* lds, int unit, int l) {
    const int tid = opaque_tid(), lane = tid & 63, w = tid >> 6, fr = lane & 15, fq = lane >> 4;
    const int c = unit & 127, bh = unit >> 7, h = bh & 3, b = bh >> 2;
    const size_t r0 = (size_t)b * SEQ + (size_t)c * 64;
    LAS bf16_t* Qh = (LAS bf16_t*)lds;
    LAS bf16_t* Qt = Qh + 64 * LDQ;
    LAS bf16_t* Kh = Qt + 64 * LDQ;
    LAS bf16_t* Vt = Kh + 160 * LDQ;
    LAS bf16_t* As = Vt + 128 * LDV;
    LAS bf16_t* Sts = Kh;
    LAS float* Os = (LAS float*)Qh;
    const float* GLg = (const float*)(a.ws + WS_GL); const bf16_t* Ig = (const bf16_t*)(a.ws + WS_I);
    const bf16_t* Qg = (const bf16_t*)(a.ws + WS_Q); const bf16_t* Kg = (const bf16_t*)(a.ws + WS_KK);
    const float* STg = (const float*)(a.ws + WS_ST) + (size_t)unit * 16384;
    f32x4 sreg[8]; unsigned ogreg[8];
    bf16_t* OGg = (bf16_t*)(a.ws + WS_OG);
#pragma unroll
    for (int it = 0; it < 8; ++it) { const int idx = it * 512 + tid; sreg[it] = *(const f32x4*)(STg + (idx >> 5) * 128 + (idx & 31) * 4); }
#pragma unroll
    for (int rr = 0; rr < 8; ++rr) ogreg[rr] = *(const unsigned*)(OGg + (r0 + w * 8 + rr) * 512 + h * 128 + 2 * lane);
#pragma unroll
    for (int it = 0; it < 2; ++it) {
        const int idx = it * 512 + tid, j = idx >> 4, d0 = (idx & 15) * 8;
        const int J = __builtin_amdgcn_readfirstlane(j >> 4);
        const size_t go = (r0 + j) * 512 + h * 128 + d0;
        float qv[8], kv[8]; unpack8(*(const u32x4*)(Qg + go), qv); unpack8(*(const u32x4*)(Kg + go), kv);
        const f32x4 ga = *(const f32x4*)(GLg + go), gb = *(const f32x4*)(GLg + go + 4);
        const float gj[8] = {ga[0], ga[1], ga[2], ga[3], gb[0], gb[1], gb[2], gb[3]};
        const u32x4 raw = *(const u32x4*)(Ig + go);
        {
            u32x4 o; o.x = pk2(qv[0] * fexp2(gj[0]), qv[1] * fexp2(gj[1])); o.y = pk2(qv[2] * fexp2(gj[2]), qv[3] * fexp2(gj[3]));
            o.z = pk2(qv[4] * fexp2(gj[4]), qv[5] * fexp2(gj[5])); o.w = pk2(qv[6] * fexp2(gj[6]), qv[7] * fexp2(gj[7]));
            *(LAS u32x4*)(Qt + j * LDQ + d0) = o;
        }
#pragma unroll
        for (int I = 0; I < 4; ++I) {
            if (I >= J) {
                const size_t ro = (r0 + 16 * I) * 512 + h * 128 + d0;
                const f32x4 ra = *(const f32x4*)(GLg + ro), rb = *(const f32x4*)(GLg + ro + 4);
                const float rf[8] = {ra[0], ra[1], ra[2], ra[3], rb[0], rb[1], rb[2], rb[3]};
                float kh[8];
#pragma unroll
                for (int e = 0; e < 8; ++e) kh[e] = kv[e] * fexp2(fminf(rf[e] - gj[e], 120.f));
                u32x4 o; o.x = pk2(kh[0], kh[1]); o.y = pk2(kh[2], kh[3]); o.z = pk2(kh[4], kh[5]); o.w = pk2(kh[6], kh[7]);
                *(LAS u32x4*)(Kh + (8 * I * (I + 1) + j) * LDQ + d0) = o;
                if (I == J) {
                    u32x4 q; q.x = pk2(qv[0] * fexp2(gj[0] - rf[0]), qv[1] * fexp2(gj[1] - rf[1])); q.y = pk2(qv[2] * fexp2(gj[2] - rf[2]), qv[3] * fexp2(gj[3] - rf[3]));
                    q.z = pk2(qv[4] * fexp2(gj[4] - rf[4]), qv[5] * fexp2(gj[5] - rf[5])); q.w = pk2(qv[6] * fexp2(gj[6] - rf[6]), qv[7] * fexp2(gj[7] - rf[7]));
                    *(LAS u32x4*)(Qh + j * LDQ + d0) = q;
                }
            }
        }
        const unsigned rw[4] = {raw.x, raw.y, raw.z, raw.w};
#pragma unroll
        for (int e = 0; e < 8; ++e) Vt[(d0 + e) * LDV + j] = (bf16_t)((rw[e >> 1] >> ((e & 1) * 16)) & 0xffffu);
    }
    for (int idx = tid; idx < 64 * LDV / 8; idx += 512) *(LAS u32x4*)(As + idx * 8) = (u32x4){0u, 0u, 0u, 0u};
    LDS_BARRIER();
#pragma unroll 1
    for (int t = w; t < 10; t += 8) {
        const int I = t >= 6 ? 3 : t >= 3 ? 2 : t >= 1 ? 1 : 0, J = t - (I * (I + 1)) / 2;
        f32x4 acc = {0.f, 0.f, 0.f, 0.f};
#pragma unroll
        for (int ks = 0; ks < 4; ++ks) acc = MMA16(ldfrag(Kh + (8 * I * (I + 1) + 16 * J) * LDQ, LDQ, fr, fq, ks * 32), ldfrag(Qh + (16 * I) * LDQ, LDQ, fr, fq, ks * 32), acc);
        if (I == J) {
#pragma unroll
            for (int r = 0; r < 4; ++r) acc[r] = (4 * fq + r <= fr) ? acc[r] : 0.f;
        }
        u32x2 o; o.x = pk2(acc[0], acc[1]); o.y = pk2(acc[2], acc[3]);
        *(LAS u32x2*)(As + (16 * I + fr) * LDV + 16 * J + 4 * fq) = o;
    }
    LDS_BARRIER();
#pragma unroll
    for (int it = 0; it < 8; ++it) {
        const int idx = it * 512 + tid, e = idx >> 5, d4 = (idx & 31) * 4;
        const f32x4 sv = sreg[it];
        u32x2 o; o.x = pk2(sv[0], sv[1]); o.y = pk2(sv[2], sv[3]);
        *(LAS u32x2*)(Sts + e * LDQ + d4) = o;
    }
    LDS_BARRIER();
    {
        const int it = w & 3, eb = (w >> 2) * 4;
        bf16x8 af[2], qf[4];
#pragma unroll
        for (int ks = 0; ks < 2; ++ks) af[ks] = ldfrag(As + (it * 16) * LDV, LDV, fr, fq, ks * 32);
#pragma unroll
        for (int ks = 0; ks < 4; ++ks) qf[ks] = ldfrag(Qt + (it * 16) * LDQ, LDQ, fr, fq, ks * 32);
        LDS_BARRIER();
#pragma unroll
        for (int t = 0; t < 4; ++t) {
            const int et = eb + t; f32x4 acc = {0.f, 0.f, 0.f, 0.f};
#pragma unroll
            for (int ks = 0; ks < 2; ++ks) acc = MMA16(ldfrag(Vt + (et * 16) * LDV, LDV, fr, fq, ks * 32), af[ks], acc);
#pragma unroll
            for (int ks = 0; ks < 4; ++ks) acc = MMA16(ldfrag(Sts + (et * 16) * LDQ, LDQ, fr, fq, ks * 32), qf[ks], acc);
            *(LAS f32x4*)(Os + (it * 16 + fr) * LDG + et * 16 + 4 * fq) = acc;
        }
    }
    LDS_BARRIER();
    {
        const f32x2 ng = *(const f32x2*)(a.hg_norm_g + l * 128 + 2 * lane);
#pragma unroll
        for (int rr = 0; rr < 8; ++rr) {
            const int i = w * 8 + rr;
            const f32x2 o = *(const LAS f32x2*)(Os + i * LDG + 2 * lane);
            const float r = rsqrtf(wave_sum(o.x * o.x + o.y * o.y) * (1.f / 128.f) + EPS);
            unsigned* op = (unsigned*)(OGg + (r0 + i) * 512 + h * 128 + 2 * lane);
            const unsigned og = ogreg[rr];
            *op = pk2(o.x * r * ng.x * bf2f(og & 0xffffu), o.y * r * ng.y * bf2f(og >> 16));
        }
    }
    LDS_BARRIER();
}

constexpr int HG_GC = 4, HG_NG = (SEQ / 64) / HG_GC;
__device__ __forceinline__ void hg1g_unit(const Args& a, LAS unsigned char* lds, int unit) {
    const int tid = opaque_tid(), lane = tid & 63, w = tid >> 6, fr = lane & 15, fq = lane >> 4;
    const int cg = unit % HG_NG, bh = unit / HG_NG, h = bh & 3, b = bh >> 2;
    LAS float* Gs = (LAS float*)lds;
    LAS float* Tot = Gs + 64 * LDG;
    LAS bf16_t* Vt = (LAS bf16_t*)(lds + 64 * LDG * 4 + 2048);
    LAS bf16_t* Kt = Vt + 128 * LDV;
    float* GLg = (float*)(a.ws + WS_GL); const bf16_t* Ig = (const bf16_t*)(a.ws + WS_I); const bf16_t* Kg = (const bf16_t*)(a.ws + WS_KK);
    const int d = tid & 127, sg = tid >> 7;
    f32x4 acc[8];
#pragma unroll
    for (int dt = 0; dt < 8; ++dt) acc[dt] = (f32x4){0.f, 0.f, 0.f, 0.f};
    float dsum = 0.f;
#pragma unroll 1
    for (int s = 0; s < HG_GC; ++s) {
        const size_t r0 = (size_t)b * SEQ + (size_t)(cg * HG_GC + s) * 64;
        float* gp = GLg + (r0 + sg * 16) * 512 + h * 128 + d;
        float g[16];
#pragma unroll
        for (int j = 0; j < 16; ++j) g[j] = gp[(size_t)j * 512];
        u32x4 kraw[2], vraw[2];
#pragma unroll
        for (int it = 0; it < 2; ++it) { const size_t go = (r0 + lane) * 512 + h * 128 + (it * 8 + w) * 8; vraw[it] = *(const u32x4*)(Ig + go); kraw[it] = *(const u32x4*)(Kg + go); }
#pragma unroll
        for (int j = 1; j < 16; ++j) g[j] += g[j - 1];
        Tot[sg * 128 + d] = g[15];
#pragma unroll
        for (int it = 0; it < 2; ++it) {
            const int j = lane, e0 = (it * 8 + w) * 8;
            const unsigned rw[4] = {vraw[it].x, vraw[it].y, vraw[it].z, vraw[it].w};
#pragma unroll
            for (int e = 0; e < 8; ++e) Vt[(e0 + e) * LDV + j] = (bf16_t)((rw[e >> 1] >> ((e & 1) * 16)) & 0xffffu);
        }
        LDS_BARRIER();
        float off = 0.f;
#pragma unroll
        for (int q = 0; q < 3; ++q) off += (q < sg) ? Tot[q * 128 + d] : 0.f;
#pragma unroll
        for (int j = 0; j < 16; ++j) { g[j] += off; gp[(size_t)j * 512] = g[j]; Gs[(sg * 16 + j) * LDG + d] = g[j]; }
        LDS_BARRIER();
#pragma unroll
        for (int it = 0; it < 2; ++it) {
            const int j = lane, d0 = (it * 8 + w) * 8;
            float kv[8]; unpack8(kraw[it], kv);
            const f32x4 la = *(const LAS f32x4*)(Gs + 63 * LDG + d0), lb = *(const LAS f32x4*)(Gs + 63 * LDG + d0 + 4), ja = *(const LAS f32x4*)(Gs + j * LDG + d0), jb = *(const LAS f32x4*)(Gs + j * LDG + d0 + 4);
            const float dl[8] = {la[0] - ja[0], la[1] - ja[1], la[2] - ja[2], la[3] - ja[3], lb[0] - jb[0], lb[1] - jb[1], lb[2] - jb[2], lb[3] - jb[3]};
#pragma unroll
            for (int e = 0; e < 8; ++e) Kt[(d0 + e) * LDV + j] = (bf16_t)f2bf(kv[e] * fexp2(dl[e]));
        }
        if (tid < 128) { const float g63 = Gs[63 * LDG + tid]; dsum += g63; Tot[tid] = fexp2(g63); }
        LDS_BARRIER();
        bf16x8 af[2];
#pragma unroll
        for (int ks = 0; ks < 2; ++ks) af[ks] = ldfrag(Vt + (w * 16) * LDV, LDV, fr, fq, ks * 32);
#pragma unroll
        for (int dt = 0; dt < 8; ++dt) {
            acc[dt] = acc[dt] * *(const LAS f32x4*)(Tot + dt * 16 + 4 * fq);
#pragma unroll
            for (int ks = 0; ks < 2; ++ks) acc[dt] = MMA16(ldfrag(Kt + (dt * 16) * LDV, LDV, fr, fq, ks * 32), af[ks], acc[dt]);
        }
        LDS_BARRIER();
    }
    float* TGg = (float*)(a.ws + WS_ST) + (size_t)unit * 16384;
#pragma unroll
    for (int dt = 0; dt < 8; ++dt) *(f32x4*)(TGg + (w * 16 + fr) * 128 + dt * 16 + 4 * fq) = acc[dt];
    if (tid < 128) ((float*)(a.ws + WS_DEC))[(size_t)unit * 128 + tid] = fexp2(dsum);
}
__device__ __forceinline__ void hg_gscan(const Args& a) {
    const float* TG = (const float*)(a.ws + WS_ST); float* SG = (float*)(a.ws + WS_ST + 16 * MiB); const float* DG = (const float*)(a.ws + WS_DEC);
    for (int idx = blockIdx.x * 512 + opaque_tid(); idx < 8 * 16384; idx += gridDim.x * 512) {
        const int bh = idx >> 14, ed = idx & 16383, d = ed & 127;
        const float* p = TG + (size_t)bh * HG_NG * 16384 + ed; float* q = SG + (size_t)bh * HG_NG * 16384 + ed; const float* dc = DG + (size_t)bh * HG_NG * 128 + d;
        float S = 0.f;
#pragma unroll
        for (int c = 0; c < HG_NG; ++c) { const float u = p[(size_t)c * 16384]; const float dec = dc[c * 128]; q[(size_t)c * 16384] = S; S = dec * S + u; }
    }
}
__device__ __forceinline__ void hg3g_unit(const Args& a, LAS unsigned char* lds, int unit, int l, unsigned long long& pr_acc) {
    unsigned long long pt0 = 0;
#define HP_B(bit) do { if ((PROBE_MASK) & (bit)) pt0 = __builtin_amdgcn_s_memrealtime(); } while (0)
#define HP_E(bit) do { if ((PROBE_MASK) & (bit)) pr_acc += __builtin_amdgcn_s_memrealtime() - pt0; } while (0)
    const int tid = opaque_tid(), lane = tid & 63, w = tid >> 6, fr = lane & 15, fq = lane >> 4;
    const int cg = unit % HG_NG, bh = unit / HG_NG, h = bh & 3, b = bh >> 2;
    LAS bf16_t* Qh = (LAS bf16_t*)lds;
    LAS bf16_t* Qt = Qh + 64 * LDQ;
    LAS bf16_t* Kh = Qt + 64 * LDQ;
    LAS bf16_t* Vt = Kh + 160 * LDQ;
    LAS bf16_t* As = Vt + 128 * LDV;
    LAS bf16_t* Sts = As + 64 * LDV;
    LAS float* Os = (LAS float*)Qh;
    LAS bf16_t* Kt = Kh; LAS float* DecL = (LAS float*)(Kh + 128 * LDV);
    const float* GLg = (const float*)(a.ws + WS_GL); const bf16_t* Ig = (const bf16_t*)(a.ws + WS_I);
    const bf16_t* Qg = (const bf16_t*)(a.ws + WS_Q); const bf16_t* Kg = (const bf16_t*)(a.ws + WS_KK);
    bf16_t* OGg = (bf16_t*)(a.ws + WS_OG);
    f32x4 acc[8];
    {
        const float* TGg = (const float*)(a.ws + WS_ST + 16 * MiB) + (size_t)unit * 16384;
#pragma unroll
        for (int dt = 0; dt < 8; ++dt) acc[dt] = *(const f32x4*)(TGg + (w * 16 + fr) * 128 + dt * 16 + 4 * fq);
#pragma unroll
        for (int dt = 0; dt < 8; ++dt) { u32x2 o; o.x = pk2(acc[dt][0], acc[dt][1]); o.y = pk2(acc[dt][2], acc[dt][3]); *(LAS u32x2*)(Sts + (w * 16 + fr) * LDQ + dt * 16 + 4 * fq) = o; }
    }
    u32x4 nq[2], nk[2], nv[2]; f32x4 nga[2], ngb[2]; float ng63 = 0.f;
#define HG3_LOADS(R0) do { _Pragma("unroll") for (int it_ = 0; it_ < 2; ++it_) { const size_t go_ = ((R0) + 16 * ((it_ * 8 + w) >> 2) + (lane & 15)) * 512 + h * 128 + (((it_ * 8 + w) & 3) * 4 + (lane >> 4)) * 8; \
        nq[it_] = *(const u32x4*)(Qg + go_); nk[it_] = *(const u32x4*)(Kg + go_); nv[it_] = *(const u32x4*)(Ig + go_); nga[it_] = *(const f32x4*)(GLg + go_); ngb[it_] = *(const f32x4*)(GLg + go_ + 4); \
        } \
        if (tid < 128) ng63 = GLg[((R0) + 63) * 512 + h * 128 + tid]; } while (0)
    { const size_t rr0 = (size_t)b * SEQ + (size_t)(cg * HG_GC) * 64; HG3_LOADS(rr0); }
#pragma unroll 1
    for (int s = 0; s < HG_GC; ++s) {
        const size_t r0 = (size_t)b * SEQ + (size_t)(cg * HG_GC + s) * 64;
        HP_B(0x10000);
        unsigned ogreg[8]; u32x4 ktp[2]; u32x4 cq[2], ck[2], cv[2]; f32x4 cga[2], cgb[2];
        const float g63s = ng63;
        { const u32x4* ogp = (const u32x4*)(OGg + (r0 + w * 8 + (lane >> 3)) * 512 + h * 128 + (lane & 7) * 16); const u32x4 o0 = ogp[0], o1 = ogp[1];
          ogreg[0] = o0.x; ogreg[1] = o0.y; ogreg[2] = o0.z; ogreg[3] = o0.w; ogreg[4] = o1.x; ogreg[5] = o1.y; ogreg[6] = o1.z; ogreg[7] = o1.w; }
#pragma unroll
        for (int it = 0; it < 2; ++it) { cq[it] = nq[it]; ck[it] = nk[it]; cv[it] = nv[it]; cga[it] = nga[it]; cgb[it] = ngb[it]; }
        if (s + 1 < HG_GC) { const size_t rn = r0 + 64; HG3_LOADS(rn); }
#pragma unroll
        for (int it = 0; it < 2; ++it) {
            const int J = (it * 8 + w) >> 2, j = 16 * J + (lane & 15), d0 = (((it * 8 + w) & 3) * 4 + (lane >> 4)) * 8;
            float qv[8], kv[8]; unpack8(cq[it], qv); unpack8(ck[it], kv);
            const f32x4 ga = cga[it], gb = cgb[it];
            const float gj[8] = {ga[0], ga[1], ga[2], ga[3], gb[0], gb[1], gb[2], gb[3]};
            const u32x4 raw = cv[it];
            {
                const size_t lo = (r0 + 63) * 512 + h * 128 + d0;
                const f32x4 la = *(const f32x4*)(GLg + lo), lb = *(const f32x4*)(GLg + lo + 4);
                const float gl[8] = {la[0], la[1], la[2], la[3], lb[0], lb[1], lb[2], lb[3]};
                u32x4 o; o.x = pk2(kv[0] * fexp2(gl[0] - gj[0]), kv[1] * fexp2(gl[1] - gj[1])); o.y = pk2(kv[2] * fexp2(gl[2] - gj[2]), kv[3] * fexp2(gl[3] - gj[3]));
                o.z = pk2(kv[4] * fexp2(gl[4] - gj[4]), kv[5] * fexp2(gl[5] - gj[5])); o.w = pk2(kv[6] * fexp2(gl[6] - gj[6]), kv[7] * fexp2(gl[7] - gj[7]));
                ktp[it] = o;
            }
            {
                u32x4 o; o.x = pk2(qv[0] * fexp2(gj[0]), qv[1] * fexp2(gj[1])); o.y = pk2(qv[2] * fexp2(gj[2]), qv[3] * fexp2(gj[3]));
                o.z = pk2(qv[4] * fexp2(gj[4]), qv[5] * fexp2(gj[5])); o.w = pk2(qv[6] * fexp2(gj[6]), qv[7] * fexp2(gj[7]));
                *(LAS u32x4*)(Qt + j * LDQ + d0) = o;
            }
            {
                const size_t ro = (r0 + 16 * J) * 512 + h * 128 + d0;
                const f32x4 ra = *(const f32x4*)(GLg + ro), rb = *(const f32x4*)(GLg + ro + 4);
                const float rf[8] = {ra[0], ra[1], ra[2], ra[3], rb[0], rb[1], rb[2], rb[3]};
                u32x4 q; q.x = pk2(qv[0] * fexp2(gj[0] - rf[0]), qv[1] * fexp2(gj[1] - rf[1])); q.y = pk2(qv[2] * fexp2(gj[2] - rf[2]), qv[3] * fexp2(gj[3] - rf[3]));
                q.z = pk2(qv[4] * fexp2(gj[4] - rf[4]), qv[5] * fexp2(gj[5] - rf[5])); q.w = pk2(qv[6] * fexp2(gj[6] - rf[6]), qv[7] * fexp2(gj[7] - rf[7]));
                *(LAS u32x4*)(Qh + j * LDQ + d0) = q;
            }
#pragma unroll
            for (int I = 0; I < 4; ++I) if (I >= J) {
                const size_t ro = (r0 + 16 * I) * 512 + h * 128 + d0;
                const f32x4 ra = *(const f32x4*)(GLg + ro), rb = *(const f32x4*)(GLg + ro + 4);
                const float rf[8] = {ra[0], ra[1], ra[2], ra[3], rb[0], rb[1], rb[2], rb[3]};
                float kh[8];
#pragma unroll
                for (int e = 0; e < 8; ++e) kh[e] = kv[e] * fexp2(fminf(rf[e] - gj[e], 120.f));
                u32x4 o; o.x = pk2(kh[0], kh[1]); o.y = pk2(kh[2], kh[3]); o.z = pk2(kh[4], kh[5]); o.w = pk2(kh[6], kh[7]);
                *(LAS u32x4*)(Kh + (8 * I * (I + 1) + j) * LDQ + d0) = o;
            }
            const unsigned rw[4] = {raw.x, raw.y, raw.z, raw.w};
#pragma unroll
            for (int e = 0; e < 8; ++e) Vt[(d0 + e) * LDV + j] = (bf16_t)((rw[e >> 1] >> ((e & 1) * 16)) & 0xffffu);
        }
        for (int idx = tid; idx < 64 * LDV / 8; idx += 512) *(LAS u32x4*)(As + idx * 8) = (u32x4){0u, 0u, 0u, 0u};
        LDS_BARRIER();
        HP_E(0x10000); HP_B(0x20000);
#pragma unroll 1
        for (int t = w; t < 10; t += 8) {
            const int I = t >= 6 ? 3 : t >= 3 ? 2 : t >= 1 ? 1 : 0, J = t - (I * (I + 1)) / 2;
            f32x4 sc = {0.f, 0.f, 0.f, 0.f};
#pragma unroll
            for (int ks = 0; ks < 4; ++ks) sc = MMA16(ldfrag(Kh + (8 * I * (I + 1) + 16 * J) * LDQ, LDQ, fr, fq, ks * 32), ldfrag(Qh + (16 * I) * LDQ, LDQ, fr, fq, ks * 32), sc);
            if (I == J) {
#pragma unroll
                for (int r = 0; r < 4; ++r) sc[r] = (4 * fq + r <= fr) ? sc[r] : 0.f;
            }
            u32x2 o; o.x = pk2(sc[0], sc[1]); o.y = pk2(sc[2], sc[3]);
            *(LAS u32x2*)(As + (16 * I + fr) * LDV + 16 * J + 4 * fq) = o;
        }
        LDS_BARRIER();
        HP_E(0x20000); HP_B(0x40000);
        const int it4 = w & 3, eb = (w >> 2) * 4;
        bf16x8 af[2], qf[4];
#pragma unroll
        for (int ks = 0; ks < 2; ++ks) af[ks] = ldfrag(As + (it4 * 16) * LDV, LDV, fr, fq, ks * 32);
#pragma unroll
        for (int ks = 0; ks < 4; ++ks) qf[ks] = ldfrag(Qt + (it4 * 16) * LDQ, LDQ, fr, fq, ks * 32);
#pragma unroll
        for (int it = 0; it < 2; ++it) {
            const int j = 16 * ((it * 8 + w) >> 2) + (lane & 15), d0 = (((it * 8 + w) & 3) * 4 + (lane >> 4)) * 8;
            const unsigned rw[4] = {ktp[it].x, ktp[it].y, ktp[it].z, ktp[it].w};
#pragma unroll
            for (int e = 0; e < 8; ++e) Kt[(d0 + e) * LDV + j] = (bf16_t)((rw[e >> 1] >> ((e & 1) * 16)) & 0xffffu);
        }
        if (tid < 128) DecL[tid] = fexp2(g63s);
        LDS_BARRIER();
#pragma unroll
        for (int t = 0; t < 4; ++t) {
            const int et = eb + t; f32x4 o = {0.f, 0.f, 0.f, 0.f};
#pragma unroll
            for (int ks = 0; ks < 2; ++ks) if (ks == 0 || it4 >= 2) o = MMA16(ldfrag(Vt + (et * 16) * LDV, LDV, fr, fq, ks * 32), af[ks], o);
#pragma unroll
            for (int ks = 0; ks < 4; ++ks) o = MMA16(ldfrag(Sts + (et * 16) * LDQ, LDQ, fr, fq, ks * 32), qf[ks], o);
            *(LAS f32x4*)(Os + (it4 * 16 + fr) * LDG + et * 16 + 4 * fq) = o;
        }
        {
            bf16x8 vf[2];
#pragma unroll
            for (int ks = 0; ks < 2; ++ks) vf[ks] = ldfrag(Vt + (w * 16) * LDV, LDV, fr, fq, ks * 32);
#pragma unroll
            for (int dt = 0; dt < 8; ++dt) {
                acc[dt] = acc[dt] * *(const LAS f32x4*)(DecL + dt * 16 + 4 * fq);
#pragma unroll
                for (int ks = 0; ks < 2; ++ks) acc[dt] = MMA16(ldfrag(Kt + (dt * 16) * LDV, LDV, fr, fq, ks * 32), vf[ks], acc[dt]);
            }
        }
        LDS_BARRIER();
        HP_E(0x40000); HP_B(0x80000);
#pragma unroll
        for (int dt = 0; dt < 8; ++dt) { u32x2 o; o.x = pk2(acc[dt][0], acc[dt][1]); o.y = pk2(acc[dt][2], acc[dt][3]); *(LAS u32x2*)(Sts + (w * 16 + fr) * LDQ + dt * 16 + 4 * fq) = o; }
        {
            const int i = w * 8 + (lane >> 3), c0 = (lane & 7) * 16;
            f32x4 ov[4]; float ss = 0.f;
#pragma unroll
            for (int q = 0; q < 4; ++q) { ov[q] = *(const LAS f32x4*)(Os + i * LDG + c0 + 4 * q); ss += (ov[q][0] * ov[q][0] + ov[q][1] * ov[q][1]) + (ov[q][2] * ov[q][2] + ov[q][3] * ov[q][3]); }
            ss += __shfl_xor(ss, 1); ss += __shfl_xor(ss, 2); ss += __shfl_xor(ss, 4);
            const float r = rsqrtf(ss * (1.f / 128.f) + EPS);
            const float* ngp = a.hg_norm_g + l * 128 + c0;
            unsigned ow[8];
#pragma unroll
            for (int q = 0; q < 4; ++q) { const f32x4 g = *(const f32x4*)(ngp + 4 * q); const unsigned og0 = ogreg[2 * q], og1 = ogreg[2 * q + 1];
                ow[2 * q] = pk2(ov[q][0] * r * g[0] * bf2f(og0 & 0xffffu), ov[q][1] * r * g[1] * bf2f(og0 >> 16));
                ow[2 * q + 1] = pk2(ov[q][2] * r * g[2] * bf2f(og1 & 0xffffu), ov[q][3] * r * g[3] * bf2f(og1 >> 16)); }
            u32x4* op = (u32x4*)(OGg + (r0 + i) * 512 + h * 128 + c0);
            op[0] = (u32x4){ow[0], ow[1], ow[2], ow[3]}; op[1] = (u32x4){ow[4], ow[5], ow[6], ow[7]};
        }
        LDS_BARRIER();
        HP_E(0x80000);
    }
}

__device__ __forceinline__ void conv_fixup(const Args& a, int l) {
    const bf16_t* H = (const bf16_t*)(a.ws + WS_Z); bf16_t* AC = (bf16_t*)(a.ws + WS_AC);
    const float* cw = a.conv_w + (size_t)l * 3 * NUP; const float* cb = a.conv_b + (size_t)l * NUP;
    constexpr int CCH = DFF / 8, NITEM = (M / 64) * CCH;
    for (int item = blockIdx.x * 512 + opaque_tid(); item < NITEM; item += gridDim.x * 512) {
        const int cc = item % CCH, gi = item / CCH, c = cc * 8;
        const bool first = (gi & (SEQ / 64 - 1)) == 0;
        float z[2][4][8];
#pragma unroll
        for (int gv = 0; gv < 2; ++gv) {
            const bf16_t* hp = H + (size_t)gi * 4 * NUP + gv * DFF + c;
            if (first) {
#pragma unroll
                for (int e = 0; e < 8; ++e) { z[gv][0][e] = 0.f; z[gv][1][e] = 0.f; }
            } else { unpack8(*(const u32x4*)(hp - 2 * NUP), z[gv][0]); unpack8(*(const u32x4*)(hp - NUP), z[gv][1]); }
            unpack8(*(const u32x4*)hp, z[gv][2]); unpack8(*(const u32x4*)(hp + NUP), z[gv][3]);
        }
        float w[2][3][8], bb[2][8];
#pragma unroll
        for (int gv = 0; gv < 2; ++gv) {
#pragma unroll
            for (int t = 0; t < 3; ++t) { const f32x4 x0 = *(const f32x4*)(cw + t * NUP + gv * DFF + c), x1 = *(const f32x4*)(cw + t * NUP + gv * DFF + c + 4);
#pragma unroll
                for (int e = 0; e < 4; ++e) { w[gv][t][e] = x0[e]; w[gv][t][4 + e] = x1[e]; } }
            const f32x4 y0 = *(const f32x4*)(cb + gv * DFF + c), y1 = *(const f32x4*)(cb + gv * DFF + c + 4);
#pragma unroll
            for (int e = 0; e < 4; ++e) { bb[gv][e] = y0[e]; bb[gv][4 + e] = y1[e]; }
        }
#pragma unroll
        for (int r = 0; r < 2; ++r) {
            float o[8];
#pragma unroll
            for (int e = 0; e < 8; ++e) {
                const float zg = bb[0][e] + w[0][0][e] * z[0][r][e] + w[0][1][e] * z[0][r + 1][e] + w[0][2][e] * z[0][r + 2][e];
                const float zv = bb[1][e] + w[1][0][e] * z[1][r][e] + w[1][1][e] * z[1][r + 1][e] + w[1][2][e] * z[1][r + 2][e];
                o[e] = silu(zg) * zv;
            }
            u32x4 wv; wv.x = pk2(o[0], o[1]); wv.y = pk2(o[2], o[3]); wv.z = pk2(o[4], o[5]); wv.w = pk2(o[6], o[7]);
            *(u32x4*)(AC + (size_t)(gi * 64 + r) * DFF + c) = wv;
        }
    }
}

__device__ __forceinline__ void prologue(const Args& a, LAS unsigned char* lds) {
    const int tid = opaque_tid(), lane = tid & 63, wave = tid >> 6;
    if (blockIdx.x == 0) {
        float* LB = (float*)(a.ws + WS_LB);
        for (int c = tid; c < 512; c += 512) {
            const float x0 = a.hg_lb[c], x1 = a.hg_lb[512 + c], x2 = a.hg_lb[1024 + c], x3 = a.hg_lb[1536 + c];
            const float mx = fmaxf(fmaxf(x0, x1), fmaxf(x2, x3));
            const float e0 = __expf(x0 - mx), e1 = __expf(x1 - mx), e2 = __expf(x2 - mx), e3 = __expf(x3 - mx), inv = 1.f / (e0 + e1 + e2 + e3);
            const float p1 = e1 * inv, p2 = e2 * inv, p3 = e3 * inv;
            LB[c] = 0.f; LB[512 + c] = fminf(fmaxf(p1, 0.f), 0.999f); LB[1024 + c] = fminf(fmaxf(p1 + p2, 0.f), 0.999f); LB[1536 + c] = fminf(fmaxf(p1 + p2 + p3, 0.f), 0.999f);
        }
    }
    convert_set(a, lds, 0, 0);
    convert_set(a, lds, 1, 0);
    const int gw = blockIdx.x * 8 + wave, NGW = gridDim.x * 8;
    bf16_t* XN = (bf16_t*)(a.ws + WS_XN); float* ssq = (float*)(a.ws + WS_SSQ);
    for (int m0 = gw; m0 < M; m0 += 4 * NGW) {
        f32x4 v[4][4];
#pragma unroll
        for (int r = 0; r < 4; ++r) { const int m = m0 + r * NGW; if (m < M) { const f32x4* xr = (const f32x4*)(a.x + (size_t)m * D) + lane;
#pragma unroll
            for (int j = 0; j < 4; ++j) v[r][j] = xr[64 * j]; } }
#pragma unroll
        for (int r = 0; r < 4; ++r) { const int m = m0 + r * NGW; if (m < M) {
            u32x2* xnr = (u32x2*)(XN + (size_t)m * D) + lane;
            float s = 0.f;
#pragma unroll
            for (int j = 0; j < 4; ++j) { const f32x4 vv = v[r][j];
                u32x2 o; o.x = pk2(vv.x, vv.y); o.y = pk2(vv.z, vv.w); xnr[64 * j] = o;
                const f32x4 vr = {bf2f(o.x & 0xffffu), bf2f(o.x >> 16), bf2f(o.y & 0xffffu), bf2f(o.y >> 16)}; s += (vr.x * vr.x + vr.y * vr.y) + (vr.z * vr.z + vr.w * vr.w); }
            s = wave_sum(s);
            if (lane < 16) ssq[(size_t)m * 16 + lane] = lane == 0 ? s : 0.f; } }
    }
}
__device__ __forceinline__ void final_norm(const Args& a) {
    const int tid = opaque_tid(), lane = tid & 63, wave = tid >> 6;
    const int gw = blockIdx.x * 8 + wave, NGW = gridDim.x * 8;
    const float* ssq = (const float*)(a.ws + WS_SSQ);
    for (int m0 = gw; m0 < M; m0 += 4 * NGW) {
        float rs[4]; u32x2 xv[4][4];
#pragma unroll
        for (int r = 0; r < 4; ++r) { const int m = m0 + r * NGW; if (m < M) { rs[r] = rowscale(ssq, m);
            const u32x2* xr = (const u32x2*)((const bf16_t*)(a.ws + WS_XN) + (size_t)m * D) + lane;
#pragma unroll
            for (int j = 0; j < 4; ++j) xv[r][j] = xr[64 * j]; } }
#pragma unroll
        for (int r = 0; r < 4; ++r) { const int m = m0 + r * NGW; if (m < M) {
            f32x4* orow = (f32x4*)(a.out + (size_t)m * D) + lane; const f32x4* gr = (const f32x4*)a.final_norm + lane; const float rr = rs[r];
#pragma unroll
            for (int j = 0; j < 4; ++j) { const u32x2 x = xv[r][j]; const f32x4 g = gr[64 * j];
                orow[64 * j] = (f32x4){bf2f(x.x & 0xffffu) * rr * g.x, bf2f(x.x >> 16) * rr * g.y, bf2f(x.y & 0xffffu) * rr * g.z, bf2f(x.y >> 16) * rr * g.w}; } } }
    }
}

#define XB_TMO      128
#define XB_XCNT(j)  (256  + 64 * (j))
#define XB_XSUB(j)  (1280 + 64 * (j))
#define XB_XGEN(j)  (2304 + 64 * (j))
#define XB_TOP      3328
#define XB_TOPGEN   3392
#define XCD_BAR_WORDS 3456
#define XB_SPIN_CAP (1u << 20)

__device__ __forceinline__ unsigned xb_ld(unsigned* p)              { return __hip_atomic_load(p, __ATOMIC_RELAXED, __HIP_MEMORY_SCOPE_AGENT); }
__device__ __forceinline__ unsigned xb_add(unsigned* p, unsigned v) { return __hip_atomic_fetch_add(p, v, __ATOMIC_RELAXED, __HIP_MEMORY_SCOPE_AGENT); }
__device__ __forceinline__ unsigned xb_xcc_id() { return (unsigned)__builtin_amdgcn_s_getreg((3 << 11) | 20) & 0xFu; }
#define XB_SPIN(cond, bar) do { unsigned _sp = 0; while (cond) {   \
    if ((++_sp & 255u) == 0u) { if (xb_ld(&(bar)[XB_TMO])) break; if (_sp > XB_SPIN_CAP) { atomicAdd(&(bar)[XB_TMO], 1u); break; } } } } while (0)

struct XcdBarrier {
    unsigned* bar; unsigned x;
    volatile LAS unsigned* st;
};

__device__ __forceinline__ XcdBarrier xcd_barrier_post(unsigned* bar, volatile LAS unsigned* st) {
    XcdBarrier b; b.bar = bar; b.x = xb_xcc_id(); b.st = st;
    if (threadIdx.x == 0) (void)xb_add(&bar[XB_XCNT(b.x)], 1u);
    return b;
}
__device__ __forceinline__ void xcd_barrier_complete(unsigned* bar, unsigned x, unsigned& nloc, unsigned& nx) {
    const unsigned G = gridDim.x * gridDim.y * gridDim.z;
    unsigned sum, cnt, mine, sp = 0u;
    for (;;) {
        sum = 0u; cnt = 0u; mine = 0u;
#pragma unroll
        for (unsigned j = 0; j < 16; ++j) { const unsigned c = xb_ld(&bar[XB_XCNT(j)]); sum += c; cnt += (c > 0u) ? 1u : 0u; mine = (j == x) ? c : mine; }
        if (sum == G) break;
        __builtin_amdgcn_s_sleep(1);
        if ((++sp & 255u) == 0u) { if (xb_ld(&bar[XB_TMO])) break; if (sp > XB_SPIN_CAP) { atomicAdd(&bar[XB_TMO], 1u); break; } }
    }
    nloc = mine > 0u ? mine : 1u; nx = cnt > 0u ? cnt : 1u;
}

__device__ __forceinline__ void xcd_barrier(const XcdBarrier& b) {
    asm volatile("s_waitcnt vmcnt(0)" ::: "memory");
    __syncthreads();
    if (threadIdx.x == 0) {
        unsigned* bar = b.bar;
        __builtin_amdgcn_s_waitcnt(0);
        unsigned nloc = b.st[0], nx = b.st[1];
        if (nloc == 0u) { xcd_barrier_complete(bar, b.x, nloc, nx); b.st[0] = nloc; b.st[1] = nx; }
        const unsigned old = xb_add(&bar[XB_XSUB(b.x)], 1u);
        const unsigned gen = old / nloc;
        if (old + 1u == (gen + 1u) * nloc) {
            __builtin_amdgcn_fence(__ATOMIC_RELEASE, "agent");
            asm volatile("s_waitcnt vmcnt(0)" ::: "memory");
            const unsigned og = xb_add(&bar[XB_TOP], 1u);
            const unsigned tg = og / nx;
            if (og + 1u == (tg + 1u) * nx) xb_add(&bar[XB_TOPGEN], 1u);
            else XB_SPIN(xb_ld(&bar[XB_TOPGEN]) == tg, bar);
            __builtin_amdgcn_fence(__ATOMIC_ACQUIRE, "agent");
            xb_add(&bar[XB_XGEN(b.x)], 1u);
            asm volatile("s_waitcnt vmcnt(0)" ::: "memory");
        } else {
            XB_SPIN(xb_ld(&bar[XB_XGEN(b.x)]) == gen, bar);
            __builtin_amdgcn_fence(__ATOMIC_ACQUIRE, "agent");
            asm volatile("s_waitcnt vmcnt(0)" ::: "memory");
        }
    }
    __syncthreads();
}

__global__ void __launch_bounds__(512, 2) trunk_fwd(Args a) {
    extern __shared__ __attribute__((aligned(16))) unsigned char lds_raw[];
    LAS unsigned char* lds = (LAS unsigned char*)lds_raw;
    cg::grid_group grid = cg::this_grid();
    if (threadIdx.x < 64) ((LAS unsigned*)(lds + (LDS_BYTES - 256)))[threadIdx.x] = 0u;
    __syncthreads();
    XcdBarrier bar = xcd_barrier_post((unsigned*)a.ws + 4096, (volatile LAS unsigned*)(lds + (LDS_BYTES - 256)));
    unsigned char* ws = a.ws;
    const int G = gridDim.x, bx = blockIdx.x;
    bf16_t* XN; float* ssq;

#ifndef PH
#define PH 0xFFFF
#endif
#ifndef PROBE_MASK
#define PROBE_MASK 0
#endif
    unsigned long long pr_acc = 0, pr_t0 = 0;
#define PR_BEGIN(bit) do { if ((PROBE_MASK) & (bit)) pr_t0 = __builtin_amdgcn_s_memrealtime(); } while (0)
#define PR_END(bit) do { if ((PROBE_MASK) & (bit)) pr_acc += __builtin_amdgcn_s_memrealtime() - pr_t0; } while (0)
    PR_BEGIN(1);
    if (PH & 1) prologue(a, lds);
    if (a.ws == nullptr) grid.sync();
    xcd_barrier(bar);
    PR_END(1);
#define LAUNDER(p) asm volatile("" : "+s"(p))
#pragma unroll 1
    for (int l = 0; l < DEPTH; ++l) {
        PR_BEGIN(2);
#ifndef REP_P1
#define REP_P1 1
#endif
#ifndef REP_P5
#define REP_P5 1
#endif
#pragma unroll 1
        for (int rep = 0; rep < REP_P1; ++rep)
        if (PH & 2) { LAUNDER(ws); XN = (bf16_t*)(ws + WS_XN); ssq = (float*)(ws + WS_SSQ);
            pg8::Gemm g{XN, (const bf16_t*)(ws + WS_WIN), M, INC, D}; pg8::StaticOrder S; S.init(M, INC, G, bx);
            EpiIn E{(bf16_t*)(ws + WS_U), (bf16_t*)(ws + WS_V), (bf16_t*)(ws + WS_Q), (bf16_t*)(ws + WS_KK), (bf16_t*)(ws + WS_I), (bf16_t*)(ws + WS_OG), (bf16_t*)(ws + WS_GT),
                    (float*)(ws + WS_GL), ssq, (const float*)(ws + WS_LB) + l * 512, (float*)(ws + WS_VS), (const LAS float*)(lds + RTAB_OFF), 0};
            fill_rtab(S, ssq, lds);
            pg8::gemm_phase<EpiIn, pg8::StaticOrder, ALIGN_HEAVY, true>(lds, g, S, E);
        }
        xcd_barrier(bar);
        PR_END(2);
        PR_BEGIN(4);
        if (PH & 4) { int wl_h = -1; for (int u = bx; u < 8 * HG_NG + 512; u += G) { if (u < 8 * HG_NG) { PR_BEGIN(2048); hg1g_unit(a, lds, u); PR_END(2048); wl_h = -1; } else { PR_BEGIN(4096); { const int gh = (u - 8 * HG_NG) & 3; gmlp_unit(a, lds, u - 8 * HG_NG, l, gh != wl_h); wl_h = gh; } PR_END(4096); } } }
        xcd_barrier(bar);
        PR_END(4);
        PR_BEGIN(8);
        if (PH & 8) { hg_gscan(a); }
        xcd_barrier(bar);
        PR_END(8);
        PR_BEGIN(16);
        if (PH & 16) for (int u = bx; u < 8 * HG_NG; u += G) hg3g_unit(a, lds, u, l, pr_acc);
        xcd_barrier(bar);
        PR_END(16);
        PR_BEGIN(32);
        if (PH & 32) { LAUNDER(ws);
            pg8::StaticOrder S; S.init(M, D, G, bx);
            pg8::Gemm g1{(const bf16_t*)(ws + WS_U), (const bf16_t*)(ws + WS_WGM), M, D, 512};
            EpiBr<false> E1{(bf16_t*)(ws + WS_Y), (const bf16_t*)(ws + WS_GT), 0};
            pg8::gemm_phase<EpiBr<false>, pg8::StaticOrder, ALIGN_SINGLE, true>(lds, g1, S, E1);
            pg8::Gemm g2{(const bf16_t*)(ws + WS_OG), (const bf16_t*)(ws + WS_WHG), M, D, 512};
            EpiBr<true> E2{(bf16_t*)(ws + WS_Y), (const bf16_t*)(ws + WS_GT), 1024};
            pg8::gemm_phase<EpiBr<true>, pg8::StaticOrder, ALIGN_SINGLE, true>(lds, g2, S, E2);
        }
        xcd_barrier(bar);
        PR_END(32);
        PR_BEGIN(64);
        if (PH & 64) { LAUNDER(ws); XN = (bf16_t*)(ws + WS_XN); ssq = (float*)(ws + WS_SSQ);
            pg8::Gemm g{(const bf16_t*)(ws + WS_Y), (const bf16_t*)(ws + WS_WOUT), M, D, D}; pg8::StaticOrder S; S.init(M, D, G, bx);
            EpiRes E{XN, (bf16_t*)(ws + WS_XN2), ssq};
            pg8::gemm_phase<EpiRes, pg8::StaticOrder, ALIGN_SINGLE, true>(lds, g, S, E);
        }
        xcd_barrier(bar);
        PR_END(64);
        PR_BEGIN(128);
#pragma unroll 1
        for (int rep = 0; rep < REP_P5; ++rep)
        if (PH & 128) { LAUNDER(ws); XN = (bf16_t*)(ws + WS_XN); ssq = (float*)(ws + WS_SSQ);
            pg8::Gemm g{(const bf16_t*)(ws + WS_XN2), (const bf16_t*)(ws + WS_WUP + (l & 1) * WS_FFNW_STRIDE), M, NUP, D}; pg8::StaticOrder S; S.init(M, NUP, G, bx);
            EpiUp E{(bf16_t*)(ws + WS_AC), (bf16_t*)(ws + WS_Z), ssq, a.conv_w + (size_t)l * 3 * NUP, a.conv_b + (size_t)l * NUP, (LAS float*)(lds + 132096), (const LAS float*)(lds + RTAB_OFF), 0};
            if (l + 1 < DEPTH) { convert_set(a, lds, 0, l + 1, G / 2, G - G / 2); convert_set(a, lds, 1, l + 1, G / 2, G - G / 2); __syncthreads(); }
            fill_rtab(S, ssq, lds);
            pg8::gemm_phase<EpiUp, pg8::StaticOrder, ALIGN_HEAVY, true>(lds, g, S, E);
        }
        xcd_barrier(bar);
        PR_END(128);
        PR_BEGIN(256);
        if (PH & 256) { conv_fixup(a, l); }
        xcd_barrier(bar);
        PR_END(256);
        PR_BEGIN(512);
        if (PH & 512) { LAUNDER(ws); XN = (bf16_t*)(ws + WS_XN); ssq = (float*)(ws + WS_SSQ);
            pg8::Gemm g{(const bf16_t*)(ws + WS_AC), (const bf16_t*)(ws + WS_WDN + (l & 1) * WS_FFNW_STRIDE), M, D, DFF}; pg8::StaticOrder S; S.init(M, D, G, bx);
            EpiRes E{(const bf16_t*)(ws + WS_XN2), XN, ssq};
            pg8::gemm_phase<EpiRes, pg8::StaticOrder, ALIGN_SINGLE, true>(lds, g, S, E);
        }
        xcd_barrier(bar);
        PR_END(512);
    }
    if (PH & 1024) final_norm(a);
    if ((PROBE_MASK) && blockIdx.x == 0) { const unsigned long long te = __builtin_amdgcn_s_memrealtime() + 4 * pr_acc; while (__builtin_amdgcn_s_memrealtime() < te) __builtin_amdgcn_s_sleep(8); }
}

extern "C" void kernel_launch(void* const* d_in, const int* in_sizes, int n_in, void* d_out, int out_size, void* d_ws, size_t ws_size, hipStream_t stream) {
    static int grid = 0;
    if (grid == 0) {
        if (n_in != 18 || out_size != M * D || ws_size < WS_NEED) { fprintf(stderr, "kernel_launch: unexpected shapes (n_in %d, out %d, ws %zu < %zu)\n", n_in, out_size, ws_size, (size_t)WS_NEED); grid = -1; return; }
        int dev = 0, cus = 0, per_cu = 0;
        hipGetDevice(&dev); hipDeviceGetAttribute(&cus, hipDeviceAttributeMultiprocessorCount, dev);
        if (hipFuncSetAttribute((const void*)trunk_fwd, hipFuncAttributeMaxDynamicSharedMemorySize, LDS_BYTES) != hipSuccess) { fprintf(stderr, "kernel_launch: hipFuncSetAttribute failed\n"); grid = -1; return; }
        if (hipOccupancyMaxActiveBlocksPerMultiprocessor(&per_cu, (const void*)trunk_fwd, 512, LDS_BYTES) != hipSuccess || per_cu < 1) { fprintf(stderr, "kernel_launch: occupancy query says %d\n", per_cu); per_cu = 1; }
        (void)hipGetLastError();
        grid = cus * 1;
    }
    if (grid < 0) return;
    if (hipMemsetAsync(d_ws, 0, 65536, stream) != hipSuccess) { fprintf(stderr, "kernel_launch: memset failed\n"); return; }
    Args a{};
    const float** ap = (const float**)&a;
    for (int i = 0; i < 18; ++i) ap[i] = (const float*)d_in[i];
    a.out = (float*)d_out; a.ws = (unsigned char*)d_ws;
    void* args[] = {&a};
    hipError_t e = hipLaunchCooperativeKernel((const void*)trunk_fwd, dim3(grid), dim3(512), args, LDS_BYTES, stream);
    if (e != hipSuccess) fprintf(stderr, "cooperative launch failed: %s (grid %d)\n", hipGetErrorString(e), grid);
}
```

```cpp
#include <hip/hip_runtime.h>
#include <hip/hip_cooperative_groups.h>
#include <cstdio>
#include <cstdint>
namespace cg = cooperative_groups;
namespace pg8 {
#define PG8_LAS __attribute__((address_space(3)))
typedef unsigned short bf16_t;
typedef short bf16x8 __attribute__((ext_vector_type(8)));
typedef float f32x4 __attribute__((ext_vector_type(4)));
typedef unsigned u32x4 __attribute__((ext_vector_type(4)));
constexpr int BM = 256, BK = 64, HALF = 128, HTB = HALF * BK * 2  , STAGE_BYTES = 8 * HTB, NXCD = 8, WGM = 8;

__host__ __device__ __forceinline__ int lds_byte(int r, int c) { const int st = (r >> 4) * 2 + (c >> 5), rr = r & 15, cc = c & 31, ob = rr * 64 + cc * 2; return st * 1024 + (ob ^ (((ob >> 9) & 1) << 5)); }
__host__ __device__ __forceinline__ void stage_rc(int b, int& R, int& C) { const int st = b / 1024, sb = b % 1024, swz = sb ^ (((sb >> 9) & 1) << 5); R = (st >> 1) * 16 + swz / 64; C = (st & 1) * 32 + (swz % 64) / 2; }
__host__ __device__ __forceinline__ int perm32(int rho) { const int n = rho >> 4, i = rho & 15; return 8 * (i >> 2) + 4 * n + (i & 3); }

struct Unit { int pm, pn; };
struct Gemm { const bf16_t* A; const bf16_t* Bt; int M, N, K; };

struct StaticOrder {
    int nM, nN, nwg, G, c;
    __host__ __device__ void init(int M, int N, int G_, int c_) { nM = M / BM; nN = N / BM; nwg = nM * nN; G = G_; c = c_; }
    __host__ __device__ bool next(int i, Unit& u) const {
        const long L = (long)i * G + c; if (L >= nwg) return false;
        int wgid = (int)L; { const int q = nwg / NXCD, r = nwg % NXCD, xcd = wgid % NXCD, off = wgid / NXCD; wgid = (xcd < r ? xcd * (q + 1) : r * (q + 1) + (xcd - r) * q) + off; }
        const int nig = WGM * nN, gid = wgid / nig, fm = gid * WGM, gsz = (nM - fm) < WGM ? (nM - fm) : WGM;
        u.pm = fm + ((wgid % nig) % gsz); u.pn = (wgid % nig) / gsz; return true;
    }
    __device__ __forceinline__ void a_ready(const Unit&) const {}
    __device__ __forceinline__ void done(const Unit&) const {}
};

__device__ __forceinline__ unsigned cvt_pk_bf16(float lo, float hi) { unsigned r; asm volatile("v_cvt_pk_bf16_f32 %0, %1, %2" : "=v"(r) : "v"(lo), "v"(hi)); return r; }
typedef float f32x2 __attribute__((ext_vector_type(2)));
__device__ __forceinline__ f32x2 gelu_pk(f32x2 v) {
    const f32x2 av = __builtin_elementwise_abs(v), d = av * 0.2316418882f + 1.0f;
    f32x2 t; t.x = __builtin_amdgcn_rcpf(d.x); t.y = __builtin_amdgcn_rcpf(d.y);
    f32x2 q = t * 0.5307027145f + (-0.7265760135f); q = q * t + 0.7107068705f; q = q * t + (-0.142248368f); q = q * t + 0.127414796f; q = q * t;
    const f32x2 s = (v * v) * (-0.72134752044f);
    f32x2 e; e.x = __builtin_amdgcn_exp2f(s.x); e.y = __builtin_amdgcn_exp2f(s.y);
    const f32x2 m = v * (q * e), r = v - m;
    f32x2 o; o.x = v.x < 0.f ? m.x : r.x; o.y = v.y < 0.f ? m.y : r.y; return o;
}

template <int ACT  > struct EpiBf16 {
    static constexpr bool PERM = true, AFTER_DRAIN = false; static_assert(ACT == 0 || ACT == 1, "EpiBf16: ACT is 0 (none) or 1 (gelu_pk)");
    bf16_t* O; int ldc; const float* bias; int split_cols; size_t split_stride; float scale0;
    __device__ __forceinline__ void operator()(const f32x4 (&acc)[2][2][4][2], const Unit& u, int wr, int wc, int fr, int fq) const {
        const int row0 = u.pm * BM + wr * 64 + fr; int colt = u.pn * BM; bf16_t* base = O;
        float sc = 1.f; if (split_cols) { const int t = colt / split_cols; base += (size_t)t * split_stride; colt -= t * split_cols; if (t == 0) sc = scale0; }
        const int col0 = colt + wc * 32 + 8 * fq, bcol0 = u.pn * BM + wc * 32 + 8 * fq;
        f32x4 bv[2][2];
#pragma unroll
        for (int bj = 0; bj < 2; ++bj)
#pragma unroll
            for (int n = 0; n < 2; ++n) bv[bj][n] = bias ? *(const f32x4*)(bias + bcol0 + bj * HALF + 4 * n) : (f32x4){0.f, 0.f, 0.f, 0.f};
#pragma unroll
        for (int ai = 0; ai < 2; ++ai)
#pragma unroll
            for (int m = 0; m < 4; ++m) { bf16_t* rowp = base + (size_t)(row0 + ai * HALF + m * 16) * ldc + col0;
#pragma unroll
                for (int bj = 0; bj < 2; ++bj) { f32x4 v0 = acc[ai][bj][m][0] + bv[bj][0], v1 = acc[ai][bj][m][1] + bv[bj][1];
                    if (ACT == 1) { f32x2 a = gelu_pk((f32x2){v0[0], v0[1]}), b = gelu_pk((f32x2){v0[2], v0[3]}), c = gelu_pk((f32x2){v1[0], v1[1]}), d = gelu_pk((f32x2){v1[2], v1[3]});
                        v0 = (f32x4){a.x, a.y, b.x, b.y}; v1 = (f32x4){c.x, c.y, d.x, d.y}; }
                    v0 = v0 * sc; v1 = v1 * sc; u32x4 w; w.x = cvt_pk_bf16(v0[0], v0[1]); w.y = cvt_pk_bf16(v0[2], v0[3]); w.z = cvt_pk_bf16(v1[0], v1[1]); w.w = cvt_pk_bf16(v1[2], v1[3]);
                    *(u32x4*)(rowp + bj * HALF) = w; } }
    }
};
template <class Epi, class Sched, bool ALIGN_EPI = false, bool SP2 = false>
__device__ __forceinline__ void gemm_phase(PG8_LAS unsigned char* lds, const Gemm g, const Sched& S, const Epi& E) {
    int tid_ = threadIdx.x; asm volatile("" : "+v"(tid_)); const int tid = tid_, wid = __builtin_amdgcn_readfirstlane(tid >> 6), lane = tid & 63, wr = wid >> 2, wc = wid & 3, fr = lane & 15, fq = lane >> 4;
    const int K = g.K, nt = K / BK;
    unsigned voffA[2], voffB[2];
#pragma unroll
    for (int i = 0; i < 2; ++i) { int R, C; stage_rc(tid * 16 + i * 8192, R, C); const int Rb = Epi::PERM ? ((R & ~31) + perm32(R & 31)) : R;
        voffA[i] = (unsigned)(R * K + C) * 2u; voffB[i] = (unsigned)(Rb * K + C) * 2u; }
    const size_t kstep = (size_t)(BK * 2);
    const size_t hstep = (size_t)HALF * K * 2;
    const size_t tstep = 2 * hstep;
    const unsigned ldsw = (unsigned)wid * 1024u;
    const int aoff = lds_byte(wr * 64 + fr, fq * 8), boff = lds_byte(wc * 32 + fr, fq * 8);
#define PG8_SA(b, h) (((b) * 2 + (h)) * HTB)
#define PG8_SB(b, h) ((4 + (b) * 2 + (h)) * HTB)
#define PG8_STAGE(bufoff, gbase, voff) do { _Pragma("unroll") for (int _i = 0; _i < 2; ++_i) \
        __builtin_amdgcn_global_load_lds((const unsigned*)((const char*)(gbase) + (voff)[_i]), (PG8_LAS unsigned*)(lds + (bufoff) + ldsw + _i * 8192), 16, 0, 0); } while (0)
#define PG8_LDA(dst, b, h) do { _Pragma("unroll") for (int m = 0; m < 4; ++m) _Pragma("unroll") for (int k = 0; k < 2; ++k) dst[m][k] = *(const PG8_LAS bf16x8*)(lds + PG8_SA(b, h) + aoff + m * 2048 + k * 1024); } while (0)
#define PG8_LDB(dst, b, h) do { _Pragma("unroll") for (int n = 0; n < 2; ++n) _Pragma("unroll") for (int k = 0; k < 2; ++k) dst[n][k] = *(const PG8_LAS bf16x8*)(lds + PG8_SB(b, h) + boff + n * 2048 + k * 1024); } while (0)
#define PG8_MMA(ai, bj, At, Bt) do { __builtin_amdgcn_s_setprio(1); _Pragma("unroll") for (int m = 0; m < 4; ++m) _Pragma("unroll") for (int n = 0; n < 2; ++n) _Pragma("unroll") for (int k = 0; k < 2; ++k) \
        acc[ai][bj][m][n] = __builtin_amdgcn_mfma_f32_16x16x32_bf16(Bt[n][k], At[m][k], acc[ai][bj][m][n], 0, 0, 0); __builtin_amdgcn_s_setprio(0); } while (0)
#define PG8_WAIT_V(n) asm volatile("s_waitcnt vmcnt(" #n ")" ::: "memory")
#define PG8_WAIT_L(n) asm volatile("s_waitcnt lgkmcnt(" #n ")" ::: "memory")
#define PG8_BAR __builtin_amdgcn_s_barrier()
#define PG8_SCHED __builtin_amdgcn_sched_barrier(0)
    Unit cur, nxt; int ui = 0;
    if (!S.next(0, cur)) return;
    f32x4 acc[2][2][4][2];
#pragma unroll
    for (int a = 0; a < 2; ++a)
#pragma unroll
        for (int b = 0; b < 2; ++b)
#pragma unroll
            for (int m = 0; m < 4; ++m)
#pragma unroll
                for (int n = 0; n < 2; ++n) acc[a][b][m][n] = (f32x4){0.f, 0.f, 0.f, 0.f};
    bf16x8 At[4][2], B0[2][2], B1[2][2];
    const char* cA = (const char*)g.A + (size_t)cur.pm * tstep; const char* cB = (const char*)g.Bt + (size_t)cur.pn * tstep;
    S.a_ready(cur);
    if constexpr (SP2) {
        PG8_STAGE(PG8_SB(0, 0), cB, voffB); PG8_STAGE(PG8_SB(0, 1), cB + hstep, voffB); PG8_STAGE(PG8_SA(0, 0), cA, voffA); PG8_STAGE(PG8_SA(0, 1), cA + hstep, voffA);
        if (wr == 1) PG8_BAR;
        PG8_WAIT_V(2); PG8_BAR;
        PG8_STAGE(PG8_SB(1, 0), cB + kstep, voffB); PG8_STAGE(PG8_SA(1, 0), cA + kstep, voffA); PG8_STAGE(PG8_SB(1, 1), cB + hstep + kstep, voffB);
        PG8_WAIT_V(6); PG8_BAR;
    } else {
        PG8_STAGE(PG8_SB(0, 0), cB, voffB); PG8_STAGE(PG8_SA(0, 0), cA, voffA); PG8_STAGE(PG8_SB(0, 1), cB + hstep, voffB); PG8_STAGE(PG8_SA(0, 1), cA + hstep, voffA);
        if (wr == 1) PG8_BAR;
        PG8_WAIT_V(4); PG8_BAR;
        PG8_STAGE(PG8_SB(1, 0), cB + kstep, voffB); PG8_STAGE(PG8_SA(1, 0), cA + kstep, voffA); PG8_STAGE(PG8_SB(1, 1), cB + hstep + kstep, voffB);
        PG8_WAIT_V(6); PG8_BAR;
    }
    for (;;) {
        const bool has_next = S.next(ui + 1, nxt);
        const char* nA = has_next ? (const char*)g.A + (size_t)nxt.pm * tstep : cA; const char* nB = has_next ? (const char*)g.Bt + (size_t)nxt.pn * tstep : cB;
        for (int t = 0; t < nt; t += 2) {
            const bool last = (t == nt - 2);
            const char* a1 = cA + (size_t)(t + 1) * kstep;
            const char* a2 = last ? nA : cA + (size_t)(t + 2) * kstep; const char* b2 = last ? nB : cB + (size_t)(t + 2) * kstep;
            const char* a3 = a2 + kstep; const char* b3 = b2 + kstep;
            if (last && has_next) S.a_ready(nxt);
            if constexpr (SP2) {
            PG8_LDB(B0, 0, 0); PG8_LDB(B1, 0, 1); PG8_SCHED; PG8_LDA(At, 0, 0); PG8_STAGE(PG8_SA(1, 1), a1 + hstep, voffA);
            PG8_WAIT_V(8); PG8_WAIT_L(0); PG8_BAR; PG8_MMA(0, 0, At, B0); PG8_MMA(0, 1, At, B1); PG8_BAR; PG8_SCHED;
            PG8_LDA(At, 0, 1); PG8_STAGE(PG8_SB(0, 0), b2, voffB); PG8_STAGE(PG8_SB(0, 1), b2 + hstep, voffB); PG8_STAGE(PG8_SA(0, 0), a2, voffA);
            PG8_WAIT_V(8); PG8_WAIT_L(0); PG8_BAR; PG8_MMA(1, 0, At, B0); PG8_MMA(1, 1, At, B1); PG8_BAR; PG8_SCHED;
            PG8_LDB(B0, 1, 0); PG8_LDB(B1, 1, 1); PG8_SCHED; PG8_LDA(At, 1, 0); PG8_STAGE(PG8_SA(0, 1), a2 + hstep, voffA);
            PG8_WAIT_V(8); PG8_WAIT_L(0); PG8_BAR; PG8_MMA(0, 0, At, B0); PG8_MMA(0, 1, At, B1); PG8_BAR; PG8_SCHED;
            PG8_LDA(At, 1, 1); PG8_STAGE(PG8_SB(1, 0), b3, voffB); PG8_STAGE(PG8_SB(1, 1), b3 + hstep, voffB); PG8_STAGE(PG8_SA(1, 0), a3, voffA);
            PG8_WAIT_V(8); PG8_WAIT_L(0); PG8_BAR; PG8_MMA(1, 0, At, B0); PG8_MMA(1, 1, At, B1); PG8_BAR; PG8_SCHED;
            } else {
            PG8_LDB(B0, 0, 0); PG8_SCHED; PG8_LDA(At, 0, 0); PG8_STAGE(PG8_SA(1, 1), a1 + hstep, voffA);
            PG8_WAIT_L(8); PG8_BAR; PG8_WAIT_L(0); PG8_MMA(0, 0, At, B0); PG8_BAR; PG8_SCHED;
            PG8_LDB(B1, 0, 1); PG8_STAGE(PG8_SB(0, 0), b2, voffB);
            PG8_BAR; PG8_WAIT_L(0); PG8_MMA(0, 1, At, B1); PG8_BAR;
            PG8_LDA(At, 0, 1); PG8_STAGE(PG8_SA(0, 0), a2, voffA);
            PG8_BAR; PG8_WAIT_L(0); PG8_MMA(1, 0, At, B0); PG8_BAR; PG8_SCHED;
            PG8_STAGE(PG8_SB(0, 1), b2 + hstep, voffB);
            PG8_WAIT_V(6); PG8_BAR; PG8_MMA(1, 1, At, B1); PG8_BAR;
            PG8_LDB(B0, 1, 0); PG8_SCHED; PG8_LDA(At, 1, 0); PG8_STAGE(PG8_SA(0, 1), a2 + hstep, voffA);
            PG8_WAIT_L(8); PG8_BAR; PG8_WAIT_L(0); PG8_MMA(0, 0, At, B0); PG8_BAR; PG8_SCHED;
            PG8_LDB(B1, 1, 1); PG8_STAGE(PG8_SB(1, 0), b3, voffB);
            PG8_BAR; PG8_WAIT_L(0); PG8_MMA(0, 1, At, B1); PG8_BAR;
            PG8_LDA(At, 1, 1); PG8_STAGE(PG8_SA(1, 0), a3, voffA);
            PG8_BAR; PG8_WAIT_L(0); PG8_MMA(1, 0, At, B0); PG8_BAR; PG8_SCHED;
            PG8_STAGE(PG8_SB(1, 1), b3 + hstep, voffB);
            PG8_WAIT_V(6); PG8_BAR; PG8_MMA(1, 1, At, B1); PG8_BAR;
            }
        }
        if constexpr (ALIGN_EPI) { if (wr == 0) PG8_BAR; }
        if constexpr (!Epi::AFTER_DRAIN) { E(acc, cur, wr, wc, fr, fq); S.done(cur); }
        if (!has_next) break;
#pragma unroll
        for (int a = 0; a < 2; ++a)
#pragma unroll
            for (int b = 0; b < 2; ++b)
#pragma unroll
                for (int m = 0; m < 4; ++m)
#pragma unroll
                    for (int n = 0; n < 2; ++n) acc[a][b][m][n] = (f32x4){0.f, 0.f, 0.f, 0.f};
        cur = nxt; cA = nA; cB = nB; ++ui;
        if constexpr (ALIGN_EPI) { if (wr == 1) PG8_BAR; }
    }
    PG8_WAIT_V(0);
    if constexpr (!ALIGN_EPI) { if (wr == 0) PG8_BAR; }
    PG8_BAR;
    if constexpr (Epi::AFTER_DRAIN) { E.fused(acc, cur, wr, wc, fr, fq, lds, wid, lane); S.done(cur); }
#undef PG8_SA
#undef PG8_SB
#undef PG8_STAGE
#undef PG8_LDA
#undef PG8_LDB
#undef PG8_MMA
#undef PG8_WAIT_V
#undef PG8_WAIT_L
#undef PG8_BAR
#undef PG8_SCHED
}
}
#define LAS __attribute__((address_space(3)))
__device__ __forceinline__ int opaque_tid() { int t = threadIdx.x; asm volatile("" : "+v"(t)); return t; }
using pg8::bf16_t; using pg8::bf16x8; using pg8::f32x4; using pg8::u32x4; using pg8::Unit;
typedef float f32x2 __attribute__((ext_vector_type(2)));
typedef unsigned u32x2 __attribute__((ext_vector_type(2)));

constexpr int NB = 2, SEQ = 8192, M = NB * SEQ, D = 1024, DEPTH = 4, INC = 5120, DFF = 2816, NUP = 2 * DFF;
constexpr float EPS = 1e-6f, LOG2E = 1.4426950408889634f;
constexpr size_t MiB = 1u << 20;
constexpr size_t WS_LB = 1 * MiB, WS_SSQ = 2 * MiB, WS_DEC = 3 * MiB;
constexpr size_t WS_WIN = 4 * MiB, WS_WGM = 14 * MiB, WS_WHG = 15 * MiB, WS_WOUT = 16 * MiB, WS_WUP = 18 * MiB, WS_WDN = 29 * MiB;
constexpr size_t WS_XN = 36 * MiB, WS_ACT0 = 68 * MiB, WS_VS = 35 * MiB;
constexpr size_t WS_U = WS_ACT0, WS_V = WS_U + 16 * MiB, WS_Q = WS_V + 16 * MiB, WS_KK = WS_Q + 16 * MiB, WS_GL = WS_KK + 16 * MiB, WS_I = WS_GL + 32 * MiB,
                 WS_OG = WS_I + 16 * MiB, WS_GT = WS_OG + 16 * MiB, WS_ST = WS_GT + 64 * MiB, WS_END1 = WS_ST + 64 * MiB;
constexpr size_t WS_XN2 = WS_I;
constexpr size_t WS_Y = WS_Q;
constexpr size_t WS_Z = WS_ACT0, WS_AC = WS_Z + 176 * MiB, WS_END2 = WS_AC + 88 * MiB;
constexpr size_t WS_FFNW2 = WS_END2, WS_FFNW_STRIDE = WS_FFNW2 - WS_WUP;
constexpr size_t WS_NEED = WS_FFNW2 + 17 * MiB;
constexpr int LDS_BYTES = 147456;

#ifndef PROBE_MASK
#define PROBE_MASK 0
#endif
#ifndef ALIGN_SINGLE
#define ALIGN_SINGLE true
#endif
#ifndef ALIGN_HEAVY
#define ALIGN_HEAVY true
#endif
struct Args {
    const float *x, *mix_norm, *w_in, *gm_ln_g, *gm_ln_b, *gm_ws, *gm_bs, *hg_lb, *hg_norm_g, *w_br_gm, *w_br_hg, *w_out, *ffn_norm, *w_up, *conv_w, *conv_b, *w_down, *final_norm;
    float* out; unsigned char* ws;
};

__device__ __forceinline__ float bf2f(unsigned h) { return __uint_as_float(h << 16); }
__device__ __forceinline__ unsigned f2bf(float f) { unsigned u = __float_as_uint(f); return (u + 0x7fffu + ((u >> 16) & 1u)) >> 16; }
__device__ __forceinline__ unsigned pk2(float lo, float hi) { return pg8::cvt_pk_bf16(lo, hi); }
__device__ __forceinline__ float fexp2(float x) { return __builtin_amdgcn_exp2f(x); }
__device__ __forceinline__ float frcp(float x) { return __builtin_amdgcn_rcpf(x); }
__device__ __forceinline__ float sigm(float x) { return frcp(1.f + fexp2(-LOG2E * x)); }
__device__ __forceinline__ float silu(float x) { return x * sigm(x); }
__device__ __forceinline__ float wave_sum(float v) {
#pragma unroll
    for (int o = 1; o < 64; o <<= 1) v += __shfl_xor(v, o);
    return v;
}
__device__ __forceinline__ void unpack8(const u32x4 r, float (&x)[8]) {
    x[0] = bf2f(r.x & 0xffffu); x[1] = bf2f(r.x >> 16); x[2] = bf2f(r.y & 0xffffu); x[3] = bf2f(r.y >> 16);
    x[4] = bf2f(r.z & 0xffffu); x[5] = bf2f(r.z >> 16); x[6] = bf2f(r.w & 0xffffu); x[7] = bf2f(r.w >> 16);
}
__device__ __forceinline__ float rowscale(const float* ssq, int row) {
    const f32x4* p = (const f32x4*)(ssq + (size_t)row * 16); const f32x4 s = (p[0] + p[1]) + (p[2] + p[3]);
    return rsqrtf(((s.x + s.y) + (s.z + s.w)) * (1.f / 1024.f) + EPS);
}

constexpr int RTAB_OFF = 140288, RT_UNITS = 6;
template <class Sched> __device__ __forceinline__ void fill_rtab(const Sched& S, const float* ssq, LAS unsigned char* lds) {
    const int tid = opaque_tid(); LAS float* tab = (LAS float*)(lds + RTAB_OFF);
    float r[RT_UNITS]; bool ok[RT_UNITS];
#pragma unroll
    for (int i = 0; i < RT_UNITS; ++i) { Unit u; ok[i] = S.next(i, u); r[i] = (ok[i] && tid < 256) ? rowscale(ssq, u.pm * 256 + tid) : 0.f; }
#pragma unroll
    for (int i = 0; i < RT_UNITS; ++i) if (ok[i] && tid < 256) tab[i * 256 + tid] = r[i];
    __syncthreads();
}
struct EpiIn {
    static constexpr bool PERM = true, AFTER_DRAIN = false;
    bf16_t *U, *V, *Q, *KK, *I, *OG, *GT; float* GL; const float* ssq; const float* lb; float* VS; const LAS float* rtab; mutable int k;
    template <int SEG> __device__ __forceinline__ void body(const f32x4 (&acc)[2][2][4][2], const Unit& u, int wr, int wc, int fr, int fq) const {
        const int row0 = u.pm * 256 + wr * 64 + fr, pn = u.pn;
        bf16_t* base; int ldc, colt;
        if (SEG == 6) { base = GT; ldc = 2048; colt = (pn - 12) * 256; }
        else { ldc = 512; colt = (pn & 1) * 256; base = SEG == 0 ? U : SEG == 1 ? V : SEG == 2 ? Q : SEG == 3 ? KK : SEG == 4 ? I : OG; }
        const int col0 = colt + wc * 32 + 8 * fq;
        f32x4 lbq[2][2];
        if (SEG == 3) {
#pragma unroll
            for (int bj = 0; bj < 2; ++bj) { lbq[bj][0] = *(const f32x4*)(lb + col0 + bj * 128); lbq[bj][1] = *(const f32x4*)(lb + col0 + bj * 128 + 4); }
        }
#pragma unroll
        for (int ai = 0; ai < 2; ++ai)
#pragma unroll
            for (int m = 0; m < 4; ++m) {
                const int row = row0 + ai * 128 + m * 16; const float r = k < RT_UNITS ? rtab[k * 256 + ai * 128 + wr * 64 + m * 16 + fr] : rowscale(ssq, row);
                float st1 = 0.f, st2 = 0.f;
#pragma unroll
                for (int bj = 0; bj < 2; ++bj) {
                    const int c = col0 + bj * 128;
                    f32x4 v0 = acc[ai][bj][m][0] * r, v1 = acc[ai][bj][m][1] * r;
                    float o[8] = {v0[0], v0[1], v0[2], v0[3], v1[0], v1[1], v1[2], v1[3]};
                    if (SEG == 0 || SEG == 1) {
#pragma unroll
                        for (int e = 0; e < 8; e += 2) { f32x2 g = pg8::gelu_pk((f32x2){o[e], o[e + 1]}); o[e] = g.x; o[e + 1] = g.y; }
                        if (SEG == 1) {
#pragma unroll
                            for (int e = 0; e < 8; ++e) { st1 += o[e]; st2 += o[e] * o[e]; }
                        }
                    } else if (SEG == 2 || SEG == 5) {
#pragma unroll
                        for (int e = 0; e < 8; ++e) o[e] = silu(o[e]);
                    } else if (SEG == 6) {
#pragma unroll
                        for (int e = 0; e < 8; ++e) o[e] = sigm(o[e]);
                    } else if (SEG == 3) {
                        const f32x4 l0 = lbq[bj][0], l1 = lbq[bj][1];
                        const float lbv[8] = {l0[0], l0[1], l0[2], l0[3], l1[0], l1[1], l1[2], l1[3]};
                        float g2[8];
#pragma unroll
                        for (int e = 0; e < 8; ++e) {
                            const float f = fminf(fmaxf(o[e], -80.f), 80.f);
                            const float ex = fexp2(-LOG2E * f), sg = frcp(1.f + ex);
                            const float fg = lbv[e] + (1.f - lbv[e]) * sg;
                            g2[e] = __builtin_amdgcn_logf(fmaxf(fg, 1e-30f));
                            o[e] = (1.f - lbv[e]) * (ex * sg);
                        }
                        float* gp = GL + (size_t)row * 512 + c;
                        *(f32x4*)gp = (f32x4){g2[0], g2[1], g2[2], g2[3]}; *(f32x4*)(gp + 4) = (f32x4){g2[4], g2[5], g2[6], g2[7]};
                    }
                    u32x4 w; w.x = pk2(o[0], o[1]); w.y = pk2(o[2], o[3]); w.z = pk2(o[4], o[5]); w.w = pk2(o[6], o[7]);
                    *(u32x4*)(base + (size_t)row * ldc + c) = w;
                }
                if (SEG == 1) {
                    st1 += __shfl_xor(st1, 16); st1 += __shfl_xor(st1, 32); st2 += __shfl_xor(st2, 16); st2 += __shfl_xor(st2, 32);
                    if (fq == 0) *(f32x2*)(VS + (size_t)row * 16 + ((pn & 1) * 4 + wc) * 2) = (f32x2){st1, st2};
                }
                asm volatile("" ::: "memory");
            }
    }
    __device__ __forceinline__ void operator()(const f32x4 (&acc)[2][2][4][2], const Unit& u, int wr, int wc, int fr, int fq) const {
        const int seg = u.pn < 12 ? (u.pn >> 1) : 6;
        switch (seg) {
            case 0: body<0>(acc, u, wr, wc, fr, fq); break;
            case 1: body<1>(acc, u, wr, wc, fr, fq); break;
            case 2: body<2>(acc, u, wr, wc, fr, fq); break;
            case 3: body<3>(acc, u, wr, wc, fr, fq); break;
            case 4: body<4>(acc, u, wr, wc, fr, fq); break;
            case 5: body<5>(acc, u, wr, wc, fr, fq); break;
            default: body<6>(acc, u, wr, wc, fr, fq); break;
        }
        ++k;
    }
};
template <bool ADD> struct EpiBr {
    static constexpr bool PERM = true, AFTER_DRAIN = false;
    bf16_t* Y; const bf16_t* GT; int goff;
    __device__ __forceinline__ void operator()(const f32x4 (&acc)[2][2][4][2], const Unit& u, int wr, int wc, int fr, int fq) const {
        const int row0 = u.pm * 256 + wr * 64 + fr, col0 = u.pn * 256 + wc * 32 + 8 * fq;
        u32x4 gc[2], gn[2], yc[2], yn[2];
#pragma unroll
        for (int bj = 0; bj < 2; ++bj) { gc[bj] = *(const u32x4*)(GT + (size_t)row0 * 2048 + goff + col0 + bj * 128); if (ADD) yc[bj] = *(const u32x4*)(Y + (size_t)row0 * 1024 + col0 + bj * 128); }
#pragma unroll
        for (int gI = 0; gI < 8; ++gI) {
            const int ai = gI >> 2, m = gI & 3, row = row0 + ai * 128 + m * 16;
            if (gI < 7) { const int rn = row0 + ((gI + 1) >> 2) * 128 + ((gI + 1) & 3) * 16;
#pragma unroll
                for (int bj = 0; bj < 2; ++bj) { gn[bj] = *(const u32x4*)(GT + (size_t)rn * 2048 + goff + col0 + bj * 128); if (ADD) yn[bj] = *(const u32x4*)(Y + (size_t)rn * 1024 + col0 + bj * 128); } }
#pragma unroll
            for (int bj = 0; bj < 2; ++bj) {
                const int c = col0 + bj * 128;
                float g[8]; unpack8(gc[bj], g);
                const f32x4 v0 = acc[ai][bj][m][0], v1 = acc[ai][bj][m][1];
                float o[8] = {v0[0] * g[0], v0[1] * g[1], v0[2] * g[2], v0[3] * g[3], v1[0] * g[4], v1[1] * g[5], v1[2] * g[6], v1[3] * g[7]};
                if (ADD) { float y[8]; unpack8(yc[bj], y);
#pragma unroll
                    for (int e = 0; e < 8; ++e) o[e] += y[e]; }
                u32x4 w; w.x = pk2(o[0], o[1]); w.y = pk2(o[2], o[3]); w.z = pk2(o[4], o[5]); w.w = pk2(o[6], o[7]);
                *(u32x4*)(Y + (size_t)row * 1024 + c) = w;
            }
#pragma unroll
            for (int bj = 0; bj < 2; ++bj) { gc[bj] = gn[bj]; if (ADD) yc[bj] = yn[bj]; }
            asm volatile("" ::: "memory");
        }
    }
};
struct EpiRes {
    static constexpr bool PERM = true, AFTER_DRAIN = false;
    const bf16_t* xs; bf16_t* xb; float* ssq;
    __device__ __forceinline__ void operator()(const f32x4 (&acc)[2][2][4][2], const Unit& u, int wr, int wc, int fr, int fq) const {
        const int row0 = u.pm * 256 + wr * 64 + fr, col0 = u.pn * 256 + wc * 32 + 8 * fq;
        u32x4 cur[2], nxt[2];
#pragma unroll
        for (int bj = 0; bj < 2; ++bj) cur[bj] = *(const u32x4*)(xs + (size_t)row0 * 1024 + col0 + bj * 128);
#pragma unroll
        for (int gI = 0; gI < 8; ++gI) {
            const int ai = gI >> 2, m = gI & 3, row = row0 + ai * 128 + m * 16;
            if (gI < 7) { const int rn = row0 + ((gI + 1) >> 2) * 128 + ((gI + 1) & 3) * 16;
#pragma unroll
                for (int bj = 0; bj < 2; ++bj) nxt[bj] = *(const u32x4*)(xs + (size_t)rn * 1024 + col0 + bj * 128); }
            float ss = 0.f;
#pragma unroll
            for (int bj = 0; bj < 2; ++bj) {
                float x[8]; unpack8(cur[bj], x);
                const f32x4 v0 = acc[ai][bj][m][0], v1 = acc[ai][bj][m][1];
                u32x4 w; w.x = pk2(x[0] + v0[0], x[1] + v0[1]); w.y = pk2(x[2] + v0[2], x[3] + v0[3]); w.z = pk2(x[4] + v1[0], x[5] + v1[1]); w.w = pk2(x[6] + v1[2], x[7] + v1[3]);
                *(u32x4*)(xb + (size_t)row * 1024 + col0 + bj * 128) = w;
                float y[8]; unpack8(w, y);
#pragma unroll
                for (int e = 0; e < 8; ++e) ss += y[e] * y[e];
            }
            ss += __shfl_xor(ss, 16); ss += __shfl_xor(ss, 32);
            if (fq == 0) ssq[(size_t)row * 16 + u.pn * 4 + wc] = ss;
#pragma unroll
            for (int bj = 0; bj < 2; ++bj) cur[bj] = nxt[bj];
            asm volatile("" ::: "memory");
        }
    }
};
__device__ __forceinline__ float dpp_ror1(float v) { return __int_as_float(__builtin_amdgcn_update_dpp(__float_as_int(v), __float_as_int(v), 0x121, 0xf, 0xf, false)); }
__device__ __forceinline__ float dpp_ror2(float v) { return __int_as_float(__builtin_amdgcn_update_dpp(__float_as_int(v), __float_as_int(v), 0x122, 0xf, 0xf, false)); }
struct EpiUp {
    static constexpr bool PERM = true, AFTER_DRAIN = false;
    bf16_t* AC; bf16_t* H; const float* ssq; const float* cw; const float* cb; LAS float* wl; const LAS float* rtab; mutable int k;
    __device__ __forceinline__ void operator()(const f32x4 (&acc)[2][2][4][2], const Unit& u, int wr, int wc, int fr, int fq) const {
        const int rowb = u.pm * 256 + wr * 64 + fr, cl = u.pn * 128 + wc * 32 + 8 * fq;
        LAS float* wv = wl + (wr * 4 + wc) * 256;
        {
            const int lane = fq * 16 + fr, kind = lane >> 3, c4 = (lane & 7) * 4, cg = u.pn * 128 + wc * 32 + c4 + (kind >= 4 ? DFF : 0), kk = kind & 3;
            const f32x4 v = *(const f32x4*)((kk == 3 ? cb : cw + kk * NUP) + cg);
            *(LAS f32x4*)(wv + kind * 32 + c4) = v;
            asm volatile("s_waitcnt lgkmcnt(0)" ::: "memory");
        }
#pragma unroll
        for (int n = 0; n < 2; ++n) {
            const int c = cl + 4 * n; const LAS float* wp = wv + 8 * fq + 4 * n;
#pragma unroll
            for (int ai = 0; ai < 2; ++ai) {
                f32x4 pg1 = {0.f, 0.f, 0.f, 0.f}, pg2 = pg1, pv1 = pg1, pv2 = pg1;
#pragma unroll
                for (int m = 0; m < 4; ++m) {
                    const int row = rowb + ai * 128 + m * 16; const float r = k < RT_UNITS ? rtab[k * 256 + ai * 128 + wr * 64 + m * 16 + fr] : rowscale(ssq, row);
                    const f32x4 zg = acc[ai][0][m][n] * r, zv = acc[ai][1][m][n] * r;
                    f32x4 ag1, ag2, av1, av2, g1, g2, v1, v2;
#pragma unroll
                    for (int j = 0; j < 4; ++j) {
                        ag1[j] = dpp_ror1(zg[j]); ag2[j] = dpp_ror2(zg[j]); av1[j] = dpp_ror1(zv[j]); av2[j] = dpp_ror2(zv[j]);
                        g1[j] = fr >= 1 ? ag1[j] : pg1[j]; g2[j] = fr >= 2 ? ag2[j] : pg2[j];
                        v1[j] = fr >= 1 ? av1[j] : pv1[j]; v2[j] = fr >= 2 ? av2[j] : pv2[j];
                    }
                    const f32x4 zcg = *(const LAS f32x4*)(wp + 96) + *(const LAS f32x4*)(wp) * g2 + *(const LAS f32x4*)(wp + 32) * g1 + *(const LAS f32x4*)(wp + 64) * zg;
                    const f32x4 zcv = *(const LAS f32x4*)(wp + 224) + *(const LAS f32x4*)(wp + 128) * v2 + *(const LAS f32x4*)(wp + 160) * v1 + *(const LAS f32x4*)(wp + 192) * zv;
                    u32x2 o; o.x = pk2(silu(zcg[0]) * zcv[0], silu(zcg[1]) * zcv[1]); o.y = pk2(silu(zcg[2]) * zcv[2], silu(zcg[3]) * zcv[3]);
                    if (m != 0 || fr >= 2) *(u32x2*)(AC + (size_t)row * DFF + c) = o;
                    if ((m == 0 && fr < 2) || (m == 3 && fr >= 14)) {
                        const int slot = m == 0 ? fr : fr - 12;
                        bf16_t* hp = H + ((size_t)(row >> 6) * 4 + slot) * NUP + c;
                        u32x2 hg; hg.x = pk2(zg[0], zg[1]); hg.y = pk2(zg[2], zg[3]); *(u32x2*)hp = hg;
                        u32x2 hv; hv.x = pk2(zv[0], zv[1]); hv.y = pk2(zv[2], zv[3]); *(u32x2*)(hp + DFF) = hv;
                    }
                    pg1 = ag1; pg2 = ag2; pv1 = av1; pv2 = av2;
                    asm volatile("" ::: "memory"); __builtin_amdgcn_sched_barrier(0);
                }
            }
        }
        ++k;
    }
};

template <bool UPMAP = false> __device__ __forceinline__ void transpose_item(const float* W, int K, int N, bf16_t* WT, LAS float* scr, int item, int lane, const float* gk = nullptr) {
    const int nblk = N / 32, kb = item / nblk, nb = item % nblk, k0 = 64 * kb, n0 = 32 * nb;
    const int r0 = !UPMAP ? n0 : (n0 < DFF ? (n0 >> 7) * 256 + (n0 & 127) : ((n0 - DFF) >> 7) * 256 + 128 + ((n0 - DFF) & 127));
    f32x4 wv[8];
#pragma unroll
    for (int i = 0; i < 8; ++i) wv[i] = *(const f32x4*)(W + (size_t)(k0 + 8 * i + (lane >> 3)) * N + n0 + (lane & 7) * 4);
#pragma unroll
    for (int i = 0; i < 8; ++i) { const int kk = 8 * i + (lane >> 3); const float gsc = gk ? gk[k0 + kk] : 1.f; LAS float* sp = scr + kk * 33 + (lane & 7) * 4;
        sp[0] = wv[i][0] * gsc; sp[1] = wv[i][1] * gsc; sp[2] = wv[i][2] * gsc; sp[3] = wv[i][3] * gsc; }
    asm volatile("s_waitcnt lgkmcnt(0)" ::: "memory");
    const int c = lane & 7;
#pragma unroll
    for (int j = 0; j < 4; ++j) { const int n = (lane >> 3) + 8 * j; const LAS float* s = scr + (8 * c) * 33 + n;
        u32x4 o; o.x = pk2(s[0 * 33], s[1 * 33]); o.y = pk2(s[2 * 33], s[3 * 33]); o.z = pk2(s[4 * 33], s[5 * 33]); o.w = pk2(s[6 * 33], s[7 * 33]);
        *(u32x4*)(WT + (size_t)(r0 + n) * K + k0 + 8 * c) = o; }
    asm volatile("s_waitcnt lgkmcnt(0)" ::: "memory");
}
__device__ __forceinline__ void convert_set(const Args& a, LAS unsigned char* lds, int set, int l, int first_block = 0, int n_blocks = 0) {
    const int tid = opaque_tid(), lane = tid & 63, wave = tid >> 6;
    LAS float* scr = (LAS float*)(lds + wave * 16384);
    if (n_blocks == 0) n_blocks = gridDim.x;
    if ((int)blockIdx.x < first_block || (int)blockIdx.x >= first_block + n_blocks) return;
    const int gw = ((int)blockIdx.x - first_block) * 8 + wave, NGW = n_blocks * 8;
    unsigned char* ws = a.ws;
    if (set == 0) {
        constexpr int I0 = (D / 64) * (INC / 32), I1 = (512 / 64) * (D / 32), I3 = (D / 64) * (D / 32), NI = I0 + 2 * I1 + I3;
        for (int it = gw; it < NI; it += NGW) {
            int r = it;
            if (r < I0) { transpose_item(a.w_in + (size_t)l * D * INC, D, INC, (bf16_t*)(ws + WS_WIN), scr, r, lane, a.mix_norm + l * D); continue; } r -= I0;
            if (r < I1) { transpose_item(a.w_br_gm + (size_t)l * 512 * D, 512, D, (bf16_t*)(ws + WS_WGM), scr, r, lane); continue; } r -= I1;
            if (r < I1) { transpose_item(a.w_br_hg + (size_t)l * 512 * D, 512, D, (bf16_t*)(ws + WS_WHG), scr, r, lane); continue; } r -= I1;
            transpose_item(a.w_out + (size_t)l * D * D, D, D, (bf16_t*)(ws + WS_WOUT), scr, r, lane);
        }
    } else {
        constexpr int I0 = (D / 64) * (NUP / 32), I1 = (DFF / 64) * (D / 32), NI = I0 + I1;
        for (int it = gw; it < NI; it += NGW) {
            int r = it;
            if (r < I0) { transpose_item<true>(a.w_up + (size_t)l * D * NUP, D, NUP, (bf16_t*)(ws + WS_WUP + (l & 1) * WS_FFNW_STRIDE), scr, r, lane, a.ffn_norm + l * D); continue; } r -= I0;
            transpose_item(a.w_down + (size_t)l * DFF * D, DFF, D, (bf16_t*)(ws + WS_WDN + (l & 1) * WS_FFNW_STRIDE), scr, r, lane);
        }
    }
}

#define LDS_BARRIER() asm volatile("s_waitcnt lgkmcnt(0)\n\ts_barrier" ::: "memory")
constexpr int LDQ = 136, LDV = 72, LDG = 132;
__device__ __forceinline__ bf16x8 ldfrag(const LAS bf16_t* base, int ld, int fr, int fq, int k0) { return *(const LAS bf16x8*)(base + fr * ld + k0 + fq * 8); }
#define MMA16(xf, yf, acc) __builtin_amdgcn_mfma_f32_16x16x32_bf16((xf), (yf), (acc), 0, 0, 0)

__device__ __forceinline__ void gmlp_unit(const Args& a, LAS unsigned char* lds, int unit, int l, bool load_w) {
    const int tid = opaque_tid(), lane = tid & 63, w = tid >> 6, fr = lane & 15, fq = lane >> 4;
    const int h = unit & 3, blk = (unit >> 2) & 63, b = unit >> 8;
    const size_t r0 = (size_t)b * SEQ + (size_t)blk * 128;
    LAS bf16_t* Vt = (LAS bf16_t*)lds;
    LAS bf16_t* Wl = Vt + 128 * LDQ;
    LAS f32x2* stat = (LAS f32x2*)(Wl + 128 * LDQ);
    const bf16_t* Vg = (const bf16_t*)(a.ws + WS_V); bf16_t* Ug = (bf16_t*)(a.ws + WS_U);
    const float* lng = a.gm_ln_g + l * 512; const float* lnb = a.gm_ln_b + l * 512;
    const float* wsrc = a.gm_ws + (size_t)(l * 4 + h) * 16384;
    u32x4 vraw[4]; f32x4 wreg[8];
#pragma unroll
    for (int it = 0; it < 4; ++it) vraw[it] = *(const u32x4*)(Vg + (r0 + (it & 1) * 64 + lane) * 512 + h * 128 + ((it >> 1) * 8 + w) * 8);
#pragma unroll
    for (int it = 0; it < 8; ++it) { const int idx = it * 512 + tid; wreg[it] = load_w ? *(const f32x4*)(wsrc + (idx >> 5) * 128 + (idx & 31) * 4) : (f32x4){0.f, 0.f, 0.f, 0.f}; }
    f32x4 lg[2][2], lb2[2][2];
#pragma unroll
    for (int q = 0; q < 2; ++q) { const int cg0 = h * 128 + (q * 8 + w) * 8; lg[q][0] = *(const f32x4*)(lng + cg0); lg[q][1] = *(const f32x4*)(lng + cg0 + 4); lb2[q][0] = *(const f32x4*)(lnb + cg0); lb2[q][1] = *(const f32x4*)(lnb + cg0 + 4); }
    if (tid < 128) {
        const f32x4* vp = (const f32x4*)((const float*)(a.ws + WS_VS) + (r0 + tid) * 16);
        const f32x4 p0 = vp[0], p1 = vp[1], p2 = vp[2], p3 = vp[3];
        const float s1 = ((p0[0] + p0[2]) + (p1[0] + p1[2])) + ((p2[0] + p2[2]) + (p3[0] + p3[2])), s2 = ((p0[1] + p0[3]) + (p1[1] + p1[3])) + ((p2[1] + p2[3]) + (p3[1] + p3[3]));
        const float mean = s1 * (1.f / 512.f), var = fmaxf(s2 * (1.f / 512.f) - mean * mean, 0.f);
        stat[tid] = (f32x2){mean, rsqrtf(var + EPS)};
    }
    if (load_w)
#pragma unroll
    for (int it = 0; it < 8; ++it) {
        const int idx = it * 512 + tid, i = idx >> 5, j4 = (idx & 31) * 4;
        f32x4 wv = wreg[it];
        if ((i >> 6) < (j4 >> 6)) wv = (f32x4){0.f, 0.f, 0.f, 0.f};
        u32x2 o; o.x = pk2(wv[0], wv[1]); o.y = pk2(wv[2], wv[3]);
        *(LAS u32x2*)(Wl + i * LDQ + j4) = o;
    }
    LDS_BARRIER();
#pragma unroll
    for (int it = 0; it < 4; ++it) {
        const int j = (it & 1) * 64 + lane, d0 = ((it >> 1) * 8 + w) * 8;
        const f32x2 st = stat[j];
        float x[8]; unpack8(vraw[it], x);
#pragma unroll
        for (int e = 0; e < 8; ++e) Vt[(d0 + e) * LDQ + j] = (bf16_t)f2bf((x[e] - st.x) * st.y * lg[it >> 1][e >> 2][e & 3] + lb2[it >> 1][e >> 2][e & 3]);
    }
    LDS_BARRIER();
    bf16x8 af[4];
#pragma unroll
    for (int ks = 0; ks < 4; ++ks) af[ks] = ldfrag(Wl + (w * 16) * LDQ, LDQ, fr, fq, ks * 32);
    const int i = w * 16 + fr; const float bias = a.gm_bs[(l * 4 + h) * 128 + i];
    u32x2 ureg[8];
#pragma unroll
    for (int dt = 0; dt < 8; ++dt) ureg[dt] = *(const u32x2*)(Ug + (r0 + i) * 512 + h * 128 + dt * 16 + 4 * fq);
#pragma unroll
    for (int dt = 0; dt < 8; ++dt) {
        f32x4 acc = {0.f, 0.f, 0.f, 0.f};
#pragma unroll
        for (int ks = 0; ks < 4; ++ks) if (ks < 2 || w >= 4) acc = MMA16(ldfrag(Vt + (dt * 16) * LDQ, LDQ, fr, fq, ks * 32), af[ks], acc);
        bf16_t* up = Ug + (r0 + i) * 512 + h * 128 + dt * 16 + 4 * fq;
        const u32x2 uu = ureg[dt];
        u32x2 o; o.x = pk2(bf2f(uu.x & 0xffffu) * (acc[0] + bias), bf2f(uu.x >> 16) * (acc[1] + bias));
        o.y = pk2(bf2f(uu.y & 0xffffu) * (acc[2] + bias), bf2f(uu.y >> 16) * (acc[3] + bias));
        *(u32x2*)up = o;
    }
    LDS_BARRIER();
}

__device__ __forceinline__ void hg1_unit(const Args& a, LAS unsigned char* lds, int unit) {
    const int tid = opaque_tid(), lane = tid & 63, w = tid >> 6, fr = lane & 15, fq = lane >> 4;
    const int c = unit & 127, bh = unit >> 7, h = bh & 3, b = bh >> 2;
    const size_t r0 = (size_t)b * SEQ + (size_t)c * 64;
    LAS float* Gs = (LAS float*)lds;
    LAS float* Tot = Gs + 64 * LDG;
    LAS bf16_t* Vt = (LAS bf16_t*)(lds + 64 * LDG * 4 + 2048);
    LAS bf16_t* Kt = Vt + 128 * LDV;
    float* GLg = (float*)(a.ws + WS_GL); const bf16_t* Ig = (const bf16_t*)(a.ws + WS_I); const bf16_t* Kg = (const bf16_t*)(a.ws + WS_KK);
    const int d = tid & 127, sg = tid >> 7;
    float* gp = GLg + (r0 + sg * 16) * 512 + h * 128 + d;
    float g[16];
#pragma unroll
    for (int j = 0; j < 16; ++j) g[j] = gp[(size_t)j * 512];
#pragma unroll
    for (int j = 1; j < 16; ++j) g[j] += g[j - 1];
    Tot[sg * 128 + d] = g[15];
    u32x4 kraw[2], vraw[2];
#pragma unroll
    for (int it = 0; it < 2; ++it) { const int idx = it * 512 + tid; const size_t go = (r0 + (idx >> 4)) * 512 + h * 128 + (idx & 15) * 8; vraw[it] = *(const u32x4*)(Ig + go); kraw[it] = *(const u32x4*)(Kg + go); }
#pragma unroll
    for (int it = 0; it < 2; ++it) {
        const int idx = it * 512 + tid, j = idx >> 4, e0 = (idx & 15) * 8;
        const u32x4 raw = vraw[it];
        const unsigned rw[4] = {raw.x, raw.y, raw.z, raw.w};
#pragma unroll
        for (int e = 0; e < 8; ++e) Vt[(e0 + e) * LDV + j] = (bf16_t)((rw[e >> 1] >> ((e & 1) * 16)) & 0xffffu);
    }
    LDS_BARRIER();
    float off = 0.f;
#pragma unroll
    for (int s = 0; s < 3; ++s) off += (s < sg) ? Tot[s * 128 + d] : 0.f;
#pragma unroll
    for (int j = 0; j < 16; ++j) { g[j] += off; gp[(size_t)j * 512] = g[j]; Gs[(sg * 16 + j) * LDG + d] = g[j]; }
    LDS_BARRIER();
#pragma unroll
    for (int it = 0; it < 2; ++it) {
        const int idx = it * 512 + tid, j = idx >> 4, d0 = (idx & 15) * 8;
        float kv[8]; unpack8(kraw[it], kv);
#pragma unroll
        for (int e = 0; e < 8; ++e) Kt[(d0 + e) * LDV + j] = (bf16_t)f2bf(kv[e] * fexp2(Gs[63 * LDG + d0 + e] - Gs[j * LDG + d0 + e]));
    }
    if (tid < 128) ((float*)(a.ws + WS_DEC))[(size_t)unit * 128 + tid] = fexp2(Gs[63 * LDG + tid]);
    LDS_BARRIER();
    bf16x8 af[2];
#pragma unroll
    for (int ks = 0; ks < 2; ++ks) af[ks] = ldfrag(Vt + (w * 16) * LDV, LDV, fr, fq, ks * 32);
    float* STg = (float*)(a.ws + WS_ST) + (size_t)unit * 16384;
#pragma unroll
    for (int dt = 0; dt < 8; ++dt) {
        f32x4 acc = {0.f, 0.f, 0.f, 0.f};
#pragma unroll
        for (int ks = 0; ks < 2; ++ks) acc = MMA16(ldfrag(Kt + (dt * 16) * LDV, LDV, fr, fq, ks * 32), af[ks], acc);
        *(f32x4*)(STg + (w * 16 + fr) * 128 + dt * 16 + 4 * fq) = acc;
    }
    LDS_BARRIER();
}

__device__ __forceinline__ void hg_scan(const Args& a) {
    float* ST = (float*)(a.ws + WS_ST); const float* DEC = (const float*)(a.ws + WS_DEC);
    for (int idx = blockIdx.x * 512 + opaque_tid(); idx < 8 * 8192; idx += gridDim.x * 512) {
        const int bh = idx >> 13, ed = (idx & 8191) * 2, d = ed & 127;
        float* p = ST + (size_t)bh * 128 * 16384 + ed; const float* dc = DEC + (size_t)bh * 128 * 128 + d;
        f32x2 S = {0.f, 0.f};
#pragma unroll 32
        for (int c = 0; c < 128; ++c) { const f32x2 u = *(const f32x2*)(p + (size_t)c * 16384); const f32x2 dec = *(const f32x2*)(dc + c * 128); *(f32x2*)(p + (size_t)c * 16384) = S; S = dec * S + u; }
    }
}

__device__ __forceinline__ void hg3_unit(const Args& a, LAS unsigned char* lds, int unit, int l) {
    const int tid = opaque_tid(), lane = tid & 63, w = tid >> 6, fr = lane & 15, fq = lane >> 4;
    const int c = unit & 127, bh = unit >> 7, h = bh & 3, b = bh >> 2;
    const size_t r0 = (size_t)b * SEQ + (size_t)c * 64;
    LAS bf16_t* Qh = (LAS bf16_t*)lds;
    LAS bf16_t* Qt = Qh + 64 * LDQ;
    LAS bf16_t* Kh = Qt + 64 * LDQ;
    LAS bf16_t* Vt = Kh + 160 * LDQ;
    LAS bf16_t* As = Vt + 128 * LDV;
    LAS bf16_t* Sts = Kh;
    LAS float* Os = (LAS float*)Qh;
    const float* GLg = (const float*)(a.ws + WS_GL); const bf16_t* Ig = (const bf16_t*)(a.ws + WS_I);
    const bf16_t* Qg = (const bf16_t*)(a.ws + WS_Q); const bf16_t* Kg = (const bf16_t*)(a.ws + WS_KK);
    const float* STg = (const float*)(a.ws + WS_ST) + (size_t)unit * 16384;
    f32x4 sreg[8]; unsigned ogreg[8];
    bf16_t* OGg = (bf16_t*)(a.ws + WS_OG);
#pragma unroll
    for (int it = 0; it < 8; ++it) { const int idx = it * 512 + tid; sreg[it] = *(const f32x4*)(STg + (idx >> 5) * 128 + (idx & 31) * 4); }
#pragma unroll
    for (int rr = 0; rr < 8; ++rr) ogreg[rr] = *(const unsigned*)(OGg + (r0 + w * 8 + rr) * 512 + h * 128 + 2 * lane);
#pragma unroll
    for (int it = 0; it < 2; ++it) {
        const int idx = it * 512 + tid, j = idx >> 4, d0 = (idx & 15) * 8;
        const int J = __builtin_amdgcn_readfirstlane(j >> 4);
        const size_t go = (r0 + j) * 512 + h * 128 + d0;
        float qv[8], kv[8]; unpack8(*(const u32x4*)(Qg + go), qv); unpack8(*(const u32x4*)(Kg + go), kv);
        const f32x4 ga = *(const f32x4*)(GLg + go), gb = *(const f32x4*)(GLg + go + 4);
        const float gj[8] = {ga[0], ga[1], ga[2], ga[3], gb[0], gb[1], gb[2], gb[3]};
        const u32x4 raw = *(const u32x4*)(Ig + go);
        {
            u32x4 o; o.x = pk2(qv[0] * fexp2(gj[0]), qv[1] * fexp2(gj[1])); o.y = pk2(qv[2] * fexp2(gj[2]), qv[3] * fexp2(gj[3]));
            o.z = pk2(qv[4] * fexp2(gj[4]), qv[5] * fexp2(gj[5])); o.w = pk2(qv[6] * fexp2(gj[6]), qv[7] * fexp2(gj[7]));
            *(LAS u32x4*)(Qt + j * LDQ + d0) = o;
        }
#pragma unroll
        for (int I = 0; I < 4; ++I) {
            if (I >= J) {
                const size_t ro = (r0 + 16 * I) * 512 + h * 128 + d0;
                const f32x4 ra = *(const f32x4*)(GLg + ro), rb = *(const f32x4*)(GLg + ro + 4);
                const float rf[8] = {ra[0], ra[1], ra[2], ra[3], rb[0], rb[1], rb[2], rb[3]};
                float kh[8];
#pragma unroll
                for (int e = 0; e < 8; ++e) kh[e] = kv[e] * fexp2(fminf(rf[e] - gj[e], 120.f));
                u32x4 o; o.x = pk2(kh[0], kh[1]); o.y = pk2(kh[2], kh[3]); o.z = pk2(kh[4], kh[5]); o.w = pk2(kh[6], kh[7]);
                *(LAS u32x4*)(Kh + (8 * I * (I + 1) + j) * LDQ + d0) = o;
                if (I == J) {
                    u32x4 q; q.x = pk2(qv[0] * fexp2(gj[0] - rf[0]), qv[1] * fexp2(gj[1] - rf[1])); q.y = pk2(qv[2] * fexp2(gj[2] - rf[2]), qv[3] * fexp2(gj[3] - rf[3]));
                    q.z = pk2(qv[4] * fexp2(gj[4] - rf[4]), qv[5] * fexp2(gj[5] - rf[5])); q.w = pk2(qv[6] * fexp2(gj[6] - rf[6]), qv[7] * fexp2(gj[7] - rf[7]));
                    *(LAS u32x4*)(Qh + j * LDQ + d0) = q;
                }
            }
        }
        const unsigned rw[4] = {raw.x, raw.y, raw.z, raw.w};
#pragma unroll
        for (int e = 0; e < 8; ++e) Vt[(d0 + e) * LDV + j] = (bf16_t)((rw[e >> 1] >> ((e & 1) * 16)) & 0xffffu);
    }
    for (int idx = tid; idx < 64 * LDV / 8; idx += 512) *(LAS u32x4*)(As + idx * 8) = (u32x4){0u, 0u, 0u, 0u};
    LDS_BARRIER();
#pragma unroll 1
    for (int t = w; t < 10; t += 8) {
        const int I = t >= 6 ? 3 : t >= 3 ? 2 : t >= 1 ? 1 : 0, J = t - (I * (I + 1)) / 2;
        f32x4 acc = {0.f, 0.f, 0.f, 0.f};
#pragma unroll
        for (int ks = 0; ks < 4; ++ks) acc = MMA16(ldfrag(Kh + (8 * I * (I + 1) + 16 * J) * LDQ, LDQ, fr, fq, ks * 32), ldfrag(Qh + (16 * I) * LDQ, LDQ, fr, fq, ks * 32), acc);
        if (I == J) {
#pragma unroll
            for (int r = 0; r < 4; ++r) acc[r] = (4 * fq + r <= fr) ? acc[r] : 0.f;
        }
        u32x2 o; o.x = pk2(acc[0], acc[1]); o.y = pk2(acc[2], acc[3]);
        *(LAS u32x2*)(As + (16 * I + fr) * LDV + 16 * J + 4 * fq) = o;
    }
    LDS_BARRIER();
#pragma unroll
    for (int it = 0; it < 8; ++it) {
        const int idx = it * 512 + tid, e = idx >> 5, d4 = (idx & 31) * 4;
        const f32x4 sv = sreg[it];
        u32x2 o; o.x = pk2(sv[0], sv[1]); o.y = pk2(sv[2], sv[3]);
        *(LAS u32x2*)(Sts + e * LDQ + d4) = o;
    }
    LDS_BARRIER();
    {
        const int it = w & 3, eb = (w >> 2) * 4;
        bf16x8 af[2], qf[4];
#pragma unroll
        for (int ks = 0; ks < 2; ++ks) af[ks] = ldfrag(As + (it * 16) * LDV, LDV, fr, fq, ks * 32);
#pragma unroll
        for (int ks = 0; ks < 4; ++ks) qf[ks] = ldfrag(Qt + (it * 16) * LDQ, LDQ, fr, fq, ks * 32);
        LDS_BARRIER();
#pragma unroll
        for (int t = 0; t < 4; ++t) {
            const int et = eb + t; f32x4 acc = {0.f, 0.f, 0.f, 0.f};
#pragma unroll
            for (int ks = 0; ks < 2; ++ks) acc = MMA16(ldfrag(Vt + (et * 16) * LDV, LDV, fr, fq, ks * 32), af[ks], acc);
#pragma unroll
            for (int ks = 0; ks < 4; ++ks) acc = MMA16(ldfrag(Sts + (et * 16) * LDQ, LDQ, fr, fq, ks * 32), qf[ks], acc);
            *(LAS f32x4*)(Os + (it * 16 + fr) * LDG + et * 16 + 4 * fq) = acc;
        }
    }
    LDS_BARRIER();
    {
        const f32x2 ng = *(const f32x2*)(a.hg_norm_g + l * 128 + 2 * lane);
#pragma unroll
        for (int rr = 0; rr < 8; ++rr) {
            const int i = w * 8 + rr;
            const f32x2 o = *(const LAS f32x2*)(Os + i * LDG + 2 * lane);
            const float r = rsqrtf(wave_sum(o.x * o.x + o.y * o.y) * (1.f / 128.f) + EPS);
            unsigned* op = (unsigned*)(OGg + (r0 + i) * 512 + h * 128 + 2 * lane);
            const unsigned og = ogreg[rr];
            *op = pk2(o.x * r * ng.x * bf2f(og & 0xffffu), o.y * r * ng.y * bf2f(og >> 16));
        }
    }
    LDS_BARRIER();
}

constexpr int HG_GC = 4, HG_NG = (SEQ / 64) / HG_GC;
__device__ __forceinline__ void hg1g_unit(const Args& a, LAS unsigned char* lds, int unit) {
    const int tid = opaque_tid(), lane = tid & 63, w = tid >> 6, fr = lane & 15, fq = lane >> 4;
    const int cg = unit % HG_NG, bh = unit / HG_NG, h = bh & 3, b = bh >> 2;
    LAS float* Gs = (LAS float*)lds;
    LAS float* Tot = Gs + 64 * LDG;
    LAS bf16_t* Vt = (LAS bf16_t*)(lds + 64 * LDG * 4 + 2048);
    LAS bf16_t* Kt = Vt + 128 * LDV;
    float* GLg = (float*)(a.ws + WS_GL); const bf16_t* Ig = (const bf16_t*)(a.ws + WS_I); const bf16_t* Kg = (const bf16_t*)(a.ws + WS_KK);
    const int d = tid & 127, sg = tid >> 7;
    f32x4 acc[8];
#pragma unroll
    for (int dt = 0; dt < 8; ++dt) acc[dt] = (f32x4){0.f, 0.f, 0.f, 0.f};
    float dsum = 0.f;
#pragma unroll 1
    for (int s = 0; s < HG_GC; ++s) {
        const size_t r0 = (size_t)b * SEQ + (size_t)(cg * HG_GC + s) * 64;
        float* gp = GLg + (r0 + sg * 16) * 512 + h * 128 + d;
        float g[16];
#pragma unroll
        for (int j = 0; j < 16; ++j) g[j] = gp[(size_t)j * 512];
        u32x4 kraw[2], vraw[2];
#pragma unroll
        for (int it = 0; it < 2; ++it) { const size_t go = (r0 + lane) * 512 + h * 128 + (it * 8 + w) * 8; vraw[it] = *(const u32x4*)(Ig + go); kraw[it] = *(const u32x4*)(Kg + go); }
#pragma unroll
        for (int j = 1; j < 16; ++j) g[j] += g[j - 1];
        Tot[sg * 128 + d] = g[15];
#pragma unroll
        for (int it = 0; it < 2; ++it) {
            const int j = lane, e0 = (it * 8 + w) * 8;
            const unsigned rw[4] = {vraw[it].x, vraw[it].y, vraw[it].z, vraw[it].w};
#pragma unroll
            for (int e = 0; e < 8; ++e) Vt[(e0 + e) * LDV + j] = (bf16_t)((rw[e >> 1] >> ((e & 1) * 16)) & 0xffffu);
        }
        LDS_BARRIER();
        float off = 0.f;
#pragma unroll
        for (int q = 0; q < 3; ++q) off += (q < sg) ? Tot[q * 128 + d] : 0.f;
#pragma unroll
        for (int j = 0; j < 16; ++j) { g[j] += off; gp[(size_t)j * 512] = g[j]; Gs[(sg * 16 + j) * LDG + d] = g[j]; }
        LDS_BARRIER();
#pragma unroll
        for (int it = 0; it < 2; ++it) {
            const int j = lane, d0 = (it * 8 + w) * 8;
            float kv[8]; unpack8(kraw[it], kv);
            const f32x4 la = *(const LAS f32x4*)(Gs + 63 * LDG + d0), lb = *(const LAS f32x4*)(Gs + 63 * LDG + d0 + 4), ja = *(const LAS f32x4*)(Gs + j * LDG + d0), jb = *(const LAS f32x4*)(Gs + j * LDG + d0 + 4);
            const float dl[8] = {la[0] - ja[0], la[1] - ja[1], la[2] - ja[2], la[3] - ja[3], lb[0] - jb[0], lb[1] - jb[1], lb[2] - jb[2], lb[3] - jb[3]};
#pragma unroll
            for (int e = 0; e < 8; ++e) Kt[(d0 + e) * LDV + j] = (bf16_t)f2bf(kv[e] * fexp2(dl[e]));
        }
        if (tid < 128) { const float g63 = Gs[63 * LDG + tid]; dsum += g63; Tot[tid] = fexp2(g63); }
        LDS_BARRIER();
        bf16x8 af[2];
#pragma unroll
        for (int ks = 0; ks < 2; ++ks) af[ks] = ldfrag(Vt + (w * 16) * LDV, LDV, fr, fq, ks * 32);
#pragma unroll
        for (int dt = 0; dt < 8; ++dt) {
            acc[dt] = acc[dt] * *(const LAS f32x4*)(Tot + dt * 16 + 4 * fq);
#pragma unroll
            for (int ks = 0; ks < 2; ++ks) acc[dt] = MMA16(ldfrag(Kt + (dt * 16) * LDV, LDV, fr, fq, ks * 32), af[ks], acc[dt]);
        }
        LDS_BARRIER();
    }
    float* TGg = (float*)(a.ws + WS_ST) + (size_t)unit * 16384;
#pragma unroll
    for (int dt = 0; dt < 8; ++dt) *(f32x4*)(TGg + (w * 16 + fr) * 128 + dt * 16 + 4 * fq) = acc[dt];
    if (tid < 128) ((float*)(a.ws + WS_DEC))[(size_t)unit * 128 + tid] = fexp2(dsum);
}
__device__ __forceinline__ void hg_gscan(const Args& a) {
    const float* TG = (const float*)(a.ws + WS_ST); float* SG = (float*)(a.ws + WS_ST + 16 * MiB); const float* DG = (const float*)(a.ws + WS_DEC);
    for (int idx = blockIdx.x * 512 + opaque_tid(); idx < 8 * 16384; idx += gridDim.x * 512) {
        const int bh = idx >> 14, ed = idx & 16383, d = ed & 127;
        const float* p = TG + (size_t)bh * HG_NG * 16384 + ed; float* q = SG + (size_t)bh * HG_NG * 16384 + ed; const float* dc = DG + (size_t)bh * HG_NG * 128 + d;
        float S = 0.f;
#pragma unroll
        for (int c = 0; c < HG_NG; ++c) { const float u = p[(size_t)c * 16384]; const float dec = dc[c * 128]; q[(size_t)c * 16384] = S; S = dec * S + u; }
    }
}
__device__ __forceinline__ void hg3g_unit(const Args& a, LAS unsigned char* lds, int unit, int l, unsigned long long& pr_acc) {
    unsigned long long pt0 = 0;
#define HP_B(bit) do { if ((PROBE_MASK) & (bit)) pt0 = __builtin_amdgcn_s_memrealtime(); } while (0)
#define HP_E(bit) do { if ((PROBE_MASK) & (bit)) pr_acc += __builtin_amdgcn_s_memrealtime() - pt0; } while (0)
    const int tid = opaque_tid(), lane = tid & 63, w = tid >> 6, fr = lane & 15, fq = lane >> 4;
    const int cg = unit % HG_NG, bh = unit / HG_NG, h = bh & 3, b = bh >> 2;
    LAS bf16_t* Qh = (LAS bf16_t*)lds;
    LAS bf16_t* Qt = Qh + 64 * LDQ;
    LAS bf16_t* Kh = Qt + 64 * LDQ;
    LAS bf16_t* Vt = Kh + 160 * LDQ;
    LAS bf16_t* As = Vt + 128 * LDV;
    LAS bf16_t* Sts = As + 64 * LDV;
    LAS float* Os = (LAS float*)Qh;
    LAS bf16_t* Kt = Kh; LAS float* DecL = (LAS float*)(Kh + 128 * LDV);
    const float* GLg = (const float*)(a.ws + WS_GL); const bf16_t* Ig = (const bf16_t*)(a.ws + WS_I);
    const bf16_t* Qg = (const bf16_t*)(a.ws + WS_Q); const bf16_t* Kg = (const bf16_t*)(a.ws + WS_KK);
    bf16_t* OGg = (bf16_t*)(a.ws + WS_OG);
    f32x4 acc[8];
    {
        const float* TGg = (const float*)(a.ws + WS_ST + 16 * MiB) + (size_t)unit * 16384;
#pragma unroll
        for (int dt = 0; dt < 8; ++dt) acc[dt] = *(const f32x4*)(TGg + (w * 16 + fr) * 128 + dt * 16 + 4 * fq);
#pragma unroll
        for (int dt = 0; dt < 8; ++dt) { u32x2 o; o.x = pk2(acc[dt][0], acc[dt][1]); o.y = pk2(acc[dt][2], acc[dt][3]); *(LAS u32x2*)(Sts + (w * 16 + fr) * LDQ + dt * 16 + 4 * fq) = o; }
    }
    u32x4 nq[2], nk[2], nv[2]; f32x4 nga[2], ngb[2]; float ng63 = 0.f;
#define HG3_LOADS(R0) do { _Pragma("unroll") for (int it_ = 0; it_ < 2; ++it_) { const size_t go_ = ((R0) + 16 * ((it_ * 8 + w) >> 2) + (lane & 15)) * 512 + h * 128 + (((it_ * 8 + w) & 3) * 4 + (lane >> 4)) * 8; \
        nq[it_] = *(const u32x4*)(Qg + go_); nk[it_] = *(const u32x4*)(Kg + go_); nv[it_] = *(const u32x4*)(Ig + go_); nga[it_] = *(const f32x4*)(GLg + go_); ngb[it_] = *(const f32x4*)(GLg + go_ + 4); \
        } \
        if (tid < 128) ng63 = GLg[((R0) + 63) * 512 + h * 128 + tid]; } while (0)
    { const size_t rr0 = (size_t)b * SEQ + (size_t)(cg * HG_GC) * 64; HG3_LOADS(rr0); }
#pragma unroll 1
    for (int s = 0; s < HG_GC; ++s) {
        const size_t r0 = (size_t)b * SEQ + (size_t)(cg * HG_GC + s) * 64;
        HP_B(0x10000);
        unsigned ogreg[8]; u32x4 ktp[2]; u32x4 cq[2], ck[2], cv[2]; f32x4 cga[2], cgb[2];
        const float g63s = ng63;
        { const u32x4* ogp = (const u32x4*)(OGg + (r0 + w * 8 + (lane >> 3)) * 512 + h * 128 + (lane & 7) * 16); const u32x4 o0 = ogp[0], o1 = ogp[1];
          ogreg[0] = o0.x; ogreg[1] = o0.y; ogreg[2] = o0.z; ogreg[3] = o0.w; ogreg[4] = o1.x; ogreg[5] = o1.y; ogreg[6] = o1.z; ogreg[7] = o1.w; }
#pragma unroll
        for (int it = 0; it < 2; ++it) { cq[it] = nq[it]; ck[it] = nk[it]; cv[it] = nv[it]; cga[it] = nga[it]; cgb[it] = ngb[it]; }
        if (s + 1 < HG_GC) { const size_t rn = r0 + 64; HG3_LOADS(rn); }
#pragma unroll
        for (int it = 0; it < 2; ++it) {
            const int J = (it * 8 + w) >> 2, j = 16 * J + (lane & 15), d0 = (((it * 8 + w) & 3) * 4 + (lane >> 4)) * 8;
            float qv[8], kv[8]; unpack8(cq[it], qv); unpack8(ck[it], kv);
            const f32x4 ga = cga[it], gb = cgb[it];
            const float gj[8] = {ga[0], ga[1], ga[2], ga[3], gb[0], gb[1], gb[2], gb[3]};
            const u32x4 raw = cv[it];
            {
                const size_t lo = (r0 + 63) * 512 + h * 128 + d0;
                const f32x4 la = *(const f32x4*)(GLg + lo), lb = *(const f32x4*)(GLg + lo + 4);
                const float gl[8] = {la[0], la[1], la[2], la[3], lb[0], lb[1], lb[2], lb[3]};
                u32x4 o; o.x = pk2(kv[0] * fexp2(gl[0] - gj[0]), kv[1] * fexp2(gl[1] - gj[1])); o.y = pk2(kv[2] * fexp2(gl[2] - gj[2]), kv[3] * fexp2(gl[3] - gj[3]));
                o.z = pk2(kv[4] * fexp2(gl[4] - gj[4]), kv[5] * fexp2(gl[5] - gj[5])); o.w = pk2(kv[6] * fexp2(gl[6] - gj[6]), kv[7] * fexp2(gl[7] - gj[7]));
                ktp[it] = o;
            }
            {
                u32x4 o; o.x = pk2(qv[0] * fexp2(gj[0]), qv[1] * fexp2(gj[1])); o.y = pk2(qv[2] * fexp2(gj[2]), qv[3] * fexp2(gj[3]));
                o.z = pk2(qv[4] * fexp2(gj[4]), qv[5] * fexp2(gj[5])); o.w = pk2(qv[6] * fexp2(gj[6]), qv[7] * fexp2(gj[7]));
                *(LAS u32x4*)(Qt + j * LDQ + d0) = o;
            }
            {
                const size_t ro = (r0 + 16 * J) * 512 + h * 128 + d0;
                const f32x4 ra = *(const f32x4*)(GLg + ro), rb = *(const f32x4*)(GLg + ro + 4);
                const float rf[8] = {ra[0], ra[1], ra[2], ra[3], rb[0], rb[1], rb[2], rb[3]};
                u32x4 q; q.x = pk2(qv[0] * fexp2(gj[0] - rf[0]), qv[1] * fexp2(gj[1] - rf[1])); q.y = pk2(qv[2] * fexp2(gj[2] - rf[2]), qv[3] * fexp2(gj[3] - rf[3]));
                q.z = pk2(qv[4] * fexp2(gj[4] - rf[4]), qv[5] * fexp2(gj[5] - rf[5])); q.w = pk2(qv[6] * fexp2(gj[6] - rf[6]), qv[7] * fexp2(gj[7] - rf[7]));
                *(LAS u32x4*)(Qh + j * LDQ + d0) = q;
            }
#pragma unroll
            for (int I = 0; I < 4; ++I) if (I >= J) {
                const size_t ro = (r0 + 16 * I) * 512 + h * 128 + d0;
                const f32x4 ra = *(const f32x4*)(GLg + ro), rb = *(const f32x4*)(GLg + ro + 4);
                const float rf[8] = {ra[0], ra[1], ra[2], ra[3], rb[0], rb[1], rb[2], rb[3]};
                float kh[8];
#pragma unroll
                for (int e = 0; e < 8; ++e) kh[e] = kv[e] * fexp2(fminf(rf[e] - gj[e], 120.f));
                u32x4 o; o.x = pk2(kh[0], kh[1]); o.y = pk2(kh[2], kh[3]); o.z = pk2(kh[4], kh[5]); o.w = pk2(kh[6], kh[7]);
                *(LAS u32x4*)(Kh + (8 * I * (I + 1) + j) * LDQ + d0) = o;
            }
            const unsigned rw[4] = {raw.x, raw.y, raw.z, raw.w};
#pragma unroll
            for (int e = 0; e < 8; ++e) Vt[(d0 + e) * LDV + j] = (bf16_t)((rw[e >> 1] >> ((e & 1) * 16)) & 0xffffu);
        }
        for (int idx = tid; idx < 64 * LDV / 8; idx += 512) *(LAS u32x4*)(As + idx * 8) = (u32x4){0u, 0u, 0u, 0u};
        LDS_BARRIER();
        HP_E(0x10000); HP_B(0x20000);
#pragma unroll 1
        for (int t = w; t < 10; t += 8) {
            const int I = t >= 6 ? 3 : t >= 3 ? 2 : t >= 1 ? 1 : 0, J = t - (I * (I + 1)) / 2;
            f32x4 sc = {0.f, 0.f, 0.f, 0.f};
#pragma unroll
            for (int ks = 0; ks < 4; ++ks) sc = MMA16(ldfrag(Kh + (8 * I * (I + 1) + 16 * J) * LDQ, LDQ, fr, fq, ks * 32), ldfrag(Qh + (16 * I) * LDQ, LDQ, fr, fq, ks * 32), sc);
            if (I == J) {
#pragma unroll
                for (int r = 0; r < 4; ++r) sc[r] = (4 * fq + r <= fr) ? sc[r] : 0.f;
            }
            u32x2 o; o.x = pk2(sc[0], sc[1]); o.y = pk2(sc[2], sc[3]);
            *(LAS u32x2*)(As + (16 * I + fr) * LDV + 16 * J + 4 * fq) = o;
        }
        LDS_BARRIER();
        HP_E(0x20000); HP_B(0x40000);
        const int it4 = w & 3, eb = (w >> 2) * 4;
        bf16x8 af[2], qf[4];
#pragma unroll
        for (int ks = 0; ks < 2; ++ks) af[ks] = ldfrag(As + (it4 * 16) * LDV, LDV, fr, fq, ks * 32);
#pragma unroll
        for (int ks = 0; ks < 4; ++ks) qf[ks] = ldfrag(Qt + (it4 * 16) * LDQ, LDQ, fr, fq, ks * 32);
#pragma unroll
        for (int it = 0; it < 2; ++it) {
            const int j = 16 * ((it * 8 + w) >> 2) + (lane & 15), d0 = (((it * 8 + w) & 3) * 4 + (lane >> 4)) * 8;
            const unsigned rw[4] = {ktp[it].x, ktp[it].y, ktp[it].z, ktp[it].w};
#pragma unroll
            for (int e = 0; e < 8; ++e) Kt[(d0 + e) * LDV + j] = (bf16_t)((rw[e >> 1] >> ((e & 1) * 16)) & 0xffffu);
        }
        if (tid < 128) DecL[tid] = fexp2(g63s);
        LDS_BARRIER();
#pragma unroll
        for (int t = 0; t < 4; ++t) {
            const int et = eb + t; f32x4 o = {0.f, 0.f, 0.f, 0.f};
#pragma unroll
            for (int ks = 0; ks < 2; ++ks) if (ks == 0 || it4 >= 2) o = MMA16(ldfrag(Vt + (et * 16) * LDV, LDV, fr, fq, ks * 32), af[ks], o);
#pragma unroll
            for (int ks = 0; ks < 4; ++ks) o = MMA16(ldfrag(Sts + (et * 16) * LDQ, LDQ, fr, fq, ks * 32), qf[ks], o);
            *(LAS f32x4*)(Os + (it4 * 16 + fr) * LDG + et * 16 + 4 * fq) = o;
        }
        {
            bf16x8 vf[2];
#pragma unroll
            for (int ks = 0; ks < 2; ++ks) vf[ks] = ldfrag(Vt + (w * 16) * LDV, LDV, fr, fq, ks * 32);
#pragma unroll
            for (int dt = 0; dt < 8; ++dt) {
                acc[dt] = acc[dt] * *(const LAS f32x4*)(DecL + dt * 16 + 4 * fq);
#pragma unroll
                for (int ks = 0; ks < 2; ++ks) acc[dt] = MMA16(ldfrag(Kt + (dt * 16) * LDV, LDV, fr, fq, ks * 32), vf[ks], acc[dt]);
            }
        }
        LDS_BARRIER();
        HP_E(0x40000); HP_B(0x80000);
#pragma unroll
        for (int dt = 0; dt < 8; ++dt) { u32x2 o; o.x = pk2(acc[dt][0], acc[dt][1]); o.y = pk2(acc[dt][2], acc[dt][3]); *(LAS u32x2*)(Sts + (w * 16 + fr) * LDQ + dt * 16 + 4 * fq) = o; }
        {
            const int i = w * 8 + (lane >> 3), c0 = (lane & 7) * 16;
            f32x4 ov[4]; float ss = 0.f;
#pragma unroll
            for (int q = 0; q < 4; ++q) { ov[q] = *(const LAS f32x4*)(Os + i * LDG + c0 + 4 * q); ss += (ov[q][0] * ov[q][0] + ov[q][1] * ov[q][1]) + (ov[q][2] * ov[q][2] + ov[q][3] * ov[q][3]); }
            ss += __shfl_xor(ss, 1); ss += __shfl_xor(ss, 2); ss += __shfl_xor(ss, 4);
            const float r = rsqrtf(ss * (1.f / 128.f) + EPS);
            const float* ngp = a.hg_norm_g + l * 128 + c0;
            unsigned ow[8];
#pragma unroll
            for (int q = 0; q < 4; ++q) { const f32x4 g = *(const f32x4*)(ngp + 4 * q); const unsigned og0 = ogreg[2 * q], og1 = ogreg[2 * q + 1];
                ow[2 * q] = pk2(ov[q][0] * r * g[0] * bf2f(og0 & 0xffffu), ov[q][1] * r * g[1] * bf2f(og0 >> 16));
                ow[2 * q + 1] = pk2(ov[q][2] * r * g[2] * bf2f(og1 & 0xffffu), ov[q][3] * r * g[3] * bf2f(og1 >> 16)); }
            u32x4* op = (u32x4*)(OGg + (r0 + i) * 512 + h * 128 + c0);
            op[0] = (u32x4){ow[0], ow[1], ow[2], ow[3]}; op[1] = (u32x4){ow[4], ow[5], ow[6], ow[7]};
        }
        LDS_BARRIER();
        HP_E(0x80000);
    }
}

__device__ __forceinline__ void conv_fixup(const Args& a, int l) {
    const bf16_t* H = (const bf16_t*)(a.ws + WS_Z); bf16_t* AC = (bf16_t*)(a.ws + WS_AC);
    const float* cw = a.conv_w + (size_t)l * 3 * NUP; const float* cb = a.conv_b + (size_t)l * NUP;
    constexpr int CCH = DFF / 8, NITEM = (M / 64) * CCH;
    for (int item = blockIdx.x * 512 + opaque_tid(); item < NITEM; item += gridDim.x * 512) {
        const int cc = item % CCH, gi = item / CCH, c = cc * 8;
        const bool first = (gi & (SEQ / 64 - 1)) == 0;
        float z[2][4][8];
#pragma unroll
        for (int gv = 0; gv < 2; ++gv) {
            const bf16_t* hp = H + (size_t)gi * 4 * NUP + gv * DFF + c;
            if (first) {
#pragma unroll
                for (int e = 0; e < 8; ++e) { z[gv][0][e] = 0.f; z[gv][1][e] = 0.f; }
            } else { unpack8(*(const u32x4*)(hp - 2 * NUP), z[gv][0]); unpack8(*(const u32x4*)(hp - NUP), z[gv][1]); }
            unpack8(*(const u32x4*)hp, z[gv][2]); unpack8(*(const u32x4*)(hp + NUP), z[gv][3]);
        }
        float w[2][3][8], bb[2][8];
#pragma unroll
        for (int gv = 0; gv < 2; ++gv) {
#pragma unroll
            for (int t = 0; t < 3; ++t) { const f32x4 x0 = *(const f32x4*)(cw + t * NUP + gv * DFF + c), x1 = *(const f32x4*)(cw + t * NUP + gv * DFF + c + 4);
#pragma unroll
                for (int e = 0; e < 4; ++e) { w[gv][t][e] = x0[e]; w[gv][t][4 + e] = x1[e]; } }
            const f32x4 y0 = *(const f32x4*)(cb + gv * DFF + c), y1 = *(const f32x4*)(cb + gv * DFF + c + 4);
#pragma unroll
            for (int e = 0; e < 4; ++e) { bb[gv][e] = y0[e]; bb[gv][4 + e] = y1[e]; }
        }
#pragma unroll
        for (int r = 0; r < 2; ++r) {
            float o[8];
#pragma unroll
            for (int e = 0; e < 8; ++e) {
                const float zg = bb[0][e] + w[0][0][e] * z[0][r][e] + w[0][1][e] * z[0][r + 1][e] + w[0][2][e] * z[0][r + 2][e];
                const float zv = bb[1][e] + w[1][0][e] * z[1][r][e] + w[1][1][e] * z[1][r + 1][e] + w[1][2][e] * z[1][r + 2][e];
                o[e] = silu(zg) * zv;
            }
            u32x4 wv; wv.x = pk2(o[0], o[1]); wv.y = pk2(o[2], o[3]); wv.z = pk2(o[4], o[5]); wv.w = pk2(o[6], o[7]);
            *(u32x4*)(AC + (size_t)(gi * 64 + r) * DFF + c) = wv;
        }
    }
}

__device__ __forceinline__ void prologue(const Args& a, LAS unsigned char* lds) {
    const int tid = opaque_tid(), lane = tid & 63, wave = tid >> 6;
    if (blockIdx.x == 0) {
        float* LB = (float*)(a.ws + WS_LB);
        for (int c = tid; c < 512; c += 512) {
            const float x0 = a.hg_lb[c], x1 = a.hg_lb[512 + c], x2 = a.hg_lb[1024 + c], x3 = a.hg_lb[1536 + c];
            const float mx = fmaxf(fmaxf(x0, x1), fmaxf(x2, x3));
            const float e0 = __expf(x0 - mx), e1 = __expf(x1 - mx), e2 = __expf(x2 - mx), e3 = __expf(x3 - mx), inv = 1.f / (e0 + e1 + e2 + e3);
            const float p1 = e1 * inv, p2 = e2 * inv, p3 = e3 * inv;
            LB[c] = 0.f; LB[512 + c] = fminf(fmaxf(p1, 0.f), 0.999f); LB[1024 + c] = fminf(fmaxf(p1 + p2, 0.f), 0.999f); LB[1536 + c] = fminf(fmaxf(p1 + p2 + p3, 0.f), 0.999f);
        }
    }
    convert_set(a, lds, 0, 0);
    convert_set(a, lds, 1, 0);
    const int gw = blockIdx.x * 8 + wave, NGW = gridDim.x * 8;
    bf16_t* XN = (bf16_t*)(a.ws + WS_XN); float* ssq = (float*)(a.ws + WS_SSQ);
    for (int m0 = gw; m0 < M; m0 += 4 * NGW) {
        f32x4 v[4][4];
#pragma unroll
        for (int r = 0; r < 4; ++r) { const int m = m0 + r * NGW; if (m < M) { const f32x4* xr = (const f32x4*)(a.x + (size_t)m * D) + lane;
#pragma unroll
            for (int j = 0; j < 4; ++j) v[r][j] = xr[64 * j]; } }
#pragma unroll
        for (int r = 0; r < 4; ++r) { const int m = m0 + r * NGW; if (m < M) {
            u32x2* xnr = (u32x2*)(XN + (size_t)m * D) + lane;
            float s = 0.f;
#pragma unroll
            for (int j = 0; j < 4; ++j) { const f32x4 vv = v[r][j];
                u32x2 o; o.x = pk2(vv.x, vv.y); o.y = pk2(vv.z, vv.w); xnr[64 * j] = o;
                const f32x4 vr = {bf2f(o.x & 0xffffu), bf2f(o.x >> 16), bf2f(o.y & 0xffffu), bf2f(o.y >> 16)}; s += (vr.x * vr.x + vr.y * vr.y) + (vr.z * vr.z + vr.w * vr.w); }
            s = wave_sum(s);
            if (lane < 16) ssq[(size_t)m * 16 + lane] = lane == 0 ? s : 0.f; } }
    }
}
__device__ __forceinline__ void final_norm(const Args& a) {
    const int tid = opaque_tid(), lane = tid & 63, wave = tid >> 6;
    const int gw = blockIdx.x * 8 + wave, NGW = gridDim.x * 8;
    const float* ssq = (const float*)(a.ws + WS_SSQ);
    for (int m0 = gw; m0 < M; m0 += 4 * NGW) {
        float rs[4]; u32x2 xv[4][4];
#pragma unroll
        for (int r = 0; r < 4; ++r) { const int m = m0 + r * NGW; if (m < M) { rs[r] = rowscale(ssq, m);
            const u32x2* xr = (const u32x2*)((const bf16_t*)(a.ws + WS_XN) + (size_t)m * D) + lane;
#pragma unroll
            for (int j = 0; j < 4; ++j) xv[r][j] = xr[64 * j]; } }
#pragma unroll
        for (int r = 0; r < 4; ++r) { const int m = m0 + r * NGW; if (m < M) {
            f32x4* orow = (f32x4*)(a.out + (size_t)m * D) + lane; const f32x4* gr = (const f32x4*)a.final_norm + lane; const float rr = rs[r];
#pragma unroll
            for (int j = 0; j < 4; ++j) { const u32x2 x = xv[r][j]; const f32x4 g = gr[64 * j];
                orow[64 * j] = (f32x4){bf2f(x.x & 0xffffu) * rr * g.x, bf2f(x.x >> 16) * rr * g.y, bf2f(x.y & 0xffffu) * rr * g.z, bf2f(x.y >> 16) * rr * g.w}; } } }
    }
}

#define XB_TMO      128
#define XB_XCNT(j)  (256  + 64 * (j))
#define XB_XSUB(j)  (1280 + 64 * (j))
#define XB_XGEN(j)  (2304 + 64 * (j))
#define XB_TOP      3328
#define XB_TOPGEN   3392
#define XCD_BAR_WORDS 3456
#define XB_SPIN_CAP (1u << 20)

__device__ __forceinline__ unsigned xb_ld(unsigned* p)              { return __hip_atomic_load(p, __ATOMIC_RELAXED, __HIP_MEMORY_SCOPE_AGENT); }
__device__ __forceinline__ unsigned xb_add(unsigned* p, unsigned v) { return __hip_atomic_fetch_add(p, v, __ATOMIC_RELAXED, __HIP_MEMORY_SCOPE_AGENT); }
__device__ __forceinline__ unsigned xb_xcc_id() { return (unsigned)__builtin_amdgcn_s_getreg((3 << 11) | 20) & 0xFu; }
#define XB_SPIN(cond, bar) do { unsigned _sp = 0; while (cond) {   \
    if ((++_sp & 255u) == 0u) { if (xb_ld(&(bar)[XB_TMO])) break; if (_sp > XB_SPIN_CAP) { atomicAdd(&(bar)[XB_TMO], 1u); break; } } } } while (0)

struct XcdBarrier {
    unsigned* bar; unsigned x;
    volatile LAS unsigned* st;
};

__device__ __forceinline__ XcdBarrier xcd_barrier_post(unsigned* bar, volatile LAS unsigned* st) {
    XcdBarrier b; b.bar = bar; b.x = xb_xcc_id(); b.st = st;
    if (threadIdx.x == 0) (void)xb_add(&bar[XB_XCNT(b.x)], 1u);
    return b;
}
__device__ __forceinline__ void xcd_barrier_complete(unsigned* bar, unsigned x, unsigned& nloc, unsigned& nx) {
    const unsigned G = gridDim.x * gridDim.y * gridDim.z;
    unsigned sum, cnt, mine, sp = 0u;
    for (;;) {
        sum = 0u; cnt = 0u; mine = 0u;
#pragma unroll
        for (unsigned j = 0; j < 16; ++j) { const unsigned c = xb_ld(&bar[XB_XCNT(j)]); sum += c; cnt += (c > 0u) ? 1u : 0u; mine = (j == x) ? c : mine; }
        if (sum == G) break;
        __builtin_amdgcn_s_sleep(1);
        if ((++sp & 255u) == 0u) { if (xb_ld(&bar[XB_TMO])) break; if (sp > XB_SPIN_CAP) { atomicAdd(&bar[XB_TMO], 1u); break; } }
    }
    nloc = mine > 0u ? mine : 1u; nx = cnt > 0u ? cnt : 1u;
}

__device__ __forceinline__ void xcd_barrier(const XcdBarrier& b) {
    asm volatile("s_waitcnt vmcnt(0)" ::: "memory");
    __syncthreads();
    if (threadIdx.x == 0) {
        unsigned* bar = b.bar;
        __builtin_amdgcn_s_waitcnt(0);
        unsigned nloc = b.st[0], nx = b.st[1];
        if (nloc == 0u) { xcd_barrier_complete(bar, b.x, nloc, nx); b.st[0] = nloc; b.st[1] = nx; }
        const unsigned old = xb_add(&bar[XB_XSUB(b.x)], 1u);
        const unsigned gen = old / nloc;
        if (old + 1u == (gen + 1u) * nloc) {
            __builtin_amdgcn_fence(__ATOMIC_RELEASE, "agent");
            asm volatile("s_waitcnt vmcnt(0)" ::: "memory");
            const unsigned og = xb_add(&bar[XB_TOP], 1u);
            const unsigned tg = og / nx;
            if (og + 1u == (tg + 1u) * nx) xb_add(&bar[XB_TOPGEN], 1u);
            else XB_SPIN(xb_ld(&bar[XB_TOPGEN]) == tg, bar);
            __builtin_amdgcn_fence(__ATOMIC_ACQUIRE, "agent");
            xb_add(&bar[XB_XGEN(b.x)], 1u);
            asm volatile("s_waitcnt vmcnt(0)" ::: "memory");
        } else {
            XB_SPIN(xb_ld(&bar[XB_XGEN(b.x)]) == gen, bar);
            __builtin_amdgcn_fence(__ATOMIC_ACQUIRE, "agent");
            asm volatile("s_waitcnt vmcnt(0)" ::: "memory");
        }
    }
    __syncthreads();
}

__global__ void __launch_bounds__(512, 2) trunk_fwd(Args a) {
    extern __shared__ __attribute__((aligned(16))) unsigned char lds_raw[];
    LAS unsigned char* lds = (LAS unsigned char*)lds_raw;
    cg::grid_group grid = cg::this_grid();
    if (threadIdx.x < 64) ((LAS unsigned*)(lds + (LDS_BYTES - 256)))[threadIdx.x] = 0u;
    __syncthreads();
    XcdBarrier bar = xcd_barrier_post((unsigned*)a.ws + 4096, (volatile LAS unsigned*)(lds + (LDS_BYTES - 256)));
    unsigned char* ws = a.ws;
    const int G = gridDim.x, bx = blockIdx.x;
    bf16_t* XN; float* ssq;

#ifndef PH
#define PH 0xFFFF
#endif
#ifndef PROBE_MASK
#define PROBE_MASK 0
#endif
    unsigned long long pr_acc = 0, pr_t0 = 0;
#define PR_BEGIN(bit) do { if ((PROBE_MASK) & (bit)) pr_t0 = __builtin_amdgcn_s_memrealtime(); } while (0)
#define PR_END(bit) do { if ((PROBE_MASK) & (bit)) pr_acc += __builtin_amdgcn_s_memrealtime() - pr_t0; } while (0)
    PR_BEGIN(1);
    if (PH & 1) prologue(a, lds);
    if (a.ws == nullptr) grid.sync();
    xcd_barrier(bar);
    PR_END(1);
#define LAUNDER(p) asm volatile("" : "+s"(p))
#pragma unroll 1
    for (int l = 0; l < DEPTH; ++l) {
        PR_BEGIN(2);
#ifndef REP_P1
#define REP_P1 1
#endif
#ifndef REP_P5
#define REP_P5 1
#endif
#pragma unroll 1
        for (int rep = 0; rep < REP_P1; ++rep)
        if (PH & 2) { LAUNDER(ws); XN = (bf16_t*)(ws + WS_XN); ssq = (float*)(ws + WS_SSQ);
            pg8::Gemm g{XN, (const bf16_t*)(ws + WS_WIN), M, INC, D}; pg8::StaticOrder S; S.init(M, INC, G, bx);
            EpiIn E{(bf16_t*)(ws + WS_U), (bf16_t*)(ws + WS_V), (bf16_t*)(ws + WS_Q), (bf16_t*)(ws + WS_KK), (bf16_t*)(ws + WS_I), (bf16_t*)(ws + WS_OG), (bf16_t*)(ws + WS_GT),
                    (float*)(ws + WS_GL), ssq, (const float*)(ws + WS_LB) + l * 512, (float*)(ws + WS_VS), (const LAS float*)(lds + RTAB_OFF), 0};
            fill_rtab(S, ssq, lds);
            pg8::gemm_phase<EpiIn, pg8::StaticOrder, ALIGN_HEAVY, true>(lds, g, S, E);
        }
        xcd_barrier(bar);
        PR_END(2);
        PR_BEGIN(4);
        if (PH & 4) { int wl_h = -1; for (int u = bx; u < 8 * HG_NG + 512; u += G) { if (u < 8 * HG_NG) { PR_BEGIN(2048); hg1g_unit(a, lds, u); PR_END(2048); wl_h = -1; } else { PR_BEGIN(4096); { const int gh = (u - 8 * HG_NG) & 3; gmlp_unit(a, lds, u - 8 * HG_NG, l, gh != wl_h); wl_h = gh; } PR_END(4096); } } }
        xcd_barrier(bar);
        PR_END(4);
        PR_BEGIN(8);
        if (PH & 8) { hg_gscan(a); }
        xcd_barrier(bar);
        PR_END(8);
        PR_BEGIN(16);
        if (PH & 16) for (int u = bx; u < 8 * HG_NG; u += G) hg3g_unit(a, lds, u, l, pr_acc);
        xcd_barrier(bar);
        PR_END(16);
        PR_BEGIN(32);
        if (PH & 32) { LAUNDER(ws);
            pg8::StaticOrder S; S.init(M, D, G, bx);
            pg8::Gemm g1{(const bf16_t*)(ws + WS_U), (const bf16_t*)(ws + WS_WGM), M, D, 512};
            EpiBr<false> E1{(bf16_t*)(ws + WS_Y), (const bf16_t*)(ws + WS_GT), 0};
            pg8::gemm_phase<EpiBr<false>, pg8::StaticOrder, ALIGN_SINGLE, true>(lds, g1, S, E1);
            pg8::Gemm g2{(const bf16_t*)(ws + WS_OG), (const bf16_t*)(ws + WS_WHG), M, D, 512};
            EpiBr<true> E2{(bf16_t*)(ws + WS_Y), (const bf16_t*)(ws + WS_GT), 1024};
            pg8::gemm_phase<EpiBr<true>, pg8::StaticOrder, ALIGN_SINGLE, true>(lds, g2, S, E2);
        }
        xcd_barrier(bar);
        PR_END(32);
        PR_BEGIN(64);
        if (PH & 64) { LAUNDER(ws); XN = (bf16_t*)(ws + WS_XN); ssq = (float*)(ws + WS_SSQ);
            pg8::Gemm g{(const bf16_t*)(ws + WS_Y), (const bf16_t*)(ws + WS_WOUT), M, D, D}; pg8::StaticOrder S; S.init(M, D, G, bx);
            EpiRes E{XN, (bf16_t*)(ws + WS_XN2), ssq};
            pg8::gemm_phase<EpiRes, pg8::StaticOrder, ALIGN_SINGLE, true>(lds, g, S, E);
        }
        xcd_barrier(bar);
        PR_END(64);
        PR_BEGIN(128);
#pragma unroll 1
        for (int rep = 0; rep < REP_P5; ++rep)
        if (PH & 128) { LAUNDER(ws); XN = (bf16_t*)(ws + WS_XN); ssq = (float*)(ws + WS_SSQ);
            pg8::Gemm g{(const bf16_t*)(ws + WS_XN2), (const bf16_t*)(ws + WS_WUP + (l & 1) * WS_FFNW_STRIDE), M, NUP, D}; pg8::StaticOrder S; S.init(M, NUP, G, bx);
            EpiUp E{(bf16_t*)(ws + WS_AC), (bf16_t*)(ws + WS_Z), ssq, a.conv_w + (size_t)l * 3 * NUP, a.conv_b + (size_t)l * NUP, (LAS float*)(lds + 132096), (const LAS float*)(lds + RTAB_OFF), 0};
            if (l + 1 < DEPTH) { convert_set(a, lds, 0, l + 1, G / 2, G - G / 2); convert_set(a, lds, 1, l + 1, G / 2, G - G / 2); __syncthreads(); }
            fill_rtab(S, ssq, lds);
            pg8::gemm_phase<EpiUp, pg8::StaticOrder, ALIGN_HEAVY, true>(lds, g, S, E);
        }
        xcd_barrier(bar);
        PR_END(128);
        PR_BEGIN(256);
        if (PH & 256) { conv_fixup(a, l); }
        xcd_barrier(bar);
        PR_END(256);
        PR_BEGIN(512);
        if (PH & 512) { LAUNDER(ws); XN = (bf16_t*)(ws + WS_XN); ssq = (float*)(ws + WS_SSQ);
            pg8::Gemm g{(const bf16_t*)(ws + WS_AC), (const bf16_t*)(ws + WS_WDN + (l & 1) * WS_FFNW_STRIDE), M, D, DFF}; pg8::StaticOrder S; S.init(M, D, G, bx);
            EpiRes E{(const bf16_t*)(ws + WS_XN2), XN, ssq};
            pg8::gemm_phase<EpiRes, pg8::StaticOrder, ALIGN_SINGLE, true>(lds, g, S, E);
        }
        xcd_barrier(bar);
        PR_END(512);
    }
    if (PH & 1024) final_norm(a);
    if ((PROBE_MASK) && blockIdx.x == 0) { const unsigned long long te = __builtin_amdgcn_s_memrealtime() + 4 * pr_acc; while (__builtin_amdgcn_s_memrealtime() < te) __builtin_amdgcn_s_sleep(8); }
}

extern "C" void kernel_launch(void* const* d_in, const int* in_sizes, int n_in, void* d_out, int out_size, void* d_ws, size_t ws_size, hipStream_t stream) {
    static int grid = 0;
    if (grid == 0) {
        if (n_in != 18 || out_size != M * D || ws_size < WS_NEED) { fprintf(stderr, "kernel_launch: unexpected shapes (n_in %d, out %d, ws %zu < %zu)\n", n_in, out_size, ws_size, (size_t)WS_NEED); grid = -1; return; }
        int dev = 0, cus = 0, per_cu = 0;
        hipGetDevice(&dev); hipDeviceGetAttribute(&cus, hipDeviceAttributeMultiprocessorCount, dev);
        if (hipFuncSetAttribute((const void*)trunk_fwd, hipFuncAttributeMaxDynamicSharedMemorySize, LDS_BYTES) != hipSuccess) { fprintf(stderr, "kernel_launch: hipFuncSetAttribute failed\n"); grid = -1; return; }
        if (hipOccupancyMaxActiveBlocksPerMultiprocessor(&per_cu, (const void*)trunk_fwd, 512, LDS_BYTES) != hipSuccess || per_cu < 1) { fprintf(stderr, "kernel_launch: occupancy query says %d\n", per_cu); per_cu = 1; }
        (void)hipGetLastError();
        grid = cus * 1;
    }
    if (grid < 0) return;
    if (hipMemsetAsync(d_ws, 0, 32768, stream) != hipSuccess) { fprintf(stderr, "kernel_launch: memset failed\n"); return; }
    Args a{};
    const float** ap = (const float**)&a;
    for (int i = 0; i < 18; ++i) ap[i] = (const float*)d_in[i];
    a.out = (float*)d_out; a.ws = (unsigned char*)d_ws;
    void* args[] = {&a};
    hipError_t e = hipLaunchCooperativeKernel((const void*)trunk_fwd, dim3(grid), dim3(512), args, LDS_BYTES, stream);
    if (e != hipSuccess) fprintf(stderr, "cooperative launch failed: %s (grid %d)\n", hipGetErrorString(e), grid);
}
```
